# Optimizing an MI355X kernel written in HIP

```python
import jax, jax.numpy as jnp
from jax import lax
import numpy as np

D_MODEL = 2048
BATCH = 1
SEQ = 8192
DEPTH = 1

CHUNK = 128
A_GROUPS = 8
A_GROUP_DIM = 128
A_WIDTH = A_GROUPS * A_GROUP_DIM
SB_HEADS = 8
SB_HEAD_DIM = 128
SB_WIDTH = SB_HEADS * SB_HEAD_DIM
Q_BLOCK = 128
N_GROUPS = 4
EXPERTS_PER_GROUP = 8
N_EXPERTS = N_GROUPS * EXPERTS_PER_GROUP
TOP_K_IN_GROUP = 2
D_EXPERT = D_MODEL // 2
MOE_BLOCK = 128
EPS = 1e-6
PROJ_WIDTH = 2 * A_WIDTH + 3 * SB_WIDTH + 2 * D_MODEL
SPLITS = [A_WIDTH, 2 * A_WIDTH, 2 * A_WIDTH + SB_WIDTH, 2 * A_WIDTH + 2 * SB_WIDTH,
          2 * A_WIDTH + 3 * SB_WIDTH, 2 * A_WIDTH + 3 * SB_WIDTH + D_MODEL]

kernel_name = "hybrid_gmlp_stickbreak_hmoe"


def rms_norm(x, g):
    xf = x.astype(jnp.float32)
    y = xf * lax.rsqrt(jnp.mean(xf * xf, axis=-1, keepdims=True) + EPS)
    return (y * g.astype(jnp.float32)).astype(x.dtype)


def layer_norm(x, g, b):
    xf = x.astype(jnp.float32)
    mu = jnp.mean(xf, axis=-1, keepdims=True)
    xc = xf - mu
    y = xc * lax.rsqrt(jnp.mean(xc * xc, axis=-1, keepdims=True) + EPS)
    return (y * g.astype(jnp.float32) + b.astype(jnp.float32)).astype(x.dtype)


def chunked_spatial_gating(u, v, ln_g, ln_b, w_s, b_s):
    B, S, _ = v.shape
    v = layer_norm(v, ln_g, ln_b)
    vc = v.reshape(B, S // CHUNK, CHUNK, A_GROUPS, A_GROUP_DIM)
    causal = jnp.tril(jnp.ones((CHUNK, CHUNK), dtype=bool))
    ws = jnp.where(causal[None], w_s, 0)
    mixed = jnp.einsum('gts,bcsgd->bctgd', ws, vc) + b_s.T[:, :, None]
    return u * mixed.reshape(B, S, A_WIDTH)


def stick_breaking_attention(q, k, v):
    B, S, _ = q.shape
    nb = S // Q_BLOCK
    def heads(t):
        return t.reshape(B, S, SB_HEADS, SB_HEAD_DIM).transpose(0, 2, 1, 3)
    q, k, v = heads(q), heads(k), heads(v)
    v32 = v.astype(jnp.float32)
    q_blocks = q.reshape(B, SB_HEADS, nb, Q_BLOCK, SB_HEAD_DIM).transpose(2, 0, 1, 3, 4)
    kpos = jnp.arange(S)
    scale = SB_HEAD_DIM ** -0.5

    def block(args):
        qi, i = args
        z = jnp.einsum('bhqd,bhkd->bhqk', qi, k).astype(jnp.float32) * scale
        qpos = i * Q_BLOCK + jnp.arange(Q_BLOCK)
        mask = kpos[None, :] < qpos[:, None]
        log_rem = jnp.where(mask, jax.nn.log_sigmoid(-z), 0.0)
        suffix = lax.cumsum(log_rem, axis=3, reverse=True) - log_rem
        weights = jnp.where(mask, jnp.exp(jax.nn.log_sigmoid(z) + suffix), 0.0)
        return jnp.einsum('bhqk,bhkd->bhqd', weights, v32).astype(v.dtype)

    o = lax.map(block, (q_blocks, jnp.arange(nb)))
    o = o.transpose(1, 0, 3, 2, 4).reshape(B, S, SB_WIDTH)
    return o


def hierarchical_moe(h, w_rg, b_rg, w_re, b_re, w_gate, w_up, w_down):
    B, S, D = h.shape
    T = B * S
    xt = h.reshape(T, D)
    lg = jnp.einsum('td,dg->tg', xt, w_rg).astype(jnp.float32) + b_rg.astype(jnp.float32)
    pg = jax.nn.softmax(lg, axis=-1)
    grp = jnp.argmax(lg, axis=-1)
    pg_sel = jnp.take_along_axis(pg, grp[:, None], axis=1)[:, 0]
    le = (jnp.einsum('td,de->te', xt, w_re).astype(jnp.float32)
          + b_re.astype(jnp.float32)).reshape(T, N_GROUPS, EXPERTS_PER_GROUP)
    le_sel = jnp.take_along_axis(le, grp[:, None, None], axis=1)[:, 0]
    top_v, top_i = lax.top_k(le_sel, TOP_K_IN_GROUP)
    pe = jax.nn.softmax(top_v, axis=-1)
    gate_w = pg_sel[:, None] * pe
    expert = grp[:, None] * EXPERTS_PER_GROUP + top_i

    N = T * TOP_K_IN_GROUP
    e_flat = expert.reshape(N).astype(jnp.int32)
    w_flat = gate_w.reshape(N)
    tok_flat = jnp.repeat(jnp.arange(T, dtype=jnp.int32), TOP_K_IN_GROUP)
    counts = jnp.bincount(e_flat, length=N_EXPERTS)
    starts = jnp.cumsum(counts) - counts
    padded = ((counts + MOE_BLOCK - 1) // MOE_BLOCK) * MOE_BLOCK
    pends = jnp.cumsum(padded)
    pstarts = pends - padded
    order = jnp.argsort(e_flat, stable=True)
    se = e_flat[order]
    dest = pstarts[se] + (jnp.arange(N) - starts[se])
    n_rows = ((N + MOE_BLOCK - 1) // MOE_BLOCK + N_EXPERTS) * MOE_BLOCK
    row_tok = jnp.zeros((n_rows,), jnp.int32).at[dest].set(tok_flat[order])
    row_w = jnp.zeros((n_rows,), jnp.float32).at[dest].set(w_flat[order])
    nblk = n_rows // MOE_BLOCK
    block_start = jnp.arange(nblk) * MOE_BLOCK
    block_expert = jnp.minimum(jnp.sum(block_start[:, None] >= pends[None, :], axis=1),
                               N_EXPERTS - 1)

    def expert_block(args):
        tok, wrow, e = args
        xb = xt[tok]
        hdn = jax.nn.silu(xb @ w_gate[e]) * (xb @ w_up[e])
        return (hdn @ w_down[e]) * wrow[:, None].astype(xb.dtype)

    y = lax.map(expert_block, (row_tok.reshape(nblk, MOE_BLOCK),
                               row_w.reshape(nblk, MOE_BLOCK), block_expert))
    out = jnp.zeros((T, D), xt.dtype).at[row_tok].add(y.reshape(n_rows, D))
    return out.reshape(B, S, D)


def setup_inputs(seed: int = 0) -> dict:
    key = jax.random.key(seed)
    ks = jax.random.split(key, 20)
    def nrm(k, shape, scale):
        return jax.random.normal(k, shape, jnp.float32) * scale
    return {
        "x": nrm(ks[0], (BATCH, SEQ, D_MODEL), 1.0),
        "g_mix": 1.0 + nrm(ks[1], (DEPTH, D_MODEL), 0.01),
        "w_in": nrm(ks[2], (DEPTH, D_MODEL, PROJ_WIDTH), D_MODEL ** -0.5),
        "ln_v_g": 1.0 + nrm(ks[3], (DEPTH, A_WIDTH), 0.01),
        "ln_v_b": nrm(ks[4], (DEPTH, A_WIDTH), 0.01),
        "w_spatial": jnp.tril(nrm(ks[5], (DEPTH, A_GROUPS, CHUNK, CHUNK), 0.5 * CHUNK ** -0.5)),
        "b_spatial": 1.0 + nrm(ks[6], (DEPTH, A_GROUPS, CHUNK), 0.01),
        "w_branch_a": nrm(ks[7], (DEPTH, A_WIDTH, D_MODEL), A_WIDTH ** -0.5),
        "w_branch_b": nrm(ks[8], (DEPTH, SB_WIDTH, D_MODEL), SB_WIDTH ** -0.5),
        "w_out": nrm(ks[9], (DEPTH, D_MODEL, D_MODEL), D_MODEL ** -0.5),
        "g_ffn": 1.0 + nrm(ks[10], (DEPTH, D_MODEL), 0.01),
        "w_router_group": nrm(ks[11], (DEPTH, D_MODEL, N_GROUPS), D_MODEL ** -0.5),
        "b_router_group": nrm(ks[12], (DEPTH, N_GROUPS), 0.01),
        "w_router_expert": nrm(ks[13], (DEPTH, D_MODEL, N_EXPERTS), D_MODEL ** -0.5),
        "b_router_expert": nrm(ks[14], (DEPTH, N_EXPERTS), 0.01),
        "w_gate": nrm(ks[15], (DEPTH, N_EXPERTS, D_MODEL, D_EXPERT), D_MODEL ** -0.5),
        "w_up": nrm(ks[16], (DEPTH, N_EXPERTS, D_MODEL, D_EXPERT), D_MODEL ** -0.5),
        "w_down": nrm(ks[17], (DEPTH, N_EXPERTS, D_EXPERT, D_MODEL), D_EXPERT ** -0.5),
        "g_final": 1.0 + nrm(ks[18], (D_MODEL,), 0.01),
    }


def reference(x, g_mix, w_in, ln_v_g, ln_v_b, w_spatial, b_spatial, w_branch_a, w_branch_b,
              w_out, g_ffn, w_router_group, b_router_group, w_router_expert, b_router_expert,
              w_gate, w_up, w_down, g_final):
    for i in range(DEPTH):
        h = rms_norm(x, g_mix[i])
        proj = jnp.einsum('bsd,dp->bsp', h, w_in[i])
        u_a, v_a, q, k, v, gate_a, gate_b = jnp.split(proj, SPLITS, axis=-1)
        y_a = chunked_spatial_gating(jax.nn.gelu(u_a), jax.nn.gelu(v_a),
                                     ln_v_g[i], ln_v_b[i], w_spatial[i], b_spatial[i])
        y_b = stick_breaking_attention(q, k, v)
        merged = (jax.nn.sigmoid(gate_a) * jnp.einsum('bsc,cd->bsd', y_a, w_branch_a[i])
                  + jax.nn.sigmoid(gate_b) * jnp.einsum('bsc,cd->bsd', y_b, w_branch_b[i]))
        x = x + jnp.einsum('bsd,de->bse', merged, w_out[i])
        h2 = rms_norm(x, g_ffn[i])
        x = x + hierarchical_moe(h2, w_router_group[i], b_router_group[i],
                                 w_router_expert[i], b_router_expert[i],
                                 w_gate[i], w_up[i], w_down[i])
    return rms_norm(x, g_final)
```

```cpp
#include <hip/hip_runtime.h>
#include <hip/hip_cooperative_groups.h>
#include <cstdio>
#include <cstdint>
namespace cg = cooperative_groups;

#ifndef N_LAUNCH_MODE
#define N_LAUNCH_MODE 0
#endif
#ifndef ATTN_EARLY_EXIT
#define ATTN_EARLY_EXIT 0
#endif

constexpr int T = 8192, D = 2048, PW = 9216, AW = 1024, NH = 8, HD = 128, CHK = 128, NGRP = 4, EPG = 8, NE = 32, DE = 1024;
constexpr int OFF_U = 0, OFF_GV = 1024, OFF_Q = 2048, OFF_K = 3072, OFF_V = 4096, OFF_GA = 5120, OFF_GB = 7168;
constexpr float EPS = 1e-6f;
constexpr int NWAVES = 8, NTHR = 512;
constexpr int N_PHASES = 9;

constexpr size_t MiB = 1u << 20;
constexpr size_t WS_CTL = 0, CTL_ZERO_BYTES = 1 * MiB;
constexpr size_t WS_LTOK = 1 * MiB, WS_LW = 2 * MiB, WS_LRSTD = 3 * MiB, WS_TINFO = 4 * MiB;
constexpr size_t WS_WIN_T = 8 * MiB, WS_WA_T = 44 * MiB, WS_WB_T = 48 * MiB, WS_WOUT_T = 52 * MiB, WS_WGU_T = 64 * MiB, WS_WD_T = 320 * MiB;
constexpr size_t WS_XN = 448 * MiB, WS_PROJ = 480 * MiB, WS_YA = 624 * MiB, WS_YB = 640 * MiB, WS_MERGED = 656 * MiB, WS_H2 = 688 * MiB;
constexpr size_t WS_HDN = 720 * MiB, WS_Y = 768 * MiB, WS_TMP = 864 * MiB, WS_END = 928 * MiB;
constexpr int SLOT_CAP = 24576;
constexpr int CW_CNT = 0;

constexpr int LDS_BYTES = 147456;

#define LAS __attribute__((address_space(3)))
typedef unsigned short bf16;
typedef float f32x4 __attribute__((ext_vector_type(4)));
typedef unsigned u32x4 __attribute__((ext_vector_type(4)));
typedef unsigned u32x2 __attribute__((ext_vector_type(2)));

__device__ __forceinline__ float bf2f(bf16 v) { return __uint_as_float((unsigned)v << 16); }
__device__ __forceinline__ unsigned f2bf(float f) { unsigned u = __float_as_uint(f); return (u + 0x7fffu + ((u >> 16) & 1u)) >> 16; }
__device__ __forceinline__ unsigned pk2(float lo, float hi) { return f2bf(lo) | (f2bf(hi) << 16); }
__device__ __forceinline__ float wave_sum(float v) {
#pragma unroll
    for (int o = 1; o < 64; o <<= 1) v += __shfl_xor(v, o);
    return v;
}
__device__ __forceinline__ float sigmoidf_(float x) { return 1.0f / (1.0f + __expf(-x)); }
__device__ __forceinline__ float gelu_tanh(float x) { const float y = 0.7978845608028654f * (x + 0.044715f * x * x * x); return x / (1.0f + __expf(-2.0f * y)); }

struct Args { const float* in[19]; float* out; unsigned char* ws; int ph_lo, ph_hi; };

struct Frame {
    unsigned char* lds;
    int tid, lane, wave, G, bid;
    const Args* A;
};
#define IN_(i) (F.A->in[i])
#define F_x IN_(0)
#define F_g_mix IN_(1)
#define F_w_in IN_(2)
#define F_ln_g IN_(3)
#define F_ln_b IN_(4)
#define F_w_sp IN_(5)
#define F_b_sp IN_(6)
#define F_w_a IN_(7)
#define F_w_b IN_(8)
#define F_w_out IN_(9)
#define F_g_ffn IN_(10)
#define F_w_rg IN_(11)
#define F_b_rg IN_(12)
#define F_w_re IN_(13)
#define F_b_re IN_(14)
#define F_w_gate IN_(15)
#define F_w_up IN_(16)
#define F_w_down IN_(17)
#define F_g_final IN_(18)
#define F_out (F.A->out)
#define WSP(type, off) ((type*)(F.A->ws + (off)))
#define F_ctl WSP(unsigned, WS_CTL)
#define F_XN WSP(bf16, WS_XN)
#define F_PROJ WSP(bf16, WS_PROJ)
#define F_YA WSP(bf16, WS_YA)
#define F_YB WSP(bf16, WS_YB)
#define F_MERGED WSP(bf16, WS_MERGED)
#define F_H2 WSP(bf16, WS_H2)
#define F_HDN WSP(bf16, WS_HDN)
#define F_Y WSP(bf16, WS_Y)
#define F_TMP WSP(float, WS_TMP)
#define F_LTOK WSP(int, WS_LTOK)
#define F_LW WSP(float, WS_LW)
#define F_LRSTD WSP(float, WS_LRSTD)
#define F_TINFO WSP(int, WS_TINFO)

template <bool DUAL, class AF, class BF, class BF2, class EP>
__device__ __forceinline__ void ngemm(unsigned char* lds_, int tid, int M, int N, int K, int tile0, int tstride, AF af, BF bfn, BF2 bfn2, EP ep) {
    float* As = (float*)lds_;
    float* Bs = As + 16 * 132;
    float* Bs2 = Bs + 16 * 68;
    const int mt = (M + 127) / 128, nt = N / 64, ntile = mt * nt;
    const int ty = tid >> 4, tx = tid & 15;
    for (int L = tile0; L < ntile; L += tstride) {
        const int m0 = (L / nt) * 128, n0 = (L % nt) * 64;
        float acc[4][4], acc2[4][4];
#pragma unroll
        for (int i = 0; i < 4; ++i)
#pragma unroll
            for (int j = 0; j < 4; ++j) { acc[i][j] = 0.f; acc2[i][j] = 0.f; }
        for (int k0 = 0; k0 < K; k0 += 16) {
            __syncthreads();
#pragma unroll
            for (int i = 0; i < 4; ++i) { const int idx = tid * 4 + i, r = idx >> 4, kk = idx & 15; const int row = m0 + r; As[kk * 132 + r] = (row < M) ? af(row, k0 + kk) : 0.f; }
#pragma unroll
            for (int i = 0; i < 2; ++i) { const int idx = tid * 2 + i, kk = idx >> 6, n = idx & 63; Bs[kk * 68 + n] = bfn(k0 + kk, n0 + n); if (DUAL) Bs2[kk * 68 + n] = bfn2(k0 + kk, n0 + n); }
            __syncthreads();
#pragma unroll
            for (int kk = 0; kk < 16; ++kk) {
                const f32x4 a = *(const f32x4*)(As + kk * 132 + ty * 4), b = *(const f32x4*)(Bs + kk * 68 + tx * 4);
                f32x4 b2 = (f32x4){0.f, 0.f, 0.f, 0.f}; if (DUAL) b2 = *(const f32x4*)(Bs2 + kk * 68 + tx * 4);
#pragma unroll
                for (int i = 0; i < 4; ++i)
#pragma unroll
                    for (int j = 0; j < 4; ++j) { acc[i][j] += a[i] * b[j]; if (DUAL) acc2[i][j] += a[i] * b2[j]; }
            }
        }
#pragma unroll
        for (int i = 0; i < 4; ++i) { const int row = m0 + ty * 4 + i; if (row < M) {
#pragma unroll
            for (int j = 0; j < 4; ++j) ep(row, n0 + tx * 4 + j, acc[i][j], acc2[i][j]); } }
    }
    __syncthreads();
}

__device__ __forceinline__ void p0_prologue(Frame& F) {
    const int gw = F.bid * NWAVES + F.wave, NGW = F.G * NWAVES;
    for (int m = gw; m < T; m += NGW) {
        const f32x4* xr = (const f32x4*)(F_x + (size_t)m * D) + F.lane;
        f32x4 v[8]; float s = 0.f;
#pragma unroll
        for (int j = 0; j < 8; ++j) { v[j] = xr[64 * j]; s += (v[j].x * v[j].x + v[j].y * v[j].y) + (v[j].z * v[j].z + v[j].w * v[j].w); }
        const float rstd = rsqrtf(wave_sum(s) * (1.f / D) + EPS);
        u32x2* o = (u32x2*)(F_XN + (size_t)m * D) + F.lane;
#pragma unroll
        for (int j = 0; j < 8; ++j) { const f32x4 g = ((const f32x4*)F_g_mix)[64 * j + F.lane]; u32x2 w; w.x = pk2(v[j].x * rstd * g.x, v[j].y * rstd * g.y); w.y = pk2(v[j].z * rstd * g.z, v[j].w * rstd * g.w); o[64 * j] = w; }
    }
}

__device__ __forceinline__ float proj_act(int n, float a) {
    if (n < OFF_Q) return gelu_tanh(a);
    if (n < OFF_GA) return a;
    return sigmoidf_(a);
}
__device__ __forceinline__ void p1_proj(Frame& F) {
    const bf16* XN = F_XN; const float* W = F_w_in; bf16* P = F_PROJ;
    ngemm<false>(F.lds, F.tid, T, PW, D, F.bid, F.G,
        [=](int r, int k) { return bf2f(XN[(size_t)r * D + k]); },
        [=](int k, int n) { return W[(size_t)k * PW + n]; },
        [=](int k, int n) { return 0.f; },
        [=](int r, int n, float a, float) { P[(size_t)r * PW + n] = (bf16)f2bf(proj_act(n, a)); });
}

__device__ __forceinline__ void p2_gating(Frame& F) {
    float* vn = (float*)F.lds;
    float* wsm = vn + 128 * 128;
    float* st = wsm + 128 * 129;
    const int tid = F.tid;
    for (int item = F.bid; item < (T / CHK) * 8; item += F.G) {
        const int c = item >> 3, g = item & 7, t0 = c * CHK;
        __syncthreads();
        {
            const int r = tid >> 2, q = tid & 3; const bf16* row = F_PROJ + (size_t)(t0 + r) * PW + OFF_GV + q * 256;
            float s = 0.f, s2 = 0.f;
            for (int i = 0; i < 32; ++i) { const u32x4 w = ((const u32x4*)row)[i];
#pragma unroll
                for (int e = 0; e < 4; ++e) { const float a = __uint_as_float(w[e] << 16), b = __uint_as_float(w[e] & 0xffff0000u); s += a + b; s2 += a * a + b * b; } }
            s += __shfl_xor(s, 1); s += __shfl_xor(s, 2); s2 += __shfl_xor(s2, 1); s2 += __shfl_xor(s2, 2);
            const float mu = s * (1.f / AW), var = s2 * (1.f / AW) - mu * mu;
            if (q == 0) { st[r * 2] = mu; st[r * 2 + 1] = rsqrtf(fmaxf(var, 0.f) + EPS); }
        }
        for (int i = tid; i < 128 * 128; i += NTHR) { const int t = i >> 7, s = i & 127; wsm[t * 129 + s] = (s <= t) ? F_w_sp[(size_t)g * 16384 + i] : 0.f; }
        __syncthreads();
        for (int i = tid; i < 128 * 128; i += NTHR) { const int s = i >> 7, d = i & 127; const int ch = g * 128 + d;
            const float v = bf2f(F_PROJ[(size_t)(t0 + s) * PW + OFF_GV + ch]);
            vn[i] = (v - st[s * 2]) * st[s * 2 + 1] * F_ln_g[ch] + F_ln_b[ch]; }
        __syncthreads();
        {   const int t = tid >> 2, d0 = (tid & 3) * 32;
            float acc[32];
#pragma unroll
            for (int j = 0; j < 32; ++j) acc[j] = 0.f;
            for (int s = 0; s <= t; ++s) { const float w = wsm[t * 129 + s];
#pragma unroll
                for (int j = 0; j < 32; j += 4) { const f32x4 v = *(const f32x4*)(vn + s * 128 + d0 + j); acc[j] += w * v.x; acc[j + 1] += w * v.y; acc[j + 2] += w * v.z; acc[j + 3] += w * v.w; } }
            const float bb = F_b_sp[g * 128 + t];
            const bf16* urow = F_PROJ + (size_t)(t0 + t) * PW + OFF_U + g * 128 + d0; bf16* yrow = F_YA + (size_t)(t0 + t) * AW + g * 128 + d0;
#pragma unroll
            for (int j = 0; j < 32; ++j) yrow[j] = (bf16)f2bf(bf2f(urow[j]) * (acc[j] + bb));
        }
    }
    __syncthreads();
}

__device__ __forceinline__ void p2_attn(Frame& F) {
    float* qs = (float*)(F.lds) + F.wave * 128;
    const int gw = F.bid * NWAVES + F.wave, NGW = F.G * NWAVES, lane = F.lane;
    const float scale = 0.08838834764831845f;
    for (int item = gw; item < NH * T; item += NGW) {
        const int h = item / T, t = item % T;
        const bf16* qrow = F_PROJ + (size_t)t * PW + OFF_Q + h * HD;
        qs[lane] = bf2f(qrow[lane]) * scale; qs[lane + 64] = bf2f(qrow[lane + 64]) * scale;
        asm volatile("s_waitcnt lgkmcnt(0)" ::: "memory");
        float R = 1.f, o0 = 0.f, o1 = 0.f;
        const int nb = (t + 63) >> 6;
        for (int b = nb - 1; b >= 0; --b) {
            const int key = b * 64 + lane; const bool valid = key < t;
            const u32x4* krow = (const u32x4*)(F_PROJ + (size_t)key * PW + OFF_K + h * HD);
            float dot = 0.f;
#pragma unroll
            for (int c = 0; c < 16; ++c) { const u32x4 w = krow[c]; const f32x4 q0 = *(const f32x4*)(qs + c * 8), q1 = *(const f32x4*)(qs + c * 8 + 4);
                dot += __uint_as_float(w.x << 16) * q0.x + __uint_as_float(w.x & 0xffff0000u) * q0.y + __uint_as_float(w.y << 16) * q0.z + __uint_as_float(w.y & 0xffff0000u) * q0.w
                     + __uint_as_float(w.z << 16) * q1.x + __uint_as_float(w.z & 0xffff0000u) * q1.y + __uint_as_float(w.w << 16) * q1.z + __uint_as_float(w.w & 0xffff0000u) * q1.w; }
            const float z = fminf(dot, 80.f), e = __expf(z);
            float r = 1.0f / (1.0f + e), beta = e * r;
            if (!valid) { r = 1.f; beta = 0.f; }
            float s = r;
#pragma unroll
            for (int off = 1; off < 64; off <<= 1) { const float v = __shfl_down(s, off); if (lane + off < 64) s *= v; }
            float ex = __shfl_down(s, 1); if (lane == 63) ex = 1.f;
            const float w = beta * ex * R;
            R *= __shfl(s, 0);
            const bf16* vb = F_PROJ + (size_t)(b * 64) * PW + OFF_V + h * HD + lane;
            for (int j = 0; j < 64; ++j) { const float wj = __shfl(w, j); o0 += wj * bf2f(vb[(size_t)j * PW]); o1 += wj * bf2f(vb[(size_t)j * PW + 64]); }
            if (ATTN_EARLY_EXIT && R < 1e-30f) break;
        }
        bf16* yrow = F_YB + (size_t)t * AW + h * HD;
        yrow[lane] = (bf16)f2bf(o0); yrow[lane + 64] = (bf16)f2bf(o1);
    }
}

__device__ __forceinline__ void p3_branch(Frame& F) {
    const bf16 *YA = F_YA, *YB = F_YB, *P = F_PROJ; const float *Wa = F_w_a, *Wb = F_w_b; float* TMP = F_TMP; bf16* MG = F_MERGED;
    ngemm<false>(F.lds, F.tid, T, D, AW, F.bid, F.G,
        [=](int r, int k) { return bf2f(YA[(size_t)r * AW + k]); },
        [=](int k, int n) { return Wa[(size_t)k * D + n]; },
        [=](int k, int n) { return 0.f; },
        [=](int r, int n, float a, float) { TMP[(size_t)r * D + n] = a * bf2f(P[(size_t)r * PW + OFF_GA + n]); });
    ngemm<false>(F.lds, F.tid, T, D, AW, F.bid, F.G,
        [=](int r, int k) { return bf2f(YB[(size_t)r * AW + k]); },
        [=](int k, int n) { return Wb[(size_t)k * D + n]; },
        [=](int k, int n) { return 0.f; },
        [=](int r, int n, float a, float) { MG[(size_t)r * D + n] = (bf16)f2bf(TMP[(size_t)r * D + n] + a * bf2f(P[(size_t)r * PW + OFF_GB + n])); });
}

__device__ __forceinline__ void p4_out(Frame& F) {
    const bf16* MG = F_MERGED; const float *W = F_w_out, *x = F_x, *gf = F_g_ffn; float* X1 = F_out; bf16* H2 = F_H2;
    ngemm<false>(F.lds, F.tid, T, D, D, F.bid, F.G,
        [=](int r, int k) { return bf2f(MG[(size_t)r * D + k]); },
        [=](int k, int n) { return W[(size_t)k * D + n]; },
        [=](int k, int n) { return 0.f; },
        [=](int r, int n, float a, float) { const float v = x[(size_t)r * D + n] + a; X1[(size_t)r * D + n] = v; H2[(size_t)r * D + n] = (bf16)f2bf(v * gf[n]); });
}

__device__ __forceinline__ void route_token(Frame& F, int t, float logit, float rstd) {
    float lg[4], le[8];
#pragma unroll
    for (int i = 0; i < 4; ++i) lg[i] = __shfl(logit, 32 + i);
    int grp = 0; float m = lg[0];
#pragma unroll
    for (int i = 1; i < 4; ++i) if (lg[i] > m) { m = lg[i]; grp = i; }
    float ssum = 0.f;
#pragma unroll
    for (int i = 0; i < 4; ++i) ssum += __expf(lg[i] - m);
    const float pg = 1.0f / ssum;
#pragma unroll
    for (int i = 0; i < 8; ++i) le[i] = __shfl(logit, grp * 8 + i);
    int i1 = 0; float v1 = le[0];
#pragma unroll
    for (int i = 1; i < 8; ++i) if (le[i] > v1) { v1 = le[i]; i1 = i; }
    int i2 = -1; float v2 = -3.0e38f;
#pragma unroll
    for (int i = 0; i < 8; ++i) if (i != i1 && le[i] > v2) { v2 = le[i]; i2 = i; }
    const float ed = __expf(v2 - v1), pe1 = 1.0f / (1.0f + ed), pe2 = ed * pe1;
    if (F.lane == 0) {
        const int e0 = grp * 8 + i1, e1 = grp * 8 + i2;
        const int p0 = (int)atomicAdd(F_ctl + CW_CNT + e0, 1u), p1 = (int)atomicAdd(F_ctl + CW_CNT + e1, 1u);
        F_LTOK[e0 * T + p0] = t; F_LW[e0 * T + p0] = pg * pe1; F_LRSTD[e0 * T + p0] = rstd;
        F_LTOK[e1 * T + p1] = t; F_LW[e1 * T + p1] = pg * pe2; F_LRSTD[e1 * T + p1] = rstd;
        F_TINFO[t * 4 + 0] = e0; F_TINFO[t * 4 + 1] = e1; F_TINFO[t * 4 + 2] = p0; F_TINFO[t * 4 + 3] = p1;
    }
}
__device__ __forceinline__ void p5_router(Frame& F) {
    float* hs = (float*)F.lds + F.wave * 4096;
    const int gw = F.bid * NWAVES + F.wave, NGW = F.G * NWAVES, lane = F.lane;
    for (int tp = gw; tp < T / 2; tp += NGW) {
        float rstd[2];
#pragma unroll
        for (int tt = 0; tt < 2; ++tt) {
            const f32x4* xr = (const f32x4*)(F_out + (size_t)(tp * 2 + tt) * D) + lane; float s = 0.f;
#pragma unroll
            for (int j = 0; j < 8; ++j) { const f32x4 v = xr[64 * j], g = ((const f32x4*)F_g_ffn)[64 * j + lane]; s += (v.x * v.x + v.y * v.y) + (v.z * v.z + v.w * v.w);
                const int k = (64 * j + lane) * 4; hs[(k + 0) * 2 + tt] = v.x * g.x; hs[(k + 1) * 2 + tt] = v.y * g.y; hs[(k + 2) * 2 + tt] = v.z * g.z; hs[(k + 3) * 2 + tt] = v.w * g.w; }
            rstd[tt] = rsqrtf(wave_sum(s) * (1.f / D) + EPS);
        }
        asm volatile("s_waitcnt lgkmcnt(0)" ::: "memory");
        float a0 = 0.f, a1 = 0.f;
        const float* wp = (lane < 32) ? (F_w_re + lane) : (F_w_rg + ((lane - 32) & 3)); const int wst = (lane < 32) ? 32 : 4; const bool act = lane < 36;
#pragma unroll 8
        for (int k = 0; k < D; ++k) { const float w = act ? wp[(size_t)k * wst] : 0.f; const float h0 = hs[k * 2], h1 = hs[k * 2 + 1]; a0 += h0 * w; a1 += h1 * w; }
        const float bias = (lane < 32) ? F_b_re[lane] : (lane < 36 ? F_b_rg[lane - 32] : 0.f);
        route_token(F, tp * 2, a0 * rstd[0] + bias, rstd[0]);
        route_token(F, tp * 2 + 1, a1 * rstd[1] + bias, rstd[1]);
        asm volatile("s_waitcnt lgkmcnt(0)" ::: "memory");
    }
}

__device__ __forceinline__ void compute_pstart(Frame& F, int* ps) {
    __syncthreads();
    if (F.tid == 0) { int acc = 0; for (int e = 0; e < NE; ++e) { ps[e] = acc; const int c = (int)__hip_atomic_load(F_ctl + CW_CNT + e, __ATOMIC_RELAXED, __HIP_MEMORY_SCOPE_AGENT); acc += ((c + 255) >> 8) << 8; } ps[NE] = acc; }
    __syncthreads();
}

__device__ __forceinline__ void p6_gateup(Frame& F) {
    int* ps = (int*)(F.lds + 65536); compute_pstart(F, ps);
    const bf16* H2 = F_H2; bf16* HDN = F_HDN; int base = 0;
    for (int e = 0; e < NE; ++e) {
        const int cnt = (int)__hip_atomic_load(F_ctl + CW_CNT + e, __ATOMIC_RELAXED, __HIP_MEMORY_SCOPE_AGENT); const int ntile = ((cnt + 127) / 128) * (DE / 64);
        const int first = ((F.bid - base) % F.G + F.G) % F.G;
        const int* ltok = F_LTOK + e * T; const float* lr = F_LRSTD + e * T; const float *Wg = F_w_gate + (size_t)e * D * DE, *Wu = F_w_up + (size_t)e * D * DE; const int p0 = ps[e];
        ngemm<true>(F.lds, F.tid, cnt, DE, D, first, F.G,
            [=](int r, int k) { return bf2f(H2[(size_t)ltok[r] * D + k]); },
            [=](int k, int n) { return Wg[(size_t)k * DE + n]; },
            [=](int k, int n) { return Wu[(size_t)k * DE + n]; },
            [=](int r, int n, float g, float u) { const float rs = lr[r]; const float gg = g * rs; HDN[(size_t)(p0 + r) * DE + n] = (bf16)f2bf(gg * sigmoidf_(gg) * (u * rs)); });
        base += ntile;
    }
}
__device__ __forceinline__ void p7_down(Frame& F) {
    int* ps = (int*)(F.lds + 65536); compute_pstart(F, ps);
    const bf16* HDN = F_HDN; bf16* Y = F_Y; int base = 0;
    for (int e = 0; e < NE; ++e) {
        const int cnt = (int)__hip_atomic_load(F_ctl + CW_CNT + e, __ATOMIC_RELAXED, __HIP_MEMORY_SCOPE_AGENT); const int ntile = ((cnt + 127) / 128) * (D / 64);
        const int first = ((F.bid - base) % F.G + F.G) % F.G;
        const float* lw = F_LW + e * T; const float* Wd = F_w_down + (size_t)e * DE * D; const int p0 = ps[e];
        ngemm<false>(F.lds, F.tid, cnt, D, DE, first, F.G,
            [=](int r, int k) { return bf2f(HDN[(size_t)(p0 + r) * DE + k]); },
            [=](int k, int n) { return Wd[(size_t)k * D + n]; },
            [=](int k, int n) { return 0.f; },
            [=](int r, int n, float a, float) { Y[(size_t)(p0 + r) * D + n] = (bf16)f2bf(a * lw[r]); });
        base += ntile;
    }
}
__device__ __forceinline__ void p8_final(Frame& F) {
    int* ps = (int*)(F.lds + 65536); compute_pstart(F, ps);
    const int gw = F.bid * NWAVES + F.wave, NGW = F.G * NWAVES, lane = F.lane;
    for (int t = gw; t < T; t += NGW) {
        const int e0 = F_TINFO[t * 4], e1 = F_TINFO[t * 4 + 1], q0 = F_TINFO[t * 4 + 2], q1 = F_TINFO[t * 4 + 3];
        const u32x2* y0 = (const u32x2*)(F_Y + (size_t)(ps[e0] + q0) * D) + lane; const u32x2* y1 = (const u32x2*)(F_Y + (size_t)(ps[e1] + q1) * D) + lane;
        f32x4* xr = (f32x4*)(F_out + (size_t)t * D) + lane;
        f32x4 v[8]; float s = 0.f;
#pragma unroll
        for (int j = 0; j < 8; ++j) { v[j] = xr[64 * j]; const u32x2 a = y0[64 * j], b = y1[64 * j];
            v[j].x += __uint_as_float(a.x << 16) + __uint_as_float(b.x << 16); v[j].y += __uint_as_float(a.x & 0xffff0000u) + __uint_as_float(b.x & 0xffff0000u);
            v[j].z += __uint_as_float(a.y << 16) + __uint_as_float(b.y << 16); v[j].w += __uint_as_float(a.y & 0xffff0000u) + __uint_as_float(b.y & 0xffff0000u);
            s += (v[j].x * v[j].x + v[j].y * v[j].y) + (v[j].z * v[j].z + v[j].w * v[j].w); }
        const float rstd = rsqrtf(wave_sum(s) * (1.f / D) + EPS);
#pragma unroll
        for (int j = 0; j < 8; ++j) { const f32x4 g = ((const f32x4*)F_g_final)[64 * j + lane]; xr[64 * j] = (f32x4){v[j].x * rstd * g.x, v[j].y * rstd * g.y, v[j].z * rstd * g.z, v[j].w * rstd * g.w}; }
    }
}

__global__ void __launch_bounds__(NTHR, 2) fwd_kernel(Args args) {
    extern __shared__ __attribute__((aligned(16))) unsigned char lds[];
    cg::grid_group grid = cg::this_grid();
    Frame F;
    F.lds = lds; F.tid = threadIdx.x; F.lane = F.tid & 63; F.wave = __builtin_amdgcn_readfirstlane(F.tid >> 6); F.G = gridDim.x; F.bid = blockIdx.x; F.A = &args;
    const int lo = args.ph_lo, hi = args.ph_hi;
#define IN(k) (lo <= (k) && (k) < hi)
#define SEAM(k) do { if (IN(k) && IN((k) + 1)) grid.sync(); } while (0)
    if (IN(0)) { p0_prologue(F); } SEAM(0);
    if (IN(1)) { p1_proj(F); } SEAM(1);
    if (IN(2)) { p2_gating(F); p2_attn(F); } SEAM(2);
    if (IN(3)) { p3_branch(F); } SEAM(3);
    if (IN(4)) { p4_out(F); } SEAM(4);
    if (IN(5)) { p5_router(F); } SEAM(5);
    if (IN(6)) { p6_gateup(F); } SEAM(6);
    if (IN(7)) { p7_down(F); } SEAM(7);
    if (IN(8)) { p8_final(F); }
#undef IN
#undef SEAM
}

extern "C" void kernel_launch(void* const* d_in, const int* in_sizes, int n_in, void* d_out, int out_size, void* d_ws, size_t ws_size, hipStream_t stream) {
    static int grid = 0;
    if (grid == 0) {
        if (n_in != 19 || out_size != T * D || ws_size < WS_END) { fprintf(stderr, "kernel_launch: unexpected problem (n_in %d out %d ws %zu)\n", n_in, out_size, ws_size); grid = -1; return; }
        int dev = 0, cus = 0, per_cu = 0;
        hipGetDevice(&dev); hipDeviceGetAttribute(&cus, hipDeviceAttributeMultiprocessorCount, dev);
        if (hipFuncSetAttribute((const void*)fwd_kernel, hipFuncAttributeMaxDynamicSharedMemorySize, LDS_BYTES) != hipSuccess) { fprintf(stderr, "kernel_launch: hipFuncSetAttribute failed\n"); grid = -1; return; }
        if (hipOccupancyMaxActiveBlocksPerMultiprocessor(&per_cu, (const void*)fwd_kernel, NTHR, LDS_BYTES) != hipSuccess || per_cu < 1) { fprintf(stderr, "kernel_launch: occupancy query says %d\n", per_cu); per_cu = 1; }
        (void)hipGetLastError();
        grid = cus;
    }
    if (grid < 0) return;
    hipMemsetAsync((char*)d_ws + WS_CTL, 0, CTL_ZERO_BYTES, stream);
    Args a{};
    for (int i = 0; i < 19; ++i) a.in[i] = (const float*)d_in[i];
    a.out = (float*)d_out; a.ws = (unsigned char*)d_ws;
    if (N_LAUNCH_MODE == 1) {
        a.ph_lo = 0; a.ph_hi = N_PHASES; void* kargs[] = {&a};
        hipError_t e = hipLaunchCooperativeKernel((const void*)fwd_kernel, dim3(grid), dim3(NTHR), kargs, LDS_BYTES, stream);
        if (e != hipSuccess) fprintf(stderr, "cooperative launch failed: %s\n", hipGetErrorString(e));
    } else {
        for (int p = 0; p < N_PHASES; ++p) {
            a.ph_lo = p; a.ph_hi = p + 1; void* kargs[] = {&a};
            hipError_t e = hipLaunchCooperativeKernel((const void*)fwd_kernel, dim3(grid), dim3(NTHR), kargs, LDS_BYTES, stream);
            if (e != hipSuccess) { fprintf(stderr, "cooperative launch %d failed: %s\n", p, hipGetErrorString(e)); break; }
        }
    }
}
```

```cpp
#include <hip/hip_runtime.h>
#include <hip/hip_cooperative_groups.h>
#include <cstdio>
#include <cstdint>
namespace cg = cooperative_groups;

#ifndef N_LAUNCH_MODE
#define N_LAUNCH_MODE 1
#endif
#ifndef ATTN_EARLY_EXIT
#define ATTN_EARLY_EXIT 0
#endif

constexpr int T = 8192, D = 2048, PW = 9216, AW = 1024, NH = 8, HD = 128, CHK = 128, NGRP = 4, EPG = 8, NE = 32, DE = 1024;
constexpr int OFF_U = 0, OFF_GV = 1024, OFF_Q = 2048, OFF_K = 3072, OFF_V = 4096, OFF_GA = 5120, OFF_GB = 7168;
constexpr float EPS = 1e-6f;
constexpr int NWAVES = 8, NTHR = 512;
constexpr int N_PHASES = 9;

constexpr size_t MiB = 1u << 20;
constexpr size_t WS_CTL = 0, CTL_ZERO_BYTES = 1 * MiB;
constexpr size_t WS_LTOK = 1 * MiB, WS_LW = 2 * MiB, WS_LRSTD = 3 * MiB, WS_TINFO = 4 * MiB;
constexpr size_t WS_WIN_T = 8 * MiB, WS_WA_T = 44 * MiB, WS_WB_T = 48 * MiB, WS_WOUT_T = 52 * MiB, WS_WGU_T = 64 * MiB, WS_WD_T = 320 * MiB;
constexpr size_t WS_XN = 448 * MiB, WS_PROJ = 480 * MiB, WS_YA = 624 * MiB, WS_YB = 640 * MiB, WS_MERGED = 656 * MiB, WS_H2 = 688 * MiB;
constexpr size_t WS_HDN = 720 * MiB, WS_Y = 768 * MiB, WS_TMP = 864 * MiB, WS_END = 928 * MiB;
constexpr int SLOT_CAP = 24576;
constexpr int CW_CNT = 0;

constexpr int LDS_BYTES = 147456;

#define LAS __attribute__((address_space(3)))
typedef unsigned short bf16;
typedef float f32x4 __attribute__((ext_vector_type(4)));
typedef unsigned u32x4 __attribute__((ext_vector_type(4)));
typedef unsigned u32x2 __attribute__((ext_vector_type(2)));

__device__ __forceinline__ float bf2f(bf16 v) { return __uint_as_float((unsigned)v << 16); }
__device__ __forceinline__ unsigned f2bf(float f) { unsigned u = __float_as_uint(f); return (u + 0x7fffu + ((u >> 16) & 1u)) >> 16; }
__device__ __forceinline__ unsigned pk2(float lo, float hi) { return f2bf(lo) | (f2bf(hi) << 16); }
__device__ __forceinline__ float wave_sum(float v) {
#pragma unroll
    for (int o = 1; o < 64; o <<= 1) v += __shfl_xor(v, o);
    return v;
}
__device__ __forceinline__ float sigmoidf_(float x) { return 1.0f / (1.0f + __expf(-x)); }
__device__ __forceinline__ float gelu_tanh(float x) { const float y = 0.7978845608028654f * (x + 0.044715f * x * x * x); return x / (1.0f + __expf(-2.0f * y)); }

struct Args { const float* in[19]; float* out; unsigned char* ws; int ph_lo, ph_hi; };

struct Frame {
    unsigned char* lds;
    int tid, lane, wave, G, bid;
    const Args* A;
};
#define IN_(i) (F.A->in[i])
#define F_x IN_(0)
#define F_g_mix IN_(1)
#define F_w_in IN_(2)
#define F_ln_g IN_(3)
#define F_ln_b IN_(4)
#define F_w_sp IN_(5)
#define F_b_sp IN_(6)
#define F_w_a IN_(7)
#define F_w_b IN_(8)
#define F_w_out IN_(9)
#define F_g_ffn IN_(10)
#define F_w_rg IN_(11)
#define F_b_rg IN_(12)
#define F_w_re IN_(13)
#define F_b_re IN_(14)
#define F_w_gate IN_(15)
#define F_w_up IN_(16)
#define F_w_down IN_(17)
#define F_g_final IN_(18)
#define F_out (F.A->out)
#define WSP(type, off) ((type*)(F.A->ws + (off)))
#define F_ctl WSP(unsigned, WS_CTL)
#define F_XN WSP(bf16, WS_XN)
#define F_PROJ WSP(bf16, WS_PROJ)
#define F_YA WSP(bf16, WS_YA)
#define F_YB WSP(bf16, WS_YB)
#define F_MERGED WSP(bf16, WS_MERGED)
#define F_H2 WSP(bf16, WS_H2)
#define F_HDN WSP(bf16, WS_HDN)
#define F_Y WSP(bf16, WS_Y)
#define F_TMP WSP(float, WS_TMP)
#define F_LTOK WSP(int, WS_LTOK)
#define F_LW WSP(float, WS_LW)
#define F_LRSTD WSP(float, WS_LRSTD)
#define F_TINFO WSP(int, WS_TINFO)

template <bool DUAL, class AF, class BF, class BF2, class EP>
__device__ __forceinline__ void ngemm(unsigned char* lds_, int tid, int M, int N, int K, int tile0, int tstride, AF af, BF bfn, BF2 bfn2, EP ep) {
    float* As = (float*)lds_;
    float* Bs = As + 16 * 132;
    float* Bs2 = Bs + 16 * 68;
    const int mt = (M + 127) / 128, nt = N / 64, ntile = mt * nt;
    const int ty = tid >> 4, tx = tid & 15;
    for (int L = tile0; L < ntile; L += tstride) {
        const int m0 = (L / nt) * 128, n0 = (L % nt) * 64;
        float acc[4][4], acc2[4][4];
#pragma unroll
        for (int i = 0; i < 4; ++i)
#pragma unroll
            for (int j = 0; j < 4; ++j) { acc[i][j] = 0.f; acc2[i][j] = 0.f; }
        for (int k0 = 0; k0 < K; k0 += 16) {
            __syncthreads();
#pragma unroll
            for (int i = 0; i < 4; ++i) { const int idx = tid * 4 + i, r = idx >> 4, kk = idx & 15; const int row = m0 + r; As[kk * 132 + r] = (row < M) ? af(row, k0 + kk) : 0.f; }
#pragma unroll
            for (int i = 0; i < 2; ++i) { const int idx = tid * 2 + i, kk = idx >> 6, n = idx & 63; Bs[kk * 68 + n] = bfn(k0 + kk, n0 + n); if (DUAL) Bs2[kk * 68 + n] = bfn2(k0 + kk, n0 + n); }
            __syncthreads();
#pragma unroll
            for (int kk = 0; kk < 16; ++kk) {
                const f32x4 a = *(const f32x4*)(As + kk * 132 + ty * 4), b = *(const f32x4*)(Bs + kk * 68 + tx * 4);
                f32x4 b2 = (f32x4){0.f, 0.f, 0.f, 0.f}; if (DUAL) b2 = *(const f32x4*)(Bs2 + kk * 68 + tx * 4);
#pragma unroll
                for (int i = 0; i < 4; ++i)
#pragma unroll
                    for (int j = 0; j < 4; ++j) { acc[i][j] += a[i] * b[j]; if (DUAL) acc2[i][j] += a[i] * b2[j]; }
            }
        }
#pragma unroll
        for (int i = 0; i < 4; ++i) { const int row = m0 + ty * 4 + i; if (row < M) {
#pragma unroll
            for (int j = 0; j < 4; ++j) ep(row, n0 + tx * 4 + j, acc[i][j], acc2[i][j]); } }
    }
    __syncthreads();
}

__device__ __forceinline__ void p0_prologue(Frame& F) {
    const int gw = F.bid * NWAVES + F.wave, NGW = F.G * NWAVES;
    for (int m = gw; m < T; m += NGW) {
        const f32x4* xr = (const f32x4*)(F_x + (size_t)m * D) + F.lane;
        f32x4 v[8]; float s = 0.f;
#pragma unroll
        for (int j = 0; j < 8; ++j) { v[j] = xr[64 * j]; s += (v[j].x * v[j].x + v[j].y * v[j].y) + (v[j].z * v[j].z + v[j].w * v[j].w); }
        const float rstd = rsqrtf(wave_sum(s) * (1.f / D) + EPS);
        u32x2* o = (u32x2*)(F_XN + (size_t)m * D) + F.lane;
#pragma unroll
        for (int j = 0; j < 8; ++j) { const f32x4 g = ((const f32x4*)F_g_mix)[64 * j + F.lane]; u32x2 w; w.x = pk2(v[j].x * rstd * g.x, v[j].y * rstd * g.y); w.y = pk2(v[j].z * rstd * g.z, v[j].w * rstd * g.w); o[64 * j] = w; }
    }
}

__device__ __forceinline__ float proj_act(int n, float a) {
    if (n < OFF_Q) return gelu_tanh(a);
    if (n < OFF_GA) return a;
    return sigmoidf_(a);
}
__device__ __forceinline__ void p1_proj(Frame& F) {
    const bf16* XN = F_XN; const float* W = F_w_in; bf16* P = F_PROJ;
    ngemm<false>(F.lds, F.tid, T, PW, D, F.bid, F.G,
        [=](int r, int k) { return bf2f(XN[(size_t)r * D + k]); },
        [=](int k, int n) { return W[(size_t)k * PW + n]; },
        [=](int k, int n) { return 0.f; },
        [=](int r, int n, float a, float) { P[(size_t)r * PW + n] = (bf16)f2bf(proj_act(n, a)); });
}

__device__ __forceinline__ void p2_gating(Frame& F) {
    float* vn = (float*)F.lds;
    float* wsm = vn + 128 * 128;
    float* st = wsm + 128 * 129;
    const int tid = F.tid;
    for (int item = F.bid; item < (T / CHK) * 8; item += F.G) {
        const int c = item >> 3, g = item & 7, t0 = c * CHK;
        __syncthreads();
        {
            const int r = tid >> 2, q = tid & 3; const bf16* row = F_PROJ + (size_t)(t0 + r) * PW + OFF_GV + q * 256;
            float s = 0.f, s2 = 0.f;
            for (int i = 0; i < 32; ++i) { const u32x4 w = ((const u32x4*)row)[i];
#pragma unroll
                for (int e = 0; e < 4; ++e) { const float a = __uint_as_float(w[e] << 16), b = __uint_as_float(w[e] & 0xffff0000u); s += a + b; s2 += a * a + b * b; } }
            s += __shfl_xor(s, 1); s += __shfl_xor(s, 2); s2 += __shfl_xor(s2, 1); s2 += __shfl_xor(s2, 2);
            const float mu = s * (1.f / AW), var = s2 * (1.f / AW) - mu * mu;
            if (q == 0) { st[r * 2] = mu; st[r * 2 + 1] = rsqrtf(fmaxf(var, 0.f) + EPS); }
        }
        for (int i = tid; i < 128 * 128; i += NTHR) { const int t = i >> 7, s = i & 127; wsm[t * 129 + s] = (s <= t) ? F_w_sp[(size_t)g * 16384 + i] : 0.f; }
        __syncthreads();
        for (int i = tid; i < 128 * 128; i += NTHR) { const int s = i >> 7, d = i & 127; const int ch = g * 128 + d;
            const float v = bf2f(F_PROJ[(size_t)(t0 + s) * PW + OFF_GV + ch]);
            vn[i] = (v - st[s * 2]) * st[s * 2 + 1] * F_ln_g[ch] + F_ln_b[ch]; }
        __syncthreads();
        {   const int t = tid >> 2, d0 = (tid & 3) * 32;
            float acc[32];
#pragma unroll
            for (int j = 0; j < 32; ++j) acc[j] = 0.f;
            for (int s = 0; s <= t; ++s) { const float w = wsm[t * 129 + s];
#pragma unroll
                for (int j = 0; j < 32; j += 4) { const f32x4 v = *(const f32x4*)(vn + s * 128 + d0 + j); acc[j] += w * v.x; acc[j + 1] += w * v.y; acc[j + 2] += w * v.z; acc[j + 3] += w * v.w; } }
            const float bb = F_b_sp[g * 128 + t];
            const bf16* urow = F_PROJ + (size_t)(t0 + t) * PW + OFF_U + g * 128 + d0; bf16* yrow = F_YA + (size_t)(t0 + t) * AW + g * 128 + d0;
#pragma unroll
            for (int j = 0; j < 32; ++j) yrow[j] = (bf16)f2bf(bf2f(urow[j]) * (acc[j] + bb));
        }
    }
    __syncthreads();
}

__device__ __forceinline__ void p2_attn(Frame& F) {
    float* qs = (float*)(F.lds) + F.wave * 128;
    const int gw = F.bid * NWAVES + F.wave, NGW = F.G * NWAVES, lane = F.lane;
    const float scale = 0.08838834764831845f;
    for (int item = gw; item < NH * T; item += NGW) {
        const int h = item / T, t = item % T;
        const bf16* qrow = F_PROJ + (size_t)t * PW + OFF_Q + h * HD;
        qs[lane] = bf2f(qrow[lane]) * scale; qs[lane + 64] = bf2f(qrow[lane + 64]) * scale;
        asm volatile("s_waitcnt lgkmcnt(0)" ::: "memory");
        float R = 1.f, o0 = 0.f, o1 = 0.f;
        const int nb = (t + 63) >> 6;
        for (int b = nb - 1; b >= 0; --b) {
            const int key = b * 64 + lane; const bool valid = key < t;
            const u32x4* krow = (const u32x4*)(F_PROJ + (size_t)key * PW + OFF_K + h * HD);
            float dot = 0.f;
#pragma unroll
            for (int c = 0; c < 16; ++c) { const u32x4 w = krow[c]; const f32x4 q0 = *(const f32x4*)(qs + c * 8), q1 = *(const f32x4*)(qs + c * 8 + 4);
                dot += __uint_as_float(w.x << 16) * q0.x + __uint_as_float(w.x & 0xffff0000u) * q0.y + __uint_as_float(w.y << 16) * q0.z + __uint_as_float(w.y & 0xffff0000u) * q0.w
                     + __uint_as_float(w.z << 16) * q1.x + __uint_as_float(w.z & 0xffff0000u) * q1.y + __uint_as_float(w.w << 16) * q1.z + __uint_as_float(w.w & 0xffff0000u) * q1.w; }
            const float z = fminf(dot, 80.f), e = __expf(z);
            float r = 1.0f / (1.0f + e), beta = e * r;
            if (!valid) { r = 1.f; beta = 0.f; }
            float s = r;
#pragma unroll
            for (int off = 1; off < 64; off <<= 1) { const float v = __shfl_down(s, off); if (lane + off < 64) s *= v; }
            float ex = __shfl_down(s, 1); if (lane == 63) ex = 1.f;
            const float w = beta * ex * R;
            R *= __shfl(s, 0);
            const bf16* vb = F_PROJ + (size_t)(b * 64) * PW + OFF_V + h * HD + lane;
            for (int j = 0; j < 64; ++j) { const float wj = __shfl(w, j); o0 += wj * bf2f(vb[(size_t)j * PW]); o1 += wj * bf2f(vb[(size_t)j * PW + 64]); }
            if (ATTN_EARLY_EXIT && R < 1e-30f) break;
        }
        bf16* yrow = F_YB + (size_t)t * AW + h * HD;
        yrow[lane] = (bf16)f2bf(o0); yrow[lane + 64] = (bf16)f2bf(o1);
    }
}

__device__ __forceinline__ void p3_branch(Frame& F) {
    const bf16 *YA = F_YA, *YB = F_YB, *P = F_PROJ; const float *Wa = F_w_a, *Wb = F_w_b; float* TMP = F_TMP; bf16* MG = F_MERGED;
    ngemm<false>(F.lds, F.tid, T, D, AW, F.bid, F.G,
        [=](int r, int k) { return bf2f(YA[(size_t)r * AW + k]); },
        [=](int k, int n) { return Wa[(size_t)k * D + n]; },
        [=](int k, int n) { return 0.f; },
        [=](int r, int n, float a, float) { TMP[(size_t)r * D + n] = a * bf2f(P[(size_t)r * PW + OFF_GA + n]); });
    ngemm<false>(F.lds, F.tid, T, D, AW, F.bid, F.G,
        [=](int r, int k) { return bf2f(YB[(size_t)r * AW + k]); },
        [=](int k, int n) { return Wb[(size_t)k * D + n]; },
        [=](int k, int n) { return 0.f; },
        [=](int r, int n, float a, float) { MG[(size_t)r * D + n] = (bf16)f2bf(TMP[(size_t)r * D + n] + a * bf2f(P[(size_t)r * PW + OFF_GB + n])); });
}

__device__ __forceinline__ void p4_out(Frame& F) {
    const bf16* MG = F_MERGED; const float *W = F_w_out, *x = F_x, *gf = F_g_ffn; float* X1 = F_out; bf16* H2 = F_H2;
    ngemm<false>(F.lds, F.tid, T, D, D, F.bid, F.G,
        [=](int r, int k) { return bf2f(MG[(size_t)r * D + k]); },
        [=](int k, int n) { return W[(size_t)k * D + n]; },
        [=](int k, int n) { return 0.f; },
        [=](int r, int n, float a, float) { const float v = x[(size_t)r * D + n] + a; X1[(size_t)r * D + n] = v; H2[(size_t)r * D + n] = (bf16)f2bf(v * gf[n]); });
}

__device__ __forceinline__ void route_token(Frame& F, int t, float logit, float rstd) {
    float lg[4], le[8];
#pragma unroll
    for (int i = 0; i < 4; ++i) lg[i] = __shfl(logit, 32 + i);
    int grp = 0; float m = lg[0];
#pragma unroll
    for (int i = 1; i < 4; ++i) if (lg[i] > m) { m = lg[i]; grp = i; }
    float ssum = 0.f;
#pragma unroll
    for (int i = 0; i < 4; ++i) ssum += __expf(lg[i] - m);
    const float pg = 1.0f / ssum;
#pragma unroll
    for (int i = 0; i < 8; ++i) le[i] = __shfl(logit, grp * 8 + i);
    int i1 = 0; float v1 = le[0];
#pragma unroll
    for (int i = 1; i < 8; ++i) if (le[i] > v1) { v1 = le[i]; i1 = i; }
    int i2 = -1; float v2 = -3.0e38f;
#pragma unroll
    for (int i = 0; i < 8; ++i) if (i != i1 && le[i] > v2) { v2 = le[i]; i2 = i; }
    const float ed = __expf(v2 - v1), pe1 = 1.0f / (1.0f + ed), pe2 = ed * pe1;
    if (F.lane == 0) {
        const int e0 = grp * 8 + i1, e1 = grp * 8 + i2;
        const int p0 = (int)atomicAdd(F_ctl + CW_CNT + e0, 1u), p1 = (int)atomicAdd(F_ctl + CW_CNT + e1, 1u);
        F_LTOK[e0 * T + p0] = t; F_LW[e0 * T + p0] = pg * pe1; F_LRSTD[e0 * T + p0] = rstd;
        F_LTOK[e1 * T + p1] = t; F_LW[e1 * T + p1] = pg * pe2; F_LRSTD[e1 * T + p1] = rstd;
        F_TINFO[t * 4 + 0] = e0; F_TINFO[t * 4 + 1] = e1; F_TINFO[t * 4 + 2] = p0; F_TINFO[t * 4 + 3] = p1;
    }
}
__device__ __forceinline__ void p5_router(Frame& F) {
    float* hs = (float*)F.lds + F.wave * 4096;
    const int gw = F.bid * NWAVES + F.wave, NGW = F.G * NWAVES, lane = F.lane;
    for (int tp = gw; tp < T / 2; tp += NGW) {
        float rstd[2];
#pragma unroll
        for (int tt = 0; tt < 2; ++tt) {
            const f32x4* xr = (const f32x4*)(F_out + (size_t)(tp * 2 + tt) * D) + lane; float s = 0.f;
#pragma unroll
            for (int j = 0; j < 8; ++j) { const f32x4 v = xr[64 * j], g = ((const f32x4*)F_g_ffn)[64 * j + lane]; s += (v.x * v.x + v.y * v.y) + (v.z * v.z + v.w * v.w);
                const int k = (64 * j + lane) * 4; hs[(k + 0) * 2 + tt] = v.x * g.x; hs[(k + 1) * 2 + tt] = v.y * g.y; hs[(k + 2) * 2 + tt] = v.z * g.z; hs[(k + 3) * 2 + tt] = v.w * g.w; }
            rstd[tt] = rsqrtf(wave_sum(s) * (1.f / D) + EPS);
        }
        asm volatile("s_waitcnt lgkmcnt(0)" ::: "memory");
        float a0 = 0.f, a1 = 0.f;
        const float* wp = (lane < 32) ? (F_w_re + lane) : (F_w_rg + ((lane - 32) & 3)); const int wst = (lane < 32) ? 32 : 4; const bool act = lane < 36;
#pragma unroll 8
        for (int k = 0; k < D; ++k) { const float w = act ? wp[(size_t)k * wst] : 0.f; const float h0 = hs[k * 2], h1 = hs[k * 2 + 1]; a0 += h0 * w; a1 += h1 * w; }
        const float bias = (lane < 32) ? F_b_re[lane] : (lane < 36 ? F_b_rg[lane - 32] : 0.f);
        route_token(F, tp * 2, a0 * rstd[0] + bias, rstd[0]);
        route_token(F, tp * 2 + 1, a1 * rstd[1] + bias, rstd[1]);
        asm volatile("s_waitcnt lgkmcnt(0)" ::: "memory");
    }
}

__device__ __forceinline__ void compute_pstart(Frame& F, int* ps) {
    __syncthreads();
    if (F.tid == 0) { int acc = 0; for (int e = 0; e < NE; ++e) { ps[e] = acc; const int c = (int)__hip_atomic_load(F_ctl + CW_CNT + e, __ATOMIC_RELAXED, __HIP_MEMORY_SCOPE_AGENT); acc += ((c + 255) >> 8) << 8; } ps[NE] = acc; }
    __syncthreads();
}

__device__ __forceinline__ void p6_gateup(Frame& F) {
    int* ps = (int*)(F.lds + 65536); compute_pstart(F, ps);
    const bf16* H2 = F_H2; bf16* HDN = F_HDN; int base = 0;
    for (int e = 0; e < NE; ++e) {
        const int cnt = (int)__hip_atomic_load(F_ctl + CW_CNT + e, __ATOMIC_RELAXED, __HIP_MEMORY_SCOPE_AGENT); const int ntile = ((cnt + 127) / 128) * (DE / 64);
        const int first = ((F.bid - base) % F.G + F.G) % F.G;
        const int* ltok = F_LTOK + e * T; const float* lr = F_LRSTD + e * T; const float *Wg = F_w_gate + (size_t)e * D * DE, *Wu = F_w_up + (size_t)e * D * DE; const int p0 = ps[e];
        ngemm<true>(F.lds, F.tid, cnt, DE, D, first, F.G,
            [=](int r, int k) { return bf2f(H2[(size_t)ltok[r] * D + k]); },
            [=](int k, int n) { return Wg[(size_t)k * DE + n]; },
            [=](int k, int n) { return Wu[(size_t)k * DE + n]; },
            [=](int r, int n, float g, float u) { const float rs = lr[r]; const float gg = g * rs; HDN[(size_t)(p0 + r) * DE + n] = (bf16)f2bf(gg * sigmoidf_(gg) * (u * rs)); });
        base += ntile;
    }
}
__device__ __forceinline__ void p7_down(Frame& F) {
    int* ps = (int*)(F.lds + 65536); compute_pstart(F, ps);
    const bf16* HDN = F_HDN; bf16* Y = F_Y; int base = 0;
    for (int e = 0; e < NE; ++e) {
        const int cnt = (int)__hip_atomic_load(F_ctl + CW_CNT + e, __ATOMIC_RELAXED, __HIP_MEMORY_SCOPE_AGENT); const int ntile = ((cnt + 127) / 128) * (D / 64);
        const int first = ((F.bid - base) % F.G + F.G) % F.G;
        const float* lw = F_LW + e * T; const float* Wd = F_w_down + (size_t)e * DE * D; const int p0 = ps[e];
        ngemm<false>(F.lds, F.tid, cnt, D, DE, first, F.G,
            [=](int r, int k) { return bf2f(HDN[(size_t)(p0 + r) * DE + k]); },
            [=](int k, int n) { return Wd[(size_t)k * D + n]; },
            [=](int k, int n) { return 0.f; },
            [=](int r, int n, float a, float) { Y[(size_t)(p0 + r) * D + n] = (bf16)f2bf(a * lw[r]); });
        base += ntile;
    }
}
__device__ __forceinline__ void p8_final(Frame& F) {
    int* ps = (int*)(F.lds + 65536); compute_pstart(F, ps);
    const int gw = F.bid * NWAVES + F.wave, NGW = F.G * NWAVES, lane = F.lane;
    for (int t = gw; t < T; t += NGW) {
        const int e0 = F_TINFO[t * 4], e1 = F_TINFO[t * 4 + 1], q0 = F_TINFO[t * 4 + 2], q1 = F_TINFO[t * 4 + 3];
        const u32x2* y0 = (const u32x2*)(F_Y + (size_t)(ps[e0] + q0) * D) + lane; const u32x2* y1 = (const u32x2*)(F_Y + (size_t)(ps[e1] + q1) * D) + lane;
        f32x4* xr = (f32x4*)(F_out + (size_t)t * D) + lane;
        f32x4 v[8]; float s = 0.f;
#pragma unroll
        for (int j = 0; j < 8; ++j) { v[j] = xr[64 * j]; const u32x2 a = y0[64 * j], b = y1[64 * j];
            v[j].x += __uint_as_float(a.x << 16) + __uint_as_float(b.x << 16); v[j].y += __uint_as_float(a.x & 0xffff0000u) + __uint_as_float(b.x & 0xffff0000u);
            v[j].z += __uint_as_float(a.y << 16) + __uint_as_float(b.y << 16); v[j].w += __uint_as_float(a.y & 0xffff0000u) + __uint_as_float(b.y & 0xffff0000u);
            s += (v[j].x * v[j].x + v[j].y * v[j].y) + (v[j].z * v[j].z + v[j].w * v[j].w); }
        const float rstd = rsqrtf(wave_sum(s) * (1.f / D) + EPS);
#pragma unroll
        for (int j = 0; j < 8; ++j) { const f32x4 g = ((const f32x4*)F_g_final)[64 * j + lane]; xr[64 * j] = (f32x4){v[j].x * rstd * g.x, v[j].y * rstd * g.y, v[j].z * rstd * g.z, v[j].w * rstd * g.w}; }
    }
}

__global__ void __launch_bounds__(NTHR, 2) fwd_kernel(Args args) {
    extern __shared__ __attribute__((aligned(16))) unsigned char lds[];
    cg::grid_group grid = cg::this_grid();
    Frame F;
    F.lds = lds; F.tid = threadIdx.x; F.lane = F.tid & 63; F.wave = __builtin_amdgcn_readfirstlane(F.tid >> 6); F.G = gridDim.x; F.bid = blockIdx.x; F.A = &args;
    const int lo = args.ph_lo, hi = args.ph_hi;
#define IN(k) (lo <= (k) && (k) < hi)
#define SEAM(k) do { if (IN(k) && IN((k) + 1)) grid.sync(); } while (0)
    if (IN(0)) { p0_prologue(F); } SEAM(0);
    if (IN(1)) { p1_proj(F); } SEAM(1);
    if (IN(2)) { p2_gating(F); p2_attn(F); } SEAM(2);
    if (IN(3)) { p3_branch(F); } SEAM(3);
    if (IN(4)) { p4_out(F); } SEAM(4);
    if (IN(5)) { p5_router(F); } SEAM(5);
    if (IN(6)) { p6_gateup(F); } SEAM(6);
    if (IN(7)) { p7_down(F); } SEAM(7);
    if (IN(8)) { p8_final(F); }
#undef IN
#undef SEAM
}

extern "C" void kernel_launch(void* const* d_in, const int* in_sizes, int n_in, void* d_out, int out_size, void* d_ws, size_t ws_size, hipStream_t stream) {
    static int grid = 0;
    if (grid == 0) {
        if (n_in != 19 || out_size != T * D || ws_size < WS_END) { fprintf(stderr, "kernel_launch: unexpected problem (n_in %d out %d ws %zu)\n", n_in, out_size, ws_size); grid = -1; return; }
        int dev = 0, cus = 0, per_cu = 0;
        hipGetDevice(&dev); hipDeviceGetAttribute(&cus, hipDeviceAttributeMultiprocessorCount, dev);
        if (hipFuncSetAttribute((const void*)fwd_kernel, hipFuncAttributeMaxDynamicSharedMemorySize, LDS_BYTES) != hipSuccess) { fprintf(stderr, "kernel_launch: hipFuncSetAttribute failed\n"); grid = -1; return; }
        if (hipOccupancyMaxActiveBlocksPerMultiprocessor(&per_cu, (const void*)fwd_kernel, NTHR, LDS_BYTES) != hipSuccess || per_cu < 1) { fprintf(stderr, "kernel_launch: occupancy query says %d\n", per_cu); per_cu = 1; }
        (void)hipGetLastError();
        grid = cus;
    }
    if (grid < 0) return;
    hipMemsetAsync((char*)d_ws + WS_CTL, 0, CTL_ZERO_BYTES, stream);
    Args a{};
    for (int i = 0; i < 19; ++i) a.in[i] = (const float*)d_in[i];
    a.out = (float*)d_out; a.ws = (unsigned char*)d_ws;
    if (N_LAUNCH_MODE == 1) {
        a.ph_lo = 0; a.ph_hi = N_PHASES; void* kargs[] = {&a};
        hipError_t e = hipLaunchCooperativeKernel((const void*)fwd_kernel, dim3(grid), dim3(NTHR), kargs, LDS_BYTES, stream);
        if (e != hipSuccess) fprintf(stderr, "cooperative launch failed: %s\n", hipGetErrorString(e));
    } else {
        for (int p = 0; p < N_PHASES; ++p) {
            a.ph_lo = p; a.ph_hi = p + 1; void* kargs[] = {&a};
            hipError_t e = hipLaunchCooperativeKernel((const void*)fwd_kernel, dim3(grid), dim3(NTHR), kargs, LDS_BYTES, stream);
            if (e != hipSuccess) { fprintf(stderr, "cooperative launch %d failed: %s\n", p, hipGetErrorString(e)); break; }
        }
    }
}
```

```cpp
#include <hip/hip_runtime.h>
#include <hip/hip_cooperative_groups.h>
#include <cstdio>
#include <cstdint>
namespace cg = cooperative_groups;

#ifndef N_LAUNCH_MODE
#define N_LAUNCH_MODE 1
#endif
#ifndef MFMA_MASK
#define MFMA_MASK 0x1f
#endif
#ifndef ATTN_MFMA
#define ATTN_MFMA 1
#endif
#ifndef ROUTER_MFMA
#define ROUTER_MFMA 2
#endif
#ifndef XCD_BARRIER
#define XCD_BARRIER 1
#endif
#ifndef GATING_MFMA
#define GATING_MFMA 1
#endif
#ifndef OVERLAP_CONV
#define OVERLAP_CONV 1
#endif
#ifndef CONV_CUS
#define CONV_CUS 112
#endif
#ifndef MOE_EARLY_DOWN
#define MOE_EARLY_DOWN 1
#endif
#ifndef EARLY_GATING
#define EARLY_GATING 1
#endif
#ifndef USE_CG_SEAMS
#define USE_CG_SEAMS 0
#endif
#ifndef PROBE_REPEAT
#define PROBE_REPEAT 0
#endif
#ifndef ATTN_EARLY_EXIT
#define GELU_U_LATE ((MFMA_MASK & 1) != 0)
#define WT_STORES 1
#define ATTN_EARLY_EXIT 1
#endif

constexpr int T = 8192, D = 2048, PW = 9216, AW = 1024, NH = 8, HD = 128, CHK = 128, NGRP = 4, EPG = 8, NE = 32, DE = 1024;
constexpr int OFF_U = 0, OFF_GV = 1024, OFF_Q = 2048, OFF_K = 3072, OFF_V = 4096, OFF_GA = 5120, OFF_GB = 7168;
constexpr float EPS = 1e-6f;
constexpr int NWAVES = 8, NTHR = 512;
constexpr int N_PHASES = 9;

constexpr size_t MiB = 1u << 20;
constexpr size_t WS_CTL = 0, CTL_ZERO_BYTES = 65536;
constexpr size_t WS_LTOK = 1 * MiB, WS_LW = 2 * MiB, WS_LRSTD = 3 * MiB, WS_TINFO = 4 * MiB;
constexpr size_t WS_WRH = 5 * MiB, WS_WRL = 5 * MiB + 262144;
constexpr size_t WS_WIN_T = 8 * MiB, WS_WA_T = 44 * MiB, WS_WB_T = 48 * MiB, WS_WOUT_T = 52 * MiB, WS_WGU_T = 64 * MiB, WS_WD_T = 320 * MiB;
constexpr size_t WS_XN = 448 * MiB, WS_PROJ = 480 * MiB, WS_YA = 624 * MiB, WS_YB = 640 * MiB, WS_MERGED = 656 * MiB, WS_H2 = 688 * MiB;
constexpr size_t WS_HDN = 720 * MiB, WS_Y = 768 * MiB, WS_TMP = 864 * MiB, WS_END = 928 * MiB;
constexpr int SLOT_CAP = 24576;
constexpr int CW_CNT = 1024, CNT_STRIDE = 64;

constexpr int LDS_BYTES = 147456;

#define LAS __attribute__((address_space(3)))
typedef unsigned short bf16;
typedef float f32x4 __attribute__((ext_vector_type(4)));
typedef unsigned u32x4 __attribute__((ext_vector_type(4)));
typedef unsigned u32x2 __attribute__((ext_vector_type(2)));

__device__ __forceinline__ float bf2f(bf16 v) { return __uint_as_float((unsigned)v << 16); }
__device__ __forceinline__ unsigned f2bf(float f) { unsigned u = __float_as_uint(f); return (u + 0x7fffu + ((u >> 16) & 1u)) >> 16; }
__device__ __forceinline__ unsigned pk2(float lo, float hi) { return f2bf(lo) | (f2bf(hi) << 16); }
__device__ __forceinline__ float wave_sum(float v) {
#pragma unroll
    for (int o = 1; o < 64; o <<= 1) v += __shfl_xor(v, o);
    return v;
}
__device__ __forceinline__ float sigmoidf_(float x) { return __builtin_amdgcn_rcpf(1.0f + __builtin_amdgcn_exp2f(fmaxf(x * -1.4426950408889634f, -126.f) )); }
__device__ __forceinline__ float gelu_tanh(float x) { const float x2 = x * x; const float t = x * (-2.302208198f - 0.1029432397f * x2); return x * __builtin_amdgcn_rcpf(1.0f + __builtin_amdgcn_exp2f(fminf(t, 126.f))); }

struct Args { const float* in[19]; float* out; unsigned char* ws; int ph_lo, ph_hi; int use_cg, pad; };

struct Frame {
    unsigned char* lds;
    int tid, lane, wave, G, bid;
    const Args* A;
};
#define IN_(i) (F.A->in[i])
#define F_x IN_(0)
#define F_g_mix IN_(1)
#define F_w_in IN_(2)
#define F_ln_g IN_(3)
#define F_ln_b IN_(4)
#define F_w_sp IN_(5)
#define F_b_sp IN_(6)
#define F_w_a IN_(7)
#define F_w_b IN_(8)
#define F_w_out IN_(9)
#define F_g_ffn IN_(10)
#define F_w_rg IN_(11)
#define F_b_rg IN_(12)
#define F_w_re IN_(13)
#define F_b_re IN_(14)
#define F_w_gate IN_(15)
#define F_w_up IN_(16)
#define F_w_down IN_(17)
#define F_g_final IN_(18)
#define F_out (F.A->out)
#define WSP(type, off) ((type*)(F.A->ws + (off)))
#define F_ctl WSP(unsigned, WS_CTL)
#define F_XN WSP(bf16, WS_XN)
#define F_PROJ WSP(bf16, WS_PROJ)
#define F_YA WSP(bf16, WS_YA)
#define F_YB WSP(bf16, WS_YB)
#define F_MERGED WSP(bf16, WS_MERGED)
#define F_H2 WSP(bf16, WS_H2)
#define F_HDN WSP(bf16, WS_HDN)
#define F_Y WSP(bf16, WS_Y)
#define F_TMP WSP(float, WS_TMP)
#define F_LTOK WSP(int, WS_LTOK)
#define F_LW WSP(float, WS_LW)
#define F_LRSTD WSP(float, WS_LRSTD)
#define F_TINFO WSP(int, WS_TINFO)

template <bool DUAL, class AF, class BF, class BF2, class EP>
__device__ __forceinline__ void ngemm(unsigned char* lds_, int tid, int M, int N, int K, int tile0, int tstride, AF af, BF bfn, BF2 bfn2, EP ep) {
    float* As = (float*)lds_;
    float* Bs = As + 16 * 132;
    float* Bs2 = Bs + 16 * 68;
    const int mt = (M + 127) / 128, nt = N / 64, ntile = mt * nt;
    const int ty = tid >> 4, tx = tid & 15;
    for (int L = tile0; L < ntile; L += tstride) {
        const int m0 = (L / nt) * 128, n0 = (L % nt) * 64;
        float acc[4][4], acc2[4][4];
#pragma unroll
        for (int i = 0; i < 4; ++i)
#pragma unroll
            for (int j = 0; j < 4; ++j) { acc[i][j] = 0.f; acc2[i][j] = 0.f; }
        for (int k0 = 0; k0 < K; k0 += 16) {
            __syncthreads();
#pragma unroll
            for (int i = 0; i < 4; ++i) { const int idx = tid * 4 + i, r = idx >> 4, kk = idx & 15; const int row = m0 + r; As[kk * 132 + r] = (row < M) ? af(row, k0 + kk) : 0.f; }
#pragma unroll
            for (int i = 0; i < 2; ++i) { const int idx = tid * 2 + i, kk = idx >> 6, n = idx & 63; Bs[kk * 68 + n] = bfn(k0 + kk, n0 + n); if (DUAL) Bs2[kk * 68 + n] = bfn2(k0 + kk, n0 + n); }
            __syncthreads();
#pragma unroll
            for (int kk = 0; kk < 16; ++kk) {
                const f32x4 a = *(const f32x4*)(As + kk * 132 + ty * 4), b = *(const f32x4*)(Bs + kk * 68 + tx * 4);
                f32x4 b2 = (f32x4){0.f, 0.f, 0.f, 0.f}; if (DUAL) b2 = *(const f32x4*)(Bs2 + kk * 68 + tx * 4);
#pragma unroll
                for (int i = 0; i < 4; ++i)
#pragma unroll
                    for (int j = 0; j < 4; ++j) { acc[i][j] += a[i] * b[j]; if (DUAL) acc2[i][j] += a[i] * b2[j]; }
            }
        }
#pragma unroll
        for (int i = 0; i < 4; ++i) { const int row = m0 + ty * 4 + i; if (row < M) {
#pragma unroll
            for (int j = 0; j < 4; ++j) ep(row, n0 + tx * 4 + j, acc[i][j], acc2[i][j]); } }
    }
    __syncthreads();
}

__device__ __forceinline__ void p0_prologue(Frame& F) {
    const int gw = F.bid * NWAVES + F.wave, NGW = F.G * NWAVES;
    for (int g = F.bid * NTHR + F.tid; g < 3 * NE * T / 4; g += F.G * NTHR) ((u32x4*)F_LTOK)[g] = (u32x4){0u, 0u, 0u, 0u};
    for (int m = gw; m < T; m += NGW) {
        const f32x4* xr = (const f32x4*)(F_x + (size_t)m * D) + F.lane;
        f32x4 v[8]; float s = 0.f;
#pragma unroll
        for (int j = 0; j < 8; ++j) { v[j] = xr[64 * j]; s += (v[j].x * v[j].x + v[j].y * v[j].y) + (v[j].z * v[j].z + v[j].w * v[j].w); }
        const float rstd = rsqrtf(wave_sum(s) * (1.f / D) + EPS);
        u32x2* o = (u32x2*)(F_XN + (size_t)m * D) + F.lane;
#pragma unroll
        for (int j = 0; j < 8; ++j) { const f32x4 g = ((const f32x4*)F_g_mix)[64 * j + F.lane]; u32x2 w; w.x = pk2(v[j].x * rstd * g.x, v[j].y * rstd * g.y); w.y = pk2(v[j].z * rstd * g.z, v[j].w * rstd * g.w); o[64 * j] = w; }
    }
}

__device__ __forceinline__ float proj_act(int n, float a) {
    if (n < OFF_Q) return gelu_tanh(a);
    if (n < OFF_GA) return a;
    return sigmoidf_(a);
}
__device__ __forceinline__ void p1_proj(Frame& F) {
    const bf16* XN = F_XN; const float* W = F_w_in; bf16* P = F_PROJ;
    ngemm<false>(F.lds, F.tid, T, PW, D, F.bid, F.G,
        [=](int r, int k) { return bf2f(XN[(size_t)r * D + k]); },
        [=](int k, int n) { return W[(size_t)k * PW + n]; },
        [=](int k, int n) { return 0.f; },
        [=](int r, int n, float a, float) { P[(size_t)r * PW + n] = (bf16)f2bf(proj_act(n, a)); });
}

__device__ __forceinline__ void p2_gating(Frame& F) {
    float* vn = (float*)F.lds;
    float* wsm = vn + 128 * 128;
    float* st = wsm + 128 * 129;
    const int tid = F.tid;
    for (int item = F.bid; item < (T / CHK) * 8; item += F.G) {
        const int c = item >> 3, g = item & 7, t0 = c * CHK;
        __syncthreads();
        {
            const int r = tid >> 2, q = tid & 3; const bf16* row = F_PROJ + (size_t)(t0 + r) * PW + OFF_GV + q * 256;
            float s = 0.f, s2 = 0.f;
            for (int i = 0; i < 32; ++i) { const u32x4 w = ((const u32x4*)row)[i];
#pragma unroll
                for (int e = 0; e < 4; ++e) { const float a = __uint_as_float(w[e] << 16), b = __uint_as_float(w[e] & 0xffff0000u); s += a + b; s2 += a * a + b * b; } }
            s += __shfl_xor(s, 1); s += __shfl_xor(s, 2); s2 += __shfl_xor(s2, 1); s2 += __shfl_xor(s2, 2);
            const float mu = s * (1.f / AW), var = s2 * (1.f / AW) - mu * mu;
            if (q == 0) { st[r * 2] = mu; st[r * 2 + 1] = rsqrtf(fmaxf(var, 0.f) + EPS); }
        }
        for (int i = tid; i < 128 * 128; i += NTHR) { const int t = i >> 7, s = i & 127; wsm[t * 129 + s] = (s <= t) ? F_w_sp[(size_t)g * 16384 + i] : 0.f; }
        __syncthreads();
        for (int i = tid; i < 128 * 128; i += NTHR) { const int s = i >> 7, d = i & 127; const int ch = g * 128 + d;
            const float v = bf2f(F_PROJ[(size_t)(t0 + s) * PW + OFF_GV + ch]);
            vn[i] = (v - st[s * 2]) * st[s * 2 + 1] * F_ln_g[ch] + F_ln_b[ch]; }
        __syncthreads();
        {   const int t = tid >> 2, d0 = (tid & 3) * 32;
            float acc[32];
#pragma unroll
            for (int j = 0; j < 32; ++j) acc[j] = 0.f;
            for (int s = 0; s <= t; ++s) { const float w = wsm[t * 129 + s];
#pragma unroll
                for (int j = 0; j < 32; j += 4) { const f32x4 v = *(const f32x4*)(vn + s * 128 + d0 + j); acc[j] += w * v.x; acc[j + 1] += w * v.y; acc[j + 2] += w * v.z; acc[j + 3] += w * v.w; } }
            const float bb = F_b_sp[g * 128 + t];
            const bf16* urow = F_PROJ + (size_t)(t0 + t) * PW + OFF_U + g * 128 + d0; bf16* yrow = F_YA + (size_t)(t0 + t) * AW + g * 128 + d0;
#pragma unroll
            for (int j = 0; j < 32; ++j) { const float uu = bf2f(urow[j]); yrow[j] = (bf16)f2bf((GELU_U_LATE ? gelu_tanh(uu) : uu) * (acc[j] + bb)); }
        }
    }
    __syncthreads();
}

__device__ __forceinline__ void p2_attn(Frame& F) {
    float* qs = (float*)(F.lds) + F.wave * 128;
    const int gw = F.bid * NWAVES + F.wave, NGW = F.G * NWAVES, lane = F.lane;
    const float scale = 0.08838834764831845f;
    for (int item = gw; item < NH * T; item += NGW) {
        const int h = item / T, t = item % T;
        const bf16* qrow = F_PROJ + (size_t)t * PW + OFF_Q + h * HD;
        qs[lane] = bf2f(qrow[lane]) * scale; qs[lane + 64] = bf2f(qrow[lane + 64]) * scale;
        asm volatile("s_waitcnt lgkmcnt(0)" ::: "memory");
        float R = 1.f, o0 = 0.f, o1 = 0.f;
        const int nb = (t + 63) >> 6;
        for (int b = nb - 1; b >= 0; --b) {
            const int key = b * 64 + lane; const bool valid = key < t;
            const u32x4* krow = (const u32x4*)(F_PROJ + (size_t)key * PW + OFF_K + h * HD);
            float dot = 0.f;
#pragma unroll
            for (int c = 0; c < 16; ++c) { const u32x4 w = krow[c]; const f32x4 q0 = *(const f32x4*)(qs + c * 8), q1 = *(const f32x4*)(qs + c * 8 + 4);
                dot += __uint_as_float(w.x << 16) * q0.x + __uint_as_float(w.x & 0xffff0000u) * q0.y + __uint_as_float(w.y << 16) * q0.z + __uint_as_float(w.y & 0xffff0000u) * q0.w
                     + __uint_as_float(w.z << 16) * q1.x + __uint_as_float(w.z & 0xffff0000u) * q1.y + __uint_as_float(w.w << 16) * q1.z + __uint_as_float(w.w & 0xffff0000u) * q1.w; }
            const float z = fminf(dot, 80.f), e = __expf(z);
            float r = 1.0f / (1.0f + e), beta = e * r;
            if (!valid) { r = 1.f; beta = 0.f; }
            float s = r;
#pragma unroll
            for (int off = 1; off < 64; off <<= 1) { const float v = __shfl_down(s, off); if (lane + off < 64) s *= v; }
            float ex = __shfl_down(s, 1); if (lane == 63) ex = 1.f;
            const float w = beta * ex * R;
            R *= __shfl(s, 0);
            const bf16* vb = F_PROJ + (size_t)(b * 64) * PW + OFF_V + h * HD + lane;
            for (int j = 0; j < 64; ++j) { const float wj = __shfl(w, j); o0 += wj * bf2f(vb[(size_t)j * PW]); o1 += wj * bf2f(vb[(size_t)j * PW + 64]); }
            if (ATTN_EARLY_EXIT && R < 1e-30f) break;
        }
        bf16* yrow = F_YB + (size_t)t * AW + h * HD;
        yrow[lane] = (bf16)f2bf(o0); yrow[lane + 64] = (bf16)f2bf(o1);
    }
}

__device__ __forceinline__ void p3_branch(Frame& F) {
    const bf16 *YA = F_YA, *YB = F_YB, *P = F_PROJ; const float *Wa = F_w_a, *Wb = F_w_b; float* TMP = F_TMP; bf16* MG = F_MERGED;
    ngemm<false>(F.lds, F.tid, T, D, AW, F.bid, F.G,
        [=](int r, int k) { return bf2f(YA[(size_t)r * AW + k]); },
        [=](int k, int n) { return Wa[(size_t)k * D + n]; },
        [=](int k, int n) { return 0.f; },
        [=](int r, int n, float a, float) { TMP[(size_t)r * D + n] = a * bf2f(P[(size_t)r * PW + OFF_GA + n]); });
    ngemm<false>(F.lds, F.tid, T, D, AW, F.bid, F.G,
        [=](int r, int k) { return bf2f(YB[(size_t)r * AW + k]); },
        [=](int k, int n) { return Wb[(size_t)k * D + n]; },
        [=](int k, int n) { return 0.f; },
        [=](int r, int n, float a, float) { MG[(size_t)r * D + n] = (bf16)f2bf(TMP[(size_t)r * D + n] + a * bf2f(P[(size_t)r * PW + OFF_GB + n])); });
}

__device__ __forceinline__ void p4_out(Frame& F) {
    const bf16* MG = F_MERGED; const float *W = F_w_out, *x = F_x, *gf = F_g_ffn; float* X1 = F_out; bf16* H2 = F_H2;
    ngemm<false>(F.lds, F.tid, T, D, D, F.bid, F.G,
        [=](int r, int k) { return bf2f(MG[(size_t)r * D + k]); },
        [=](int k, int n) { return W[(size_t)k * D + n]; },
        [=](int k, int n) { return 0.f; },
        [=](int r, int n, float a, float) { const float v = x[(size_t)r * D + n] + a; X1[(size_t)r * D + n] = v; H2[(size_t)r * D + n] = (bf16)f2bf(v * gf[n]); });
}

__device__ __forceinline__ void route_token(Frame& F, int t, float logit, float rstd) {
    float lg[4], le[8];
#pragma unroll
    for (int i = 0; i < 4; ++i) lg[i] = __shfl(logit, 32 + i);
    int grp = 0; float m = lg[0];
#pragma unroll
    for (int i = 1; i < 4; ++i) if (lg[i] > m) { m = lg[i]; grp = i; }
    float ssum = 0.f;
#pragma unroll
    for (int i = 0; i < 4; ++i) ssum += __expf(lg[i] - m);
    const float pg = 1.0f / ssum;
#pragma unroll
    for (int i = 0; i < 8; ++i) le[i] = __shfl(logit, grp * 8 + i);
    int i1 = 0; float v1 = le[0];
#pragma unroll
    for (int i = 1; i < 8; ++i) if (le[i] > v1) { v1 = le[i]; i1 = i; }
    int i2 = -1; float v2 = -3.0e38f;
#pragma unroll
    for (int i = 0; i < 8; ++i) if (i != i1 && le[i] > v2) { v2 = le[i]; i2 = i; }
    const float ed = __expf(v2 - v1), pe1 = 1.0f / (1.0f + ed), pe2 = ed * pe1;
    if (F.lane == 0) {
        const int e0 = grp * 8 + i1, e1 = grp * 8 + i2;
        const int p0 = (int)atomicAdd(F_ctl + CW_CNT + CNT_STRIDE * e0, 1u), p1 = (int)atomicAdd(F_ctl + CW_CNT + CNT_STRIDE * e1, 1u);
        F_LTOK[e0 * T + p0] = t; F_LW[e0 * T + p0] = pg * pe1; F_LRSTD[e0 * T + p0] = rstd;
        F_LTOK[e1 * T + p1] = t; F_LW[e1 * T + p1] = pg * pe2; F_LRSTD[e1 * T + p1] = rstd;
        F_TINFO[t * 4 + 0] = e0; F_TINFO[t * 4 + 1] = e1; F_TINFO[t * 4 + 2] = p0; F_TINFO[t * 4 + 3] = p1;
    }
}
__device__ __forceinline__ void p5_router(Frame& F) {
    float* hs = (float*)F.lds + F.wave * 4096;
    const int gw = F.bid * NWAVES + F.wave, NGW = F.G * NWAVES, lane = F.lane;
    for (int tp = gw; tp < T / 2; tp += NGW) {
        float rstd[2];
#pragma unroll
        for (int tt = 0; tt < 2; ++tt) {
            const f32x4* xr = (const f32x4*)(F_out + (size_t)(tp * 2 + tt) * D) + lane; float s = 0.f;
#pragma unroll
            for (int j = 0; j < 8; ++j) { const f32x4 v = xr[64 * j], g = ((const f32x4*)F_g_ffn)[64 * j + lane]; s += (v.x * v.x + v.y * v.y) + (v.z * v.z + v.w * v.w);
                const int k = (64 * j + lane) * 4; hs[(k + 0) * 2 + tt] = v.x * g.x; hs[(k + 1) * 2 + tt] = v.y * g.y; hs[(k + 2) * 2 + tt] = v.z * g.z; hs[(k + 3) * 2 + tt] = v.w * g.w; }
            rstd[tt] = rsqrtf(wave_sum(s) * (1.f / D) + EPS);
        }
        asm volatile("s_waitcnt lgkmcnt(0)" ::: "memory");
        float a0 = 0.f, a1 = 0.f;
        const float* wp = (lane < 32) ? (F_w_re + lane) : (F_w_rg + ((lane - 32) & 3)); const int wst = (lane < 32) ? 32 : 4; const bool act = lane < 36;
#pragma unroll 8
        for (int k = 0; k < D; ++k) { const float w = act ? wp[(size_t)k * wst] : 0.f; const float h0 = hs[k * 2], h1 = hs[k * 2 + 1]; a0 += h0 * w; a1 += h1 * w; }
        const float bias = (lane < 32) ? F_b_re[lane] : (lane < 36 ? F_b_rg[lane - 32] : 0.f);
        route_token(F, tp * 2, a0 * rstd[0] + bias, rstd[0]);
        route_token(F, tp * 2 + 1, a1 * rstd[1] + bias, rstd[1]);
        asm volatile("s_waitcnt lgkmcnt(0)" ::: "memory");
    }
}

__device__ __forceinline__ void compute_pstart(Frame& F, int* ps) {
    __syncthreads();
    if (F.tid < NE) ps[40 + F.tid] = (int)__hip_atomic_load(F_ctl + CW_CNT + CNT_STRIDE * F.tid, __ATOMIC_RELAXED, __HIP_MEMORY_SCOPE_AGENT);
    __syncthreads();
    if (F.tid == 0) { int acc = 0; for (int e = 0; e < NE; ++e) { ps[e] = acc; const int c = ps[40 + e]; acc += ((c + 255) >> 8) << 8; } ps[NE] = acc; }
    __syncthreads();
}

__device__ __forceinline__ void p6_gateup(Frame& F) {
    int* ps = (int*)(F.lds + 65536); compute_pstart(F, ps);
    const bf16* H2 = F_H2; bf16* HDN = F_HDN; int base = 0;
    for (int e = 0; e < NE; ++e) {
        const int cnt = (int)__hip_atomic_load(F_ctl + CW_CNT + CNT_STRIDE * e, __ATOMIC_RELAXED, __HIP_MEMORY_SCOPE_AGENT); const int ntile = ((cnt + 127) / 128) * (DE / 64);
        const int first = ((F.bid - base) % F.G + F.G) % F.G;
        const int* ltok = F_LTOK + e * T; const float* lr = F_LRSTD + e * T; const float *Wg = F_w_gate + (size_t)e * D * DE, *Wu = F_w_up + (size_t)e * D * DE; const int p0 = ps[e];
        ngemm<true>(F.lds, F.tid, cnt, DE, D, first, F.G,
            [=](int r, int k) { return bf2f(H2[(size_t)ltok[r] * D + k]); },
            [=](int k, int n) { return Wg[(size_t)k * DE + n]; },
            [=](int k, int n) { return Wu[(size_t)k * DE + n]; },
            [=](int r, int n, float g, float u) { const float rs = lr[r]; const float gg = g * rs; HDN[(size_t)(p0 + r) * DE + n] = (bf16)f2bf(gg * sigmoidf_(gg) * (u * rs)); });
        base += ntile;
    }
}
__device__ __forceinline__ void p7_down(Frame& F) {
    int* ps = (int*)(F.lds + 65536); compute_pstart(F, ps);
    const bf16* HDN = F_HDN; bf16* Y = F_Y; int base = 0;
    for (int e = 0; e < NE; ++e) {
        const int cnt = (int)__hip_atomic_load(F_ctl + CW_CNT + CNT_STRIDE * e, __ATOMIC_RELAXED, __HIP_MEMORY_SCOPE_AGENT); const int ntile = ((cnt + 127) / 128) * (D / 64);
        const int first = ((F.bid - base) % F.G + F.G) % F.G;
        const float* lw = F_LW + e * T; const float* Wd = F_w_down + (size_t)e * DE * D; const int p0 = ps[e];
        ngemm<false>(F.lds, F.tid, cnt, D, DE, first, F.G,
            [=](int r, int k) { return bf2f(HDN[(size_t)(p0 + r) * DE + k]); },
            [=](int k, int n) { return Wd[(size_t)k * D + n]; },
            [=](int k, int n) { return 0.f; },
            [=](int r, int n, float a, float) { Y[(size_t)(p0 + r) * D + n] = (bf16)f2bf(a * lw[r]); });
        base += ntile;
    }
}
__device__ __forceinline__ void p8_final(Frame& F, bool have_tab) {
    int* ps = (int*)(F.lds + 65536); if (have_tab) ps = (int*)(F.lds + 131072 + 2048); else compute_pstart(F, ps);
    const int gw = F.bid * NWAVES + F.wave, NGW = F.G * NWAVES, lane = F.lane;
    for (int t = gw; t < T; t += NGW) {
        const int e0 = F_TINFO[t * 4], e1 = F_TINFO[t * 4 + 1], q0 = F_TINFO[t * 4 + 2], q1 = F_TINFO[t * 4 + 3];
        const u32x2* y0 = (const u32x2*)(F_Y + (size_t)(ps[e0] + q0) * D) + lane; const u32x2* y1 = (const u32x2*)(F_Y + (size_t)(ps[e1] + q1) * D) + lane;
        f32x4* xr = (f32x4*)(F_out + (size_t)t * D) + lane;
        f32x4 v[8]; float s = 0.f;
#pragma unroll
        for (int j = 0; j < 8; ++j) { v[j] = xr[64 * j]; const u32x2 a = y0[64 * j], b = y1[64 * j];
            v[j].x += __uint_as_float(a.x << 16) + __uint_as_float(b.x << 16); v[j].y += __uint_as_float(a.x & 0xffff0000u) + __uint_as_float(b.x & 0xffff0000u);
            v[j].z += __uint_as_float(a.y << 16) + __uint_as_float(b.y << 16); v[j].w += __uint_as_float(a.y & 0xffff0000u) + __uint_as_float(b.y & 0xffff0000u);
            s += (v[j].x * v[j].x + v[j].y * v[j].y) + (v[j].z * v[j].z + v[j].w * v[j].w); }
        const float rstd = rsqrtf(wave_sum(s) * (1.f / D) + EPS);
#pragma unroll
        for (int j = 0; j < 8; ++j) { const f32x4 g = ((const f32x4*)F_g_final)[64 * j + lane]; xr[64 * j] = (f32x4){v[j].x * rstd * g.x, v[j].y * rstd * g.y, v[j].z * rstd * g.z, v[j].w * rstd * g.w}; }
    }
}


namespace pg8 {
typedef short bf16x8 __attribute__((ext_vector_type(8)));
constexpr int BM = 256, BK = 64, HALF = 128, HTB = HALF * BK * 2, STAGE_BYTES = 8 * HTB, NXCD = 8, WGM = 8;
constexpr int GTAB_OFF = STAGE_BYTES;
constexpr int RTAB_OFF = 131072 + 8192;
__host__ __device__ __forceinline__ int lds_byte(int r, int c) { const int st = (r >> 4) * 2 + (c >> 5), rr = r & 15, cc = c & 31, ob = rr * 64 + cc * 2; return st * 1024 + (ob ^ (((ob >> 9) & 1) << 5)); }
__host__ __device__ __forceinline__ void stage_rc(int b, int& R, int& C) { const int st = b / 1024, sb = b % 1024, swz = sb ^ (((sb >> 9) & 1) << 5); R = (st >> 1) * 16 + swz / 64; C = (st & 1) * 32 + (swz % 64) / 2; }
__host__ __device__ __forceinline__ int perm32(int rho) { const int n = rho >> 4, i = rho & 15; return 8 * (i >> 2) + 4 * n + (i & 3); }

struct Unit { const char* A; const char* B; int pm, pn, e, aux, ti; };

struct TileOrder {
    int nM, nN, nwg, G, c;
    __device__ void init(int M, int N, int G_, int c_) { nM = M / BM; nN = N / BM; nwg = nM * nN; G = G_; c = c_; }
    __device__ bool tile(int i, int& pm, int& pn) const {
        const long L = (long)i * G + c; if (L >= nwg) return false;
        int wgid = (int)L; { const int q = nwg / NXCD, r = nwg % NXCD, xcd = wgid % NXCD, off = wgid / NXCD; wgid = (xcd < r ? xcd * (q + 1) : r * (q + 1) + (xcd - r) * q) + off; }
        const int nig = WGM * nN, gid = wgid / nig, fm = gid * WGM, gsz = (nM - fm) < WGM ? (nM - fm) : WGM;
        pm = fm + ((wgid % nig) % gsz); pn = (wgid % nig) / gsz; return true;
    }
};
__device__ __forceinline__ unsigned cvt_pk_bf16(float lo, float hi) { unsigned r; asm volatile("v_cvt_pk_bf16_f32 %0, %1, %2" : "=v"(r) : "v"(lo), "v"(hi)); return r; }

template <class Epi, class Sched, bool GATHER, bool ALIGN_EPI, bool SP2, bool DYN = false>
__device__ __forceinline__ void gemm_phase(LAS unsigned char* lds, const int K, const Sched& S, const Epi& E) {
    static_assert(!(DYN && GATHER), "dynamic order + gather not combined");
    static_assert(SP2, "only the SP2 loop is kept here");
    const int tid = threadIdx.x, wid = __builtin_amdgcn_readfirstlane(tid >> 6), lane = tid & 63, wr = wid >> 2, wc = wid & 3, fr = lane & 15, fq = lane >> 4;
    const int nt = K / BK;
    unsigned voffA[2], voffB[2]; int gR[2], gC[2];
#pragma unroll
    for (int i = 0; i < 2; ++i) { int R, C; stage_rc(tid * 16 + i * 8192, R, C); const int Rb = Epi::PERM ? ((R & ~31) + perm32(R & 31)) : R;
        voffA[i] = (unsigned)(R * K + C) * 2u; voffB[i] = (unsigned)(Rb * K + C) * 2u; gR[i] = R * 4; gC[i] = C * 2; }
    const size_t kstep = (size_t)(BK * 2);
    const size_t hstep = (size_t)HALF * K * 2;
    const unsigned ldsw = (unsigned)wid * 1024u;
    const int aoff = lds_byte(wr * 64 + fr, fq * 8), boff = lds_byte(wc * 32 + fr, fq * 8);
#define PG8_SA(b, h) (((b) * 2 + (h)) * HTB)
#define PG8_SB(b, h) ((4 + (b) * 2 + (h)) * HTB)
#define PG8_STAGE(bufoff, gbase, voff) do { _Pragma("unroll") for (int _i = 0; _i < 2; ++_i) \
        __builtin_amdgcn_global_load_lds((const unsigned*)((const char*)(gbase) + (voff)[_i]), (LAS unsigned*)(lds + (bufoff) + ldsw + _i * 8192), 16, 0, 0); } while (0)
#define PG8_STAGE_A(b, h, gbase, par) do { if constexpr (GATHER) { _Pragma("unroll") for (int _i = 0; _i < 2; ++_i) { \
            const unsigned _o = (unsigned)*(const LAS int*)(lds + GTAB_OFF + (par) * 1024 + (h) * 512 + gR[_i]) * (unsigned)(K * 2) + (unsigned)gC[_i]; \
            __builtin_amdgcn_global_load_lds((const unsigned*)((const char*)(gbase) + _o), (LAS unsigned*)(lds + PG8_SA(b, h) + ldsw + _i * 8192), 16, 0, 0); } } \
        else { PG8_STAGE(PG8_SA(b, h), (gbase) + (h) * hstep, voffA); } } while (0)
#define PG8_LDA(dst, b, h) do { _Pragma("unroll") for (int m = 0; m < 4; ++m) _Pragma("unroll") for (int k = 0; k < 2; ++k) dst[m][k] = *(const LAS bf16x8*)(lds + PG8_SA(b, h) + aoff + m * 2048 + k * 1024); } while (0)
#define PG8_LDB(dst, b, h) do { _Pragma("unroll") for (int n = 0; n < 2; ++n) _Pragma("unroll") for (int k = 0; k < 2; ++k) dst[n][k] = *(const LAS bf16x8*)(lds + PG8_SB(b, h) + boff + n * 2048 + k * 1024); } while (0)
#define PG8_MMA(ai, bj, At, Bt) do { __builtin_amdgcn_s_setprio(1); _Pragma("unroll") for (int m = 0; m < 4; ++m) _Pragma("unroll") for (int n = 0; n < 2; ++n) _Pragma("unroll") for (int k = 0; k < 2; ++k) \
        acc[ai][bj][m][n] = __builtin_amdgcn_mfma_f32_16x16x32_bf16(Bt[n][k], At[m][k], acc[ai][bj][m][n], 0, 0, 0); __builtin_amdgcn_s_setprio(0); } while (0)
#define PG8_WAIT_V(n) asm volatile("s_waitcnt vmcnt(" #n ")" ::: "memory")
#define PG8_WAIT_L(n) asm volatile("s_waitcnt lgkmcnt(" #n ")" ::: "memory")
#define PG8_BAR __builtin_amdgcn_s_barrier()
#define PG8_SCHED __builtin_amdgcn_sched_barrier(0)
    Unit cur, nxt; int ui = 0;
    if (!S.next(0, cur)) return;
    f32x4 acc[2][2][4][2];
#pragma unroll
    for (int a = 0; a < 2; ++a)
#pragma unroll
        for (int b = 0; b < 2; ++b)
#pragma unroll
            for (int m = 0; m < 4; ++m)
#pragma unroll
                for (int n = 0; n < 2; ++n) acc[a][b][m][n] = (f32x4){0.f, 0.f, 0.f, 0.f};
    bf16x8 At[4][2], B0[2][2], B1[2][2];
    const char* cA = cur.A; const char* cB = cur.B;
    if constexpr (GATHER) { S.fill(cur, lds + GTAB_OFF, wid, lane); asm volatile("s_waitcnt vmcnt(0) lgkmcnt(0)" ::: "memory"); __syncthreads(); }
    int par = 0;
    PG8_STAGE(PG8_SB(0, 0), cB, voffB); PG8_STAGE(PG8_SB(0, 1), cB + hstep, voffB); PG8_STAGE_A(0, 0, cA, par); PG8_STAGE_A(0, 1, cA, par);
    if (wr == 1) PG8_BAR;
    PG8_WAIT_V(2); PG8_BAR;
    PG8_STAGE(PG8_SB(1, 0), cB + kstep, voffB); PG8_STAGE_A(1, 0, cA + kstep, par); PG8_STAGE(PG8_SB(1, 1), cB + hstep + kstep, voffB);
    PG8_WAIT_V(6); PG8_BAR;
    int rpar = 0;
    for (;;) {
        bool has_next = false; const char* nA = cA; const char* nB = cB;
        if constexpr (Epi::RTAB) E.rowtab(cur, lds + RTAB_OFF + rpar * 1024, wid, lane);
        if constexpr (DYN) { S.prefetch(ui + 1); }
        else { has_next = S.next(ui + 1, nxt); nA = has_next ? nxt.A : cA; nB = has_next ? nxt.B : cB; }
        if constexpr (GATHER) { if (has_next) S.fill(nxt, lds + GTAB_OFF + (par ^ 1) * 1024, wid, lane); }
        const int npar = (GATHER && has_next) ? (par ^ 1) : par;
        for (int t = 0; t < nt; t += 2) {
            const bool last = (t == nt - 2);
            if constexpr (DYN) { if (last) { has_next = S.next(ui + 1, nxt); nA = has_next ? nxt.A : cA; nB = has_next ? nxt.B : cB; } }
            const char* a1 = cA + (size_t)(t + 1) * kstep;
            const char* a2 = last ? nA : cA + (size_t)(t + 2) * kstep; const char* b2 = last ? nB : cB + (size_t)(t + 2) * kstep;
            const char* a3 = a2 + kstep; const char* b3 = b2 + kstep;
            const int p2 = last ? npar : par;
            PG8_LDB(B0, 0, 0); PG8_LDB(B1, 0, 1); PG8_SCHED; PG8_LDA(At, 0, 0); PG8_STAGE_A(1, 1, a1, par);
            PG8_WAIT_V(8); PG8_WAIT_L(0); PG8_BAR; PG8_MMA(0, 0, At, B0); PG8_MMA(0, 1, At, B1); PG8_BAR; PG8_SCHED;
            PG8_LDA(At, 0, 1); PG8_STAGE(PG8_SB(0, 0), b2, voffB); PG8_STAGE(PG8_SB(0, 1), b2 + hstep, voffB); PG8_STAGE_A(0, 0, a2, p2);
            PG8_WAIT_V(8); PG8_WAIT_L(0); PG8_BAR; PG8_MMA(1, 0, At, B0); PG8_MMA(1, 1, At, B1); PG8_BAR; PG8_SCHED;
            PG8_LDB(B0, 1, 0); PG8_LDB(B1, 1, 1); PG8_SCHED; PG8_LDA(At, 1, 0); PG8_STAGE_A(0, 1, a2, p2);
            PG8_WAIT_V(8); PG8_WAIT_L(0); PG8_BAR; PG8_MMA(0, 0, At, B0); PG8_MMA(0, 1, At, B1); PG8_BAR; PG8_SCHED;
            PG8_LDA(At, 1, 1); PG8_STAGE(PG8_SB(1, 0), b3, voffB); PG8_STAGE(PG8_SB(1, 1), b3 + hstep, voffB); PG8_STAGE_A(1, 0, a3, p2);
            PG8_WAIT_V(8); PG8_WAIT_L(0); PG8_BAR; PG8_MMA(1, 0, At, B0); PG8_MMA(1, 1, At, B1); PG8_BAR; PG8_SCHED;
        }
        if constexpr (ALIGN_EPI) { if (wr == 0) PG8_BAR; }
        if constexpr (Epi::RTAB) E(acc, cur, wr, wc, fr, fq, (const LAS float*)(lds + RTAB_OFF + rpar * 1024)); else E(acc, cur, wr, wc, fr, fq);
        S.done(cur);
        if (!has_next) break;
        if (!E.keep(cur)) {
#pragma unroll
            for (int a = 0; a < 2; ++a)
#pragma unroll
                for (int b = 0; b < 2; ++b)
#pragma unroll
                    for (int m = 0; m < 4; ++m)
#pragma unroll
                        for (int n = 0; n < 2; ++n) acc[a][b][m][n] = (f32x4){0.f, 0.f, 0.f, 0.f};
        }
        cur = nxt; cA = nA; cB = nB; ++ui; par = npar; rpar ^= 1;
        if constexpr (ALIGN_EPI) { if (wr == 1) PG8_BAR; }
    }
    PG8_WAIT_V(0);
    if constexpr (!ALIGN_EPI) { if (wr == 0) PG8_BAR; }
    PG8_BAR;
#undef PG8_SA
#undef PG8_SB
#undef PG8_STAGE
#undef PG8_STAGE_A
#undef PG8_LDA
#undef PG8_LDB
#undef PG8_MMA
#undef PG8_WAIT_V
#undef PG8_WAIT_L
#undef PG8_BAR
#undef PG8_SCHED
}
}

template <bool NT>
__device__ __forceinline__ void tr64_item(const float* W, int K, int N, bf16* WT, int k0, int n0, int drow0, float* scr, int lane) {
    const int rr = lane >> 4, q = lane & 15;
    f32x4 v[16];
#pragma unroll
    for (int i = 0; i < 16; ++i) { const f32x4* p = (const f32x4*)(W + (size_t)(k0 + 4 * i + rr) * N + n0 + 4 * q); v[i] = NT ? __builtin_nontemporal_load(p) : *p; }
#pragma unroll
    for (int i = 0; i < 16; ++i) { float* d = scr + (4 * i + rr) * 65 + 4 * q; d[0] = v[i].x; d[1] = v[i].y; d[2] = v[i].z; d[3] = v[i].w; }
    asm volatile("s_waitcnt lgkmcnt(0)" ::: "memory");
    const int nn = lane >> 3, c = lane & 7;
#pragma unroll
    for (int j = 0; j < 8; ++j) { const int n = nn + 8 * j; const float* s = scr + (8 * c) * 65 + n;
        u32x4 o; o.x = pk2(s[0 * 65], s[1 * 65]); o.y = pk2(s[2 * 65], s[3 * 65]); o.z = pk2(s[4 * 65], s[5 * 65]); o.w = pk2(s[6 * 65], s[7 * 65]);
        u32x4* dp = (u32x4*)(WT + (size_t)(drow0 + n) * K + k0 + 8 * c);
        if (NT) __builtin_nontemporal_store(o, dp); else *dp = o; }
    asm volatile("s_waitcnt lgkmcnt(0)" ::: "memory");
}
constexpr int TI_IN = (D / 64) * (PW / 64), TI_A = (AW / 64) * (D / 64), TI_OUT = (D / 64) * (D / 64), TI_G = (D / 64) * (DE / 64), TI_D = (DE / 64) * (D / 64);
constexpr int TI_E = 2 * TI_G + TI_D, TI_DENSE = TI_IN + 2 * TI_A + TI_OUT, TI_MOE = NE * TI_E;
__device__ __forceinline__ void conv_dense(Frame& F, int cw, int ncw, bool first) {
    float* scr = (float*)(F.lds + F.wave * 16640); const int lane = F.lane;
    if (first) { for (int r = cw; r < TI_IN; r += ncw) { const int nb = PW / 64; tr64_item<false>(F_w_in, D, PW, WSP(bf16, WS_WIN_T), 64 * (r / nb), 64 * (r % nb), 64 * (r % nb), scr, lane); } return; }
    for (int it = cw; it < 2 * TI_A + TI_OUT; it += ncw) {
        int r = it;
        if (r < TI_A) { const int nb = D / 64; tr64_item<false>(F_w_a, AW, D, WSP(bf16, WS_WA_T), 64 * (r / nb), 64 * (r % nb), 64 * (r % nb), scr, lane); continue; } r -= TI_A;
        if (r < TI_A) { const int nb = D / 64; tr64_item<false>(F_w_b, AW, D, WSP(bf16, WS_WB_T), 64 * (r / nb), 64 * (r % nb), 64 * (r % nb), scr, lane); continue; } r -= TI_A;
        { const int nb = D / 64; tr64_item<false>(F_w_out, D, D, WSP(bf16, WS_WOUT_T), 64 * (r / nb), 64 * (r % nb), 64 * (r % nb), scr, lane); }
    }
}
__device__ __forceinline__ void conv_moe(Frame& F, int cw, int ncw) {
    float* scr = (float*)(F.lds + F.wave * 16640); const int lane = F.lane;
    for (int it = cw; it < TI_MOE; it += ncw) {
        const int e = it / TI_E; int r = it - e * TI_E;
        if (r < 2 * TI_G) { const int up = r >= TI_G; if (up) r -= TI_G; const int nb = DE / 64, n0 = 64 * (r % nb);
            const int drow0 = (n0 >> 7) * 256 + up * 128 + (n0 & 127);
            tr64_item<true>((up ? F_w_up : F_w_gate) + (size_t)e * D * DE, D, DE, WSP(bf16, WS_WGU_T) + (size_t)e * 2048 * D, 64 * (r / nb), n0, drow0, scr, lane); continue; }
        r -= 2 * TI_G;
        { const int nb = D / 64; tr64_item<true>(F_w_down + (size_t)e * DE * D, DE, D, WSP(bf16, WS_WD_T) + (size_t)e * D * DE, 64 * (r / nb), 64 * (r % nb), 64 * (r % nb), scr, lane); }
    }
}

__device__ __forceinline__ void p0_router_weights(Frame& F) {
    const int gt = F.bid * NTHR + F.tid, NT = F.G * NTHR;
    bf16* wf = WSP(bf16, WS_WRH);
    for (int i = gt; i < 4 * 8 * 4 * 2 * 64 * 8; i += NT) {
        const int j = i & 7, lane = (i >> 3) & 63, nt = (i >> 9) & 1, sst = (i >> 10) & 3, w = (i >> 12) & 7, kc = i >> 15;
        const int col = 32 * nt + (lane & 31), k = 512 * kc + 64 * w + 16 * sst + 8 * (lane >> 5) + j;
        float v = 0.f; if (col < 32) v = F_w_re[(size_t)k * 32 + col] * F_g_ffn[k]; else if (col < 36) v = F_w_rg[(size_t)k * 4 + (col - 32)] * F_g_ffn[k];
        const unsigned h = f2bf(v); const float hf = __uint_as_float(h << 16);
        const size_t base = ((((size_t)(kc * 8 + w) * 4 + sst) * 2 + nt) * 2) * 512;
        wf[base + lane * 8 + j] = (bf16)h; wf[base + 512 + lane * 8 + j] = (bf16)f2bf(v - hf); }
}
__device__ __forceinline__ void p0_weights(Frame& F) {
    const int gw = F.bid * NWAVES + F.wave, NGW = F.G * NWAVES;
    conv_dense(F, gw, NGW, true);
    if (!OVERLAP_CONV) { conv_dense(F, gw, NGW, false); conv_moe(F, gw, NGW); }
}

constexpr int CW_PANEL = 12288, CW_GQ = 14400, CW_UDONE = 14464, NPROJ_UNITS = (T / 256) * (PW / 256);
static_assert((CW_UDONE + 64) * 4 <= (int)CTL_ZERO_BYTES, "hand-off words inside the zeroed control region");
constexpr int GQ_LDS_OFF = 131072 + 4096 + 64;
__device__ __forceinline__ void p2_gating_mfma(Frame& F, const bool early);
__device__ __forceinline__ __amdgpu_buffer_rsrc_t wt_rsrc(void* p) { return __builtin_amdgcn_make_buffer_rsrc(p, 0, 0x7fffffff, 0x00020000); }
__device__ __forceinline__ void wt_store16(__amdgpu_buffer_rsrc_t r, unsigned byte_off, u32x4 v) { __builtin_amdgcn_raw_buffer_store_b128(v, r, byte_off, 0, 16); }
struct EpiProj {
    static constexpr bool PERM = true; static constexpr bool RTAB = false;
    bf16* P;
    __device__ __forceinline__ bool keep(const pg8::Unit&) const { return false; }
    __device__ __forceinline__ void operator()(f32x4 (&acc)[2][2][4][2], const pg8::Unit& u, int wr, int wc, int fr, int fq) const {
        const int act = (u.pn < 8) ? ((GELU_U_LATE && u.pn < 4) ? 0 : 1) : ((u.pn < 20) ? 0 : 2);
        const int row0 = u.pm * 256 + wr * 64 + fr, col0 = u.pn * 256 + wc * 32 + 8 * fq;
#pragma unroll
        for (int ai = 0; ai < 2; ++ai)
#pragma unroll
            for (int m = 0; m < 4; ++m) { bf16* rowp = P + (size_t)(row0 + ai * 128 + m * 16) * PW + col0;
#pragma unroll
                for (int bj = 0; bj < 2; ++bj) { f32x4 v0 = acc[ai][bj][m][0], v1 = acc[ai][bj][m][1];
                    if (act == 1) {
#pragma unroll
                        for (int j = 0; j < 4; ++j) { v0[j] = gelu_tanh(v0[j]); v1[j] = gelu_tanh(v1[j]); } }
                    else if (act == 2) {
#pragma unroll
                        for (int j = 0; j < 4; ++j) { v0[j] = sigmoidf_(v0[j]); v1[j] = sigmoidf_(v1[j]); } }
                    u32x4 w; w.x = pg8::cvt_pk_bf16(v0[0], v0[1]); w.y = pg8::cvt_pk_bf16(v0[2], v0[3]); w.z = pg8::cvt_pk_bf16(v1[0], v1[1]); w.w = pg8::cvt_pk_bf16(v1[2], v1[3]);
                    if (WT_STORES || (EARLY_GATING && u.pn < 8)) asm volatile("global_store_dwordx4 %0, %1, off sc1\n\ts_nop 1" :: "v"(rowp + bj * 128), "v"(w) : "memory"); else *(u32x4*)(rowp + bj * 128) = w; } }
    }
};
struct SchedProj {
    pg8::TileOrder o; const char* A; const char* B;
    __device__ __forceinline__ void done(const pg8::Unit&) const {}
    __device__ __forceinline__ bool next(int i, pg8::Unit& u) const { int pm, pn; if (!o.tile(i, pm, pn)) return false; u.pm = pm; u.pn = pn; u.e = 0; u.aux = 0; u.ti = 0;
        u.A = A + (size_t)pm * 256 * D * 2; u.B = B + (size_t)pn * 256 * D * 2; return true; }
};
constexpr int CW_Q = 64;
constexpr int DQ_LDS_OFF = 131072 + 4096;
struct SchedProjDyn {
    pg8::TileOrder o; const char* A; const char* B; unsigned* q; volatile LAS int* slot; int x; unsigned* ctl;
    __device__ __forceinline__ void done(const pg8::Unit& u) const {
        if (!EARLY_GATING) return;
        if (u.pn < 8) { asm volatile("s_waitcnt vmcnt(0)" ::: "memory"); if ((threadIdx.x & 63) == 0) __hip_atomic_fetch_add(ctl + CW_PANEL + 64 * u.pm, 1u, __ATOMIC_RELAXED, __HIP_MEMORY_SCOPE_AGENT); }
        if (threadIdx.x == 0) __hip_atomic_fetch_add(ctl + CW_UDONE, 1u, __ATOMIC_RELAXED, __HIP_MEMORY_SCOPE_AGENT); }
    __device__ __forceinline__ bool unit_of(int idx, pg8::Unit& u) const { pg8::TileOrder t = o; t.G = 8; t.c = x; int pm, pn; if (!t.tile(idx, pm, pn)) return false; u.pm = pm; u.pn = pn; u.e = 0; u.aux = 0; u.ti = 0;
        u.A = A + (size_t)pm * 256 * D * 2; u.B = B + (size_t)pn * 256 * D * 2; return true; }
    __device__ __forceinline__ void prefetch(int i) const { if (threadIdx.x == 0) slot[i & 1] = (int)__hip_atomic_fetch_add(q, 1u, __ATOMIC_RELAXED, __HIP_MEMORY_SCOPE_AGENT); }
    __device__ __forceinline__ bool next(int i, pg8::Unit& u) const {
        if (i == 0) { prefetch(0); asm volatile("s_waitcnt vmcnt(0) lgkmcnt(0)" ::: "memory"); __syncthreads(); }
        const int idx = __builtin_amdgcn_readfirstlane(slot[i & 1]); return unit_of(idx, u); }
};
__device__ __forceinline__ void p1_proj_mfma(Frame& F) {
    EpiProj E{F_PROJ};
    if (OVERLAP_CONV) {
        const int NC = CONV_CUS < F.G ? CONV_CUS : F.G / 2;
        if (F.bid < NC) { conv_dense(F, F.bid * NWAVES + F.wave, NC * NWAVES, false); conv_moe(F, F.bid * NWAVES + F.wave, NC * NWAVES); __syncthreads(); }
        SchedProjDyn S; S.o.init(T, PW, 8, 0); S.A = (const char*)F_XN; S.B = (const char*)WSP(bf16, WS_WIN_T); S.x = F.bid & 7; S.q = F_ctl + CW_Q + 64 * S.x;
        S.slot = (volatile LAS int*)((LAS unsigned char*)F.lds + DQ_LDS_OFF); S.ctl = F_ctl;
        pg8::gemm_phase<EpiProj, SchedProjDyn, false, true, true, true>((LAS unsigned char*)F.lds, D, S, E);
        if (EARLY_GATING) p2_gating_mfma(F, true);
    } else {
        SchedProj S; S.o.init(T, PW, F.G, F.bid); S.A = (const char*)F_XN; S.B = (const char*)WSP(bf16, WS_WIN_T);
        pg8::gemm_phase<EpiProj, SchedProj, false, true, true>((LAS unsigned char*)F.lds, D, S, E);
    }
}
struct EpiBranch {
    static constexpr bool PERM = true; static constexpr bool RTAB = false;
    const bf16* P; bf16* MG;
    __device__ __forceinline__ bool keep(const pg8::Unit& u) const { return u.aux == 0; }
    __device__ __forceinline__ void operator()(f32x4 (&acc)[2][2][4][2], const pg8::Unit& u, int wr, int wc, int fr, int fq) const {
        const int row0 = u.pm * 256 + wr * 64 + fr, col0 = u.pn * 256 + wc * 32 + 8 * fq;
        if (u.aux == 0) {
#pragma unroll
            for (int ai = 0; ai < 2; ++ai) {
                u32x4 gaw[4][2], gbw[4][2];
#pragma unroll
                for (int m = 0; m < 4; ++m)
#pragma unroll
                    for (int bj = 0; bj < 2; ++bj) { const bf16* gp = P + (size_t)(row0 + ai * 128 + m * 16) * PW + col0 + bj * 128;
                        gaw[m][bj] = *(const u32x4*)(gp + OFF_GA); gbw[m][bj] = *(const u32x4*)(gp + OFF_GB); }
#pragma unroll
                for (int m = 0; m < 4; ++m)
#pragma unroll
                    for (int bj = 0; bj < 2; ++bj)
#pragma unroll
                        for (int j = 0; j < 4; ++j) {
                            const float gb0 = fmaxf(__uint_as_float(gbw[m][bj][j] << 16), 1e-30f), gb1 = fmaxf(__uint_as_float(gbw[m][bj][j] & 0xffff0000u), 1e-30f);
                            const float ga0 = __uint_as_float(gaw[m][bj][j] << 16), ga1 = __uint_as_float(gaw[m][bj][j] & 0xffff0000u);
                            const int n = j >> 1, q = (j & 1) * 2; acc[ai][bj][m][n][q] *= ga0 * __builtin_amdgcn_rcpf(gb0); acc[ai][bj][m][n][q + 1] *= ga1 * __builtin_amdgcn_rcpf(gb1); }
            }
        } else {
            const __amdgpu_buffer_rsrc_t rM = wt_rsrc(MG);
            u32x4 gbw[2][4][2];
#pragma unroll
            for (int ai = 0; ai < 2; ++ai)
#pragma unroll
                for (int m = 0; m < 4; ++m)
#pragma unroll
                    for (int bj = 0; bj < 2; ++bj) gbw[ai][m][bj] = *(const u32x4*)(P + (size_t)(row0 + ai * 128 + m * 16) * PW + OFF_GB + col0 + bj * 128);
#pragma unroll
            for (int ai = 0; ai < 2; ++ai)
#pragma unroll
                for (int m = 0; m < 4; ++m)
#pragma unroll
                    for (int bj = 0; bj < 2; ++bj) { const unsigned r = (unsigned)(row0 + ai * 128 + m * 16);
                        float gb[8];
#pragma unroll
                        for (int j = 0; j < 4; ++j) { gb[2 * j] = fmaxf(__uint_as_float(gbw[ai][m][bj][j] << 16), 1e-30f); gb[2 * j + 1] = fmaxf(__uint_as_float(gbw[ai][m][bj][j] & 0xffff0000u), 1e-30f); }
                        const f32x4 v0 = acc[ai][bj][m][0], v1 = acc[ai][bj][m][1];
                        u32x4 w; w.x = pg8::cvt_pk_bf16(v0[0] * gb[0], v0[1] * gb[1]); w.y = pg8::cvt_pk_bf16(v0[2] * gb[2], v0[3] * gb[3]);
                        w.z = pg8::cvt_pk_bf16(v1[0] * gb[4], v1[1] * gb[5]); w.w = pg8::cvt_pk_bf16(v1[2] * gb[6], v1[3] * gb[7]);
                        if (WT_STORES) wt_store16(rM, (r * D + col0 + bj * 128) * 2u, w); else *(u32x4*)(MG + (size_t)r * D + col0 + bj * 128) = w; }
        }
    }
};
struct SchedBranch {
    pg8::TileOrder o; const char *YA, *YB, *WA, *WB;
    __device__ __forceinline__ void done(const pg8::Unit&) const {}
    __device__ __forceinline__ bool next(int i, pg8::Unit& u) const { int pm, pn; if (!o.tile(i >> 1, pm, pn)) return false; u.pm = pm; u.pn = pn; u.e = 0; u.aux = i & 1; u.ti = 0;
        u.A = ((i & 1) ? YB : YA) + (size_t)pm * 256 * AW * 2; u.B = ((i & 1) ? WB : WA) + (size_t)pn * 256 * AW * 2; return true; }
};
__device__ __forceinline__ void p3_branch_mfma(Frame& F) {
    SchedBranch S; S.o.init(T, D, F.G, F.bid); S.YA = (const char*)F_YA; S.YB = (const char*)F_YB; S.WA = (const char*)WSP(bf16, WS_WA_T); S.WB = (const char*)WSP(bf16, WS_WB_T);
    EpiBranch E{F_PROJ, F_MERGED};
    pg8::gemm_phase<EpiBranch, SchedBranch, false, true, true>((LAS unsigned char*)F.lds, AW, S, E);
}
struct EpiOut {
    static constexpr bool PERM = true; static constexpr bool RTAB = false;
    const float* x; const float* gf; float* X1; bf16* H2;
    __device__ __forceinline__ bool keep(const pg8::Unit&) const { return false; }
    __device__ __forceinline__ void operator()(f32x4 (&acc)[2][2][4][2], const pg8::Unit& u, int wr, int wc, int fr, int fq) const {
        const int row0 = u.pm * 256 + wr * 64 + fr, col0 = u.pn * 256 + wc * 32 + 8 * fq;
#pragma unroll
        for (int ai = 0; ai < 2; ++ai)
#pragma unroll
            for (int m = 0; m < 4; ++m) { const size_t off = (size_t)(row0 + ai * 128 + m * 16) * D + col0;
#pragma unroll
                for (int bj = 0; bj < 2; ++bj) {
                    const f32x4 x0 = *(const f32x4*)(x + off + bj * 128), x1 = *(const f32x4*)(x + off + bj * 128 + 4);
                    const f32x4 g0 = *(const f32x4*)(gf + col0 + bj * 128), g1 = *(const f32x4*)(gf + col0 + bj * 128 + 4);
                    const f32x4 v0 = x0 + acc[ai][bj][m][0], v1 = x1 + acc[ai][bj][m][1];
                    *(f32x4*)(X1 + off + bj * 128) = v0; *(f32x4*)(X1 + off + bj * 128 + 4) = v1;
                    u32x4 w; w.x = pg8::cvt_pk_bf16(v0[0] * g0[0], v0[1] * g0[1]); w.y = pg8::cvt_pk_bf16(v0[2] * g0[2], v0[3] * g0[3]);
                    w.z = pg8::cvt_pk_bf16(v1[0] * g1[0], v1[1] * g1[1]); w.w = pg8::cvt_pk_bf16(v1[2] * g1[2], v1[3] * g1[3]);
                    *(u32x4*)(H2 + off + bj * 128) = w; }
                asm volatile("" ::: "memory"); }
    }
};
struct SchedOut {
    pg8::TileOrder o; const char* A; const char* B;
    __device__ __forceinline__ void done(const pg8::Unit&) const {}
    __device__ __forceinline__ bool next(int i, pg8::Unit& u) const { int pm, pn; if (!o.tile(i, pm, pn)) return false; u.pm = pm; u.pn = pn; u.e = 0; u.aux = 0; u.ti = 0;
        u.A = A + (size_t)pm * 256 * D * 2; u.B = B + (size_t)pn * 256 * D * 2; return true; }
};
__device__ __forceinline__ void p4_out_mfma(Frame& F) {
    SchedOut S; S.o.init(T, D, F.G, F.bid); S.A = (const char*)F_MERGED; S.B = (const char*)WSP(bf16, WS_WOUT_T);
    EpiOut E{F_x, F_g_ffn, F_out, F_H2};
    pg8::gemm_phase<EpiOut, SchedOut, false, true, true>((LAS unsigned char*)F.lds, D, S, E);
}
constexpr int MOE_TAB_OFF = 131072 + 2048;
__device__ __forceinline__ void moe_table(Frame& F) {
    int* tb = (int*)(F.lds + MOE_TAB_OFF);
    __syncthreads();
    if (F.tid < 64) {
        const int e = F.lane; int c = 0;
        if (e < NE) c = (int)__hip_atomic_load(F_ctl + CW_CNT + CNT_STRIDE * e, __ATOMIC_RELAXED, __HIP_MEMORY_SCOPE_AGENT);
        const int m = (c + 255) >> 8; int incl = m;
#pragma unroll
        for (int d = 1; d < 32; d <<= 1) { const int v = __shfl_up(incl, d); if (e >= d) incl += v; }
        const int excl = incl - m;
        if (e < NE) { tb[e] = excl << 8; tb[320 + e] = c; for (int j = 0; j < m; ++j) { tb[64 + 2 * (excl + j)] = e; tb[65 + 2 * (excl + j)] = j; } }
        if (e == NE - 1) { tb[NE] = incl << 8; tb[33] = incl; }
    }
    __syncthreads();
}
struct SchedMoe {
    const int* tb; int G, vcu, t_lo, t_hi, n_pub; unsigned* donew; const char* A; const char* B; const int* LTOK; const unsigned* cnt; int a_row_bytes; size_t b_exp_bytes, b_pn_bytes; int Kg;
    __device__ __forceinline__ bool next(int i, pg8::Unit& u) const {
        const int L = i * G + vcu; if (L >= (t_hi - t_lo) * 8) return false;
        const int ti = t_lo + (L >> 3); u.ti = ti; u.pn = L & 7; u.e = tb[64 + 2 * ti]; u.pm = tb[65 + 2 * ti]; u.aux = tb[u.e] + u.pm * 256;
        u.A = (a_row_bytes ? A + (size_t)u.aux * a_row_bytes : A); u.B = B + (size_t)u.e * b_exp_bytes + (size_t)u.pn * b_pn_bytes; return true; }
    __device__ __forceinline__ void fill(const pg8::Unit& u, LAS unsigned char* dst, int wid, int lane) const {
        if (wid < 4) __builtin_amdgcn_global_load_lds((const unsigned*)(LTOK + u.e * T + u.pm * 256 + wid * 64 + lane), (LAS unsigned*)(dst + wid * 256), 4, 0, 0); }
    __device__ __forceinline__ void done(const pg8::Unit& u) const {
        if (u.ti < n_pub) { asm volatile("s_waitcnt vmcnt(0)" ::: "memory");
            if ((threadIdx.x & 63) == 0) __hip_atomic_fetch_add(donew + 64 * u.ti, 1u, __ATOMIC_RELAXED, __HIP_MEMORY_SCOPE_AGENT); } }
};

constexpr int CW_DONE = 8192;
static_assert((CW_DONE + 64 * 32) * 4 <= (int)CTL_ZERO_BYTES, "arrival counters inside the zeroed control region");
__device__ __forceinline__ int moe_early_tiles(int nt, int G) {
    if (!MOE_EARLY_DOWN || G != 256 || nt * 8 <= 2 * G || nt * 8 >= 3 * G) return 0;
    const int idle = 3 * G - nt * 8; int n = idle >> 3; if (n > 32) n = 32; if (n > nt) n = nt; return n;
}
struct EpiGateUp {
    static constexpr bool PERM = true; static constexpr bool RTAB = true;
    const float* LRSTD; bf16* HDN; int n_pub;
    __device__ __forceinline__ bool keep(const pg8::Unit&) const { return false; }
    __device__ __forceinline__ void rowtab(const pg8::Unit& u, LAS unsigned char* dst, int wid, int lane) const {
        if (wid < 4) __builtin_amdgcn_global_load_lds((const unsigned*)(LRSTD + u.e * T + u.pm * 256 + wid * 64 + lane), (LAS unsigned*)(dst + wid * 256), 4, 0, 0); }
    __device__ __forceinline__ void operator()(f32x4 (&acc)[2][2][4][2], const pg8::Unit& u, int wr, int wc, int fr, int fq, const LAS float* rt) const {
        const int col0 = u.pn * 128 + wc * 32 + 8 * fq;
#pragma unroll
        for (int ai = 0; ai < 2; ++ai)
#pragma unroll
            for (int m = 0; m < 4; ++m) { const int rl = ai * 128 + wr * 64 + m * 16 + fr;
                const float rs = rt[rl];
                float h[8];
#pragma unroll
                for (int n = 0; n < 2; ++n)
#pragma unroll
                    for (int j = 0; j < 4; ++j) { const float g = acc[ai][0][m][n][j] * rs, uu = acc[ai][1][m][n][j] * rs; h[n * 4 + j] = g * sigmoidf_(g) * uu; }
                u32x4 w; w.x = pg8::cvt_pk_bf16(h[0], h[1]); w.y = pg8::cvt_pk_bf16(h[2], h[3]); w.z = pg8::cvt_pk_bf16(h[4], h[5]); w.w = pg8::cvt_pk_bf16(h[6], h[7]);
                bf16* dp = HDN + (size_t)(u.aux + rl) * DE + col0;
                if (WT_STORES || u.ti < n_pub) asm volatile("global_store_dwordx4 %0, %1, off sc1\n\ts_nop 1" :: "v"(dp), "v"(w) : "memory"); else *(u32x4*)dp = w; }
    }
};
__device__ __forceinline__ void p7_early(Frame& F, int n_early);
__device__ __forceinline__ void p6_gateup_mfma(Frame& F) {
    moe_table(F);
    const int* tb = (const int*)(F.lds + MOE_TAB_OFF);
    SchedMoe S; S.tb = tb; S.G = F.G; S.vcu = (F.G % 8 == 0) ? (F.bid % 8) * (F.G / 8) + F.bid / 8 : F.bid;
    S.A = (const char*)F_H2; S.a_row_bytes = 0; S.B = (const char*)WSP(bf16, WS_WGU_T); S.b_exp_bytes = (size_t)2048 * D * 2; S.b_pn_bytes = (size_t)256 * D * 2; S.LTOK = F_LTOK; S.cnt = F_ctl + CW_CNT; S.Kg = D;
    const int nt = tb[33], n_early = moe_early_tiles(nt, F.G);
    S.t_lo = 0; S.t_hi = nt; S.n_pub = n_early; S.donew = F_ctl + CW_DONE;
    EpiGateUp E{F_LRSTD, F_HDN, n_early};
    pg8::gemm_phase<EpiGateUp, SchedMoe, true, true, true>((LAS unsigned char*)F.lds, D, S, E);
    if (n_early > 0) p7_early(F, n_early);
}
struct EpiDown {
    static constexpr bool PERM = true; static constexpr bool RTAB = true;
    const float* LW; bf16* Y;
    __device__ __forceinline__ bool keep(const pg8::Unit&) const { return false; }
    __device__ __forceinline__ void rowtab(const pg8::Unit& u, LAS unsigned char* dst, int wid, int lane) const {
        if (wid < 4) __builtin_amdgcn_global_load_lds((const unsigned*)(LW + u.e * T + u.pm * 256 + wid * 64 + lane), (LAS unsigned*)(dst + wid * 256), 4, 0, 0); }
    __device__ __forceinline__ void operator()(f32x4 (&acc)[2][2][4][2], const pg8::Unit& u, int wr, int wc, int fr, int fq, const LAS float* rt) const {
        const int col0 = u.pn * 256 + wc * 32 + 8 * fq;
#pragma unroll
        for (int ai = 0; ai < 2; ++ai)
#pragma unroll
            for (int m = 0; m < 4; ++m) { const int rl = ai * 128 + wr * 64 + m * 16 + fr;
                const float gw = rt[rl];
#pragma unroll
                for (int bj = 0; bj < 2; ++bj) { const f32x4 v0 = acc[ai][bj][m][0] * gw, v1 = acc[ai][bj][m][1] * gw;
                    u32x4 w; w.x = pg8::cvt_pk_bf16(v0[0], v0[1]); w.y = pg8::cvt_pk_bf16(v0[2], v0[3]); w.z = pg8::cvt_pk_bf16(v1[0], v1[1]); w.w = pg8::cvt_pk_bf16(v1[2], v1[3]);
                    bf16* dp = Y + (size_t)(u.aux + rl) * D + col0 + bj * 128;
                    if (WT_STORES) asm volatile("global_store_dwordx4 %0, %1, off sc1\n\ts_nop 1" :: "v"(dp), "v"(w) : "memory"); else *(u32x4*)dp = w; } }
    }
};
struct SchedMoeOne {
    pg8::Unit u0; bool have;
    __device__ __forceinline__ bool next(int i, pg8::Unit& u) const { if (i != 0 || !have) return false; u = u0; return true; }
    __device__ __forceinline__ void fill(const pg8::Unit&, LAS unsigned char*, int, int) const {}
    __device__ __forceinline__ void done(const pg8::Unit&) const {}
};
__device__ __forceinline__ void p7_early(Frame& F, int n_early) {
    const int* tb = (const int*)(F.lds + MOE_TAB_OFF);
    const int nt = tb[33]; const int vcu = (F.bid % 8) * (F.G / 8) + F.bid / 8; const int first_idle = nt * 8 - 2 * F.G;
    const int j = vcu - first_idle;
    SchedMoeOne S; S.have = (j >= 0 && j < n_early * 8);
    if (S.have) { const int ti = j >> 3; S.u0.ti = ti; S.u0.pn = j & 7; S.u0.e = tb[64 + 2 * ti]; S.u0.pm = tb[65 + 2 * ti]; S.u0.aux = tb[S.u0.e] + S.u0.pm * 256;
        S.u0.A = (const char*)F_HDN + (size_t)S.u0.aux * DE * 2; S.u0.B = (const char*)WSP(bf16, WS_WD_T) + (size_t)S.u0.e * D * DE * 2 + (size_t)S.u0.pn * 256 * DE * 2;
        if (F.tid < 64) { unsigned* w = F_ctl + CW_DONE + 64 * ti; unsigned sp = 0;
            while ((unsigned)__builtin_amdgcn_readfirstlane(__hip_atomic_load(w, __ATOMIC_RELAXED, __HIP_MEMORY_SCOPE_AGENT)) < 64u) { __builtin_amdgcn_s_sleep(2); if (++sp > (1u << 22)) break; }
            __builtin_amdgcn_fence(__ATOMIC_ACQUIRE, "agent");
            asm volatile("s_waitcnt vmcnt(0)" ::: "memory"); } }
    __syncthreads();
    EpiDown E{F_LW, F_Y};
    pg8::gemm_phase<EpiDown, SchedMoeOne, false, true, true>((LAS unsigned char*)F.lds, DE, S, E);
}
__device__ __forceinline__ void p7_down_mfma(Frame& F, bool have_tab) {
    if (!have_tab) moe_table(F);
    const int* tb = (const int*)(F.lds + MOE_TAB_OFF);
    SchedMoe S; S.tb = tb; S.G = F.G; S.vcu = (F.G % 8 == 0) ? (F.bid % 8) * (F.G / 8) + F.bid / 8 : F.bid;
    S.A = (const char*)F_HDN; S.a_row_bytes = DE * 2; S.B = (const char*)WSP(bf16, WS_WD_T); S.b_exp_bytes = (size_t)D * DE * 2; S.b_pn_bytes = (size_t)256 * DE * 2; S.LTOK = F_LTOK; S.cnt = F_ctl + CW_CNT; S.Kg = DE;
    const int nt = tb[33]; S.t_lo = moe_early_tiles(nt, F.G); S.t_hi = nt; S.n_pub = 0; S.donew = F_ctl + CW_DONE;
    EpiDown E{F_LW, F_Y};
    pg8::gemm_phase<EpiDown, SchedMoe, false, true, true>((LAS unsigned char*)F.lds, DE, S, E);
}


typedef float f32x16 __attribute__((ext_vector_type(16)));
typedef short s16x8 __attribute__((ext_vector_type(8)));
typedef short s16x4 __attribute__((ext_vector_type(4)));
__device__ __forceinline__ s16x4 vtr16(const LAS unsigned char* p) { return __builtin_bit_cast(s16x4, __builtin_amdgcn_ds_read_tr16_b64_v4i16((LAS s16x4*)p)); }
__device__ __forceinline__ float xhalf(float v, int hi) { auto rr = __builtin_amdgcn_permlane32_swap(__float_as_uint(v), __float_as_uint(v), false, false); return __uint_as_float(hi ? rr[0] : rr[1]); }

__device__ __forceinline__ void p2_attn_mfma(Frame& F) {
    LAS unsigned char* L = (LAS unsigned char*)F.lds;
    constexpr int LK = 0, LV = 32768, LFL = 65536;
    const int tid = F.tid, lane = F.lane, wid = F.wave, r32 = lane & 31, hi = lane >> 5;
    const bf16* P = F_PROJ; bf16* YB = F_YB;
    const float c2 = 0.08838834764831845f * 1.4426950408889634f;
    int srow[2], sch[2], kdst[2], vdst[2];
#pragma unroll
    for (int i = 0; i < 2; ++i) { const int c = tid + 512 * i; srow[i] = c >> 4; sch[i] = c & 15; const int row = srow[i], ch = sch[i];
        kdst[i] = row * 256 + ((ch ^ (row & 15)) << 4); vdst[i] = row * 256 + ((ch ^ (((row & 3) << 2) | ((row >> 2) & 3))) << 4); }
    int vaddr[4][2];
    { const int i = lane & 15, g16b = (lane >> 4) & 1, qrow = i >> 2, p = i & 3;
#pragma unroll
      for (int db = 0; db < 4; ++db)
#pragma unroll
        for (int h8 = 0; h8 < 2; ++h8) { const int mlo = (2 * h8 + hi) & 3, chlo = (2 * g16b + (p >> 1)) ^ mlo, chhi = db ^ qrow;
            vaddr[db][h8] = 256 * (4 * hi + qrow + 8 * h8) + 16 * ((chhi << 2) | chlo) + 8 * (p & 1); } }
    for (int unit = F.bid; unit < NH * (T / 256); unit += F.G) {
        const int h = unit & 7, qb = unit >> 3, q0 = qb * 256, qw0 = q0 + 32 * wid, qg = qw0 + r32;
        s16x8 qf[8];
        { const bf16* qrow = P + (size_t)qg * PW + OFF_Q + h * HD + hi * 8;
#pragma unroll
          for (int s = 0; s < 8; ++s) qf[s] = *(const s16x8*)(qrow + 16 * s); }
        f32x16 o[4];
#pragma unroll
        for (int db = 0; db < 4; ++db)
#pragma unroll
            for (int r = 0; r < 16; ++r) o[db][r] = 0.f;
        float R = 1.f;
        int jt = (q0 >> 6) + 3;
        u32x4 kreg[2], vreg[2];
        const bf16* kbase = P + OFF_K + h * HD; const bf16* vbase = P + OFF_V + h * HD;
#define ATT_LOAD(j) do { _Pragma("unroll") for (int i = 0; i < 2; ++i) { const size_t ro = (size_t)((j) * 64 + srow[i]) * PW + sch[i] * 8; \
            kreg[i] = *(const u32x4*)(kbase + ro); vreg[i] = *(const u32x4*)(vbase + ro); } } while (0)
#define ATT_WRITE(b) do { _Pragma("unroll") for (int i = 0; i < 2; ++i) { *(LAS u32x4*)(L + LK + (b) * 16384 + kdst[i]) = kreg[i]; *(LAS u32x4*)(L + LV + (b) * 16384 + vdst[i]) = vreg[i]; } } while (0)
        __syncthreads();
        ATT_LOAD(jt); ATT_WRITE(0);
        __syncthreads();
        int buf = 0; bool wdone = false;
        for (;;) {
            const int k0 = jt * 64; const bool more = jt > 0;
            if (more) ATT_LOAD(jt - 1);
            if (!wdone && k0 < qw0 + 31) {
                const LAS unsigned char* Kb = L + LK + buf * 16384; const LAS unsigned char* Vb = L + LV + buf * 16384;
                f32x16 p0, p1;
#pragma unroll
                for (int r = 0; r < 16; ++r) { p0[r] = 0.f; p1[r] = 0.f; }
#pragma unroll
                for (int s = 0; s < 8; ++s) { const int sw = ((2 * s + hi) ^ (r32 & 15)) << 4;
                    const s16x8 a0 = *(const LAS s16x8*)(Kb + r32 * 256 + sw), a1 = *(const LAS s16x8*)(Kb + (32 + r32) * 256 + sw);
                    p0 = __builtin_amdgcn_mfma_f32_32x32x16_bf16(a0, qf[s], p0, 0, 0, 0); p1 = __builtin_amdgcn_mfma_f32_32x32x16_bf16(a1, qf[s], p1, 0, 0, 0); }
                const bool diag = (k0 + 63 >= qw0);
#pragma unroll
                for (int r = 0; r < 16; ++r) { const int kk = k0 + (r & 3) + 8 * (r >> 2) + 4 * hi;
                    float e0 = __builtin_amdgcn_exp2f(fminf(p0[r] * c2, 100.f)), e1 = __builtin_amdgcn_exp2f(fminf(p1[r] * c2, 100.f));
                    if (diag) { if (kk >= qg) e0 = 0.f; if (kk + 32 >= qg) e1 = 0.f; }
                    p0[r] = __builtin_amdgcn_rcpf(1.0f + e0); p1[r] = __builtin_amdgcn_rcpf(1.0f + e1); }
                float Gp[8], Pn[8], Sx[8];
#pragma unroll
                for (int i = 0; i < 4; ++i) { Gp[i] = (p0[4 * i] * p0[4 * i + 1]) * (p0[4 * i + 2] * p0[4 * i + 3]); Gp[4 + i] = (p1[4 * i] * p1[4 * i + 1]) * (p1[4 * i + 2] * p1[4 * i + 3]); }
#pragma unroll
                for (int g = 0; g < 8; ++g) Pn[g] = xhalf(Gp[g], hi);
                Sx[7] = R;
#pragma unroll
                for (int g = 6; g >= 0; --g) Sx[g] = Sx[g + 1] * (Gp[g + 1] * Pn[g + 1]);
                R = Sx[0] * (Gp[0] * Pn[0]);
#pragma unroll
                for (int g = 0; g < 8; ++g) { float s = hi ? Sx[g] : Sx[g] * Pn[g];
#pragma unroll
                    for (int e = 3; e >= 0; --e) { const int r = 4 * (g & 3) + e; const float rv = (g < 4) ? p0[r] : p1[r]; const float t = s * rv; if (g < 4) p0[r] = s - t; else p1[r] = s - t; s = t; } }
                s16x8 pa[4];
#pragma unroll
                for (int ks = 0; ks < 4; ++ks) { u32x4 w;
#pragma unroll
                    for (int j = 0; j < 4; ++j) { const int r = 8 * (ks & 1) + 2 * j; w[j] = (ks < 2) ? pg8::cvt_pk_bf16(p0[r], p0[r + 1]) : pg8::cvt_pk_bf16(p1[r], p1[r + 1]); }
                    pa[ks] = __builtin_bit_cast(s16x8, w); }
#pragma unroll
                for (int db = 0; db < 4; ++db)
#pragma unroll
                    for (int ks = 0; ks < 4; ++ks) { const int rb = 256 * (16 * ks);
                        const s16x4 lo = vtr16(Vb + vaddr[db][0] + rb), hi4 = vtr16(Vb + vaddr[db][1] + rb);
                        const s16x8 vf = (s16x8){lo[0], lo[1], lo[2], lo[3], hi4[0], hi4[1], hi4[2], hi4[3]};
                        o[db] = __builtin_amdgcn_mfma_f32_32x32x16_bf16(pa[ks], vf, o[db], 0, 0, 0); }
            }
            if (ATTN_EARLY_EXIT) wdone = wdone || __all(R < 1e-30f);
            if (lane == 0) *(LAS unsigned*)(L + LFL + buf * 32 + wid * 4) = wdone ? 1u : 0u;
            if (more) ATT_WRITE(buf ^ 1);
            __syncthreads();
            const u32x4 f0 = *(const LAS u32x4*)(L + LFL + buf * 32), f1 = *(const LAS u32x4*)(L + LFL + buf * 32 + 16);
            const bool alldone = (f0.x & f0.y & f0.z & f0.w & f1.x & f1.y & f1.z & f1.w) != 0u;
            if (!more || alldone) break;
            buf ^= 1; --jt;
        }
#undef ATT_LOAD
#undef ATT_WRITE
        bf16* yb = YB + (size_t)qw0 * AW + h * HD + r32;
#pragma unroll
        for (int db = 0; db < 4; ++db)
#pragma unroll
            for (int r = 0; r < 16; ++r) { const int q = (r & 3) + 8 * (r >> 2) + 4 * hi; yb[(size_t)q * AW + 32 * db] = (bf16)f2bf(o[db][r]); }
    }
    __syncthreads();
}


__device__ __forceinline__ void p2_gating_mfma(Frame& F, const bool early) {
    LAS unsigned char* L = (LAS unsigned char*)F.lds;
    constexpr int LA = 0, LB = 32768, LO = 0;
    const int tid = F.tid, lane = F.lane, wid = F.wave, r32 = lane & 31, hi = lane >> 5, wr = wid >> 1, wc = wid & 1;
    const bf16* P = F_PROJ;
    int vaddr[2][2];
    { const int i = lane & 15, g16b = (lane >> 4) & 1, qrow = i >> 2, p = i & 3;
#pragma unroll
      for (int nb = 0; nb < 2; ++nb)
#pragma unroll
        for (int q4 = 0; q4 < 2; ++q4) { const int db = 2 * wc + nb, mlo = (2 * hi + q4) & 3, chlo = (2 * g16b + (p >> 1)) ^ mlo, chhi = db ^ qrow;
            vaddr[nb][q4] = 256 * (8 * hi + 4 * q4 + qrow) + 16 * ((chhi << 2) | chlo) + 8 * (p & 1); } }
    volatile LAS int* gslot = (volatile LAS int*)((LAS unsigned char*)F.lds + GQ_LDS_OFF);
    for (;;) {
        __syncthreads();
        if (tid == 0) { int it = -1;
            if (!early || (int)__hip_atomic_load(F_ctl + CW_UDONE, __ATOMIC_RELAXED, __HIP_MEMORY_SCOPE_AGENT) < NPROJ_UNITS) it = (int)__hip_atomic_fetch_add(F_ctl + CW_GQ, 1u, __ATOMIC_RELAXED, __HIP_MEMORY_SCOPE_AGENT);
            gslot[0] = it; }
        __syncthreads();
        const int item = gslot[0];
        if (item < 0 || item >= (T / CHK) * 8) break;
        const int c = item >> 3, g = item & 7, t0 = c * CHK;
        if (early) {
            if (tid < 64) { unsigned* w = F_ctl + CW_PANEL + 64 * (c >> 1); unsigned sp = 0;
                while ((unsigned)__builtin_amdgcn_readfirstlane(__hip_atomic_load(w, __ATOMIC_RELAXED, __HIP_MEMORY_SCOPE_AGENT)) < 64u) { __builtin_amdgcn_s_sleep(2); if (++sp > (1u << 22)) break; }
                __builtin_amdgcn_fence(__ATOMIC_ACQUIRE, "agent");
                asm volatile("s_waitcnt vmcnt(0)" ::: "memory"); } }
        __syncthreads();
        f32x4 wa[4], wb[4];
#pragma unroll
        for (int i = 0; i < 4; ++i) { const int cid = tid + 512 * i, t = cid >> 4, ch = cid & 15; const float* wp = F_w_sp + (size_t)g * 16384 + t * 128 + ch * 8; wa[i] = *(const f32x4*)wp; wb[i] = *(const f32x4*)(wp + 4); }
        { const int rr = lane >> 4, q = lane & 15; const int col = g * 128 + q * 8;
          const f32x4 g0 = *(const f32x4*)(F_ln_g + col), g1 = *(const f32x4*)(F_ln_g + col + 4), b0 = *(const f32x4*)(F_ln_b + col), b1 = *(const f32x4*)(F_ln_b + col + 4);
          u32x4 wall[4][8];
#pragma unroll
          for (int pass = 0; pass < 4; ++pass) { const u32x4* row = (const u32x4*)(P + (size_t)(t0 + 16 * wid + 4 * pass + rr) * PW + OFF_GV) + q;
#pragma unroll
            for (int i = 0; i < 8; ++i) wall[pass][i] = row[16 * i]; }
#pragma unroll
          for (int pass = 0; pass < 4; ++pass) { const int s = 16 * wid + 4 * pass + rr;
            u32x4 w[8];
#pragma unroll
            for (int i = 0; i < 8; ++i) w[i] = wall[pass][i];
            float sm = 0.f, s2 = 0.f; u32x4 v = w[0];
#pragma unroll
            for (int i = 0; i < 8; ++i) { if (i == g) v = w[i];
#pragma unroll
                for (int e = 0; e < 4; ++e) { const float a = __uint_as_float(w[i][e] << 16), b = __uint_as_float(w[i][e] & 0xffff0000u); sm += a + b; s2 += a * a + b * b; } }
#pragma unroll
            for (int o = 1; o < 16; o <<= 1) { sm += __shfl_xor(sm, o); s2 += __shfl_xor(s2, o); }
            const float mu = sm * (1.f / AW), rs = rsqrtf(fmaxf(s2 * (1.f / AW) - mu * mu, 0.f) + EPS);
            u32x4 o4; o4.x = pk2((__uint_as_float(v.x << 16) - mu) * rs * g0.x + b0.x, (__uint_as_float(v.x & 0xffff0000u) - mu) * rs * g0.y + b0.y);
            o4.y = pk2((__uint_as_float(v.y << 16) - mu) * rs * g0.z + b0.z, (__uint_as_float(v.y & 0xffff0000u) - mu) * rs * g0.w + b0.w);
            o4.z = pk2((__uint_as_float(v.z << 16) - mu) * rs * g1.x + b1.x, (__uint_as_float(v.z & 0xffff0000u) - mu) * rs * g1.y + b1.y);
            o4.w = pk2((__uint_as_float(v.w << 16) - mu) * rs * g1.z + b1.z, (__uint_as_float(v.w & 0xffff0000u) - mu) * rs * g1.w + b1.w);
            *(LAS u32x4*)(L + LB + s * 256 + ((q ^ (((s & 3) << 2) | ((s >> 2) & 3))) << 4)) = o4; } }
#pragma unroll
        for (int i = 0; i < 4; ++i) { const int cid = tid + 512 * i, t = cid >> 4, ch = cid & 15; const f32x4 a = wa[i], b = wb[i]; const int s0 = ch * 8;
            u32x4 w; w.x = pk2(s0 + 0 <= t ? a.x : 0.f, s0 + 1 <= t ? a.y : 0.f); w.y = pk2(s0 + 2 <= t ? a.z : 0.f, s0 + 3 <= t ? a.w : 0.f);
            w.z = pk2(s0 + 4 <= t ? b.x : 0.f, s0 + 5 <= t ? b.y : 0.f); w.w = pk2(s0 + 6 <= t ? b.z : 0.f, s0 + 7 <= t ? b.w : 0.f);
            *(LAS u32x4*)(L + LA + t * 256 + ((ch ^ (t & 15)) << 4)) = w; }
        __syncthreads();
        f32x16 acc[2];
#pragma unroll
        for (int nb = 0; nb < 2; ++nb)
#pragma unroll
            for (int r = 0; r < 16; ++r) acc[nb][r] = 0.f;
        const int trow = 32 * wr + r32;
        for (int ks = 0; ks < 2 * (wr + 1); ++ks) {
            const s16x8 a = *(const LAS s16x8*)(L + LA + trow * 256 + (((2 * ks + hi) ^ (trow & 15)) << 4));
#pragma unroll
            for (int nb = 0; nb < 2; ++nb) { const s16x4 lo = vtr16(L + LB + vaddr[nb][0] + 4096 * ks), h4 = vtr16(L + LB + vaddr[nb][1] + 4096 * ks);
                const s16x8 b = (s16x8){lo[0], lo[1], lo[2], lo[3], h4[0], h4[1], h4[2], h4[3]};
                acc[nb] = __builtin_amdgcn_mfma_f32_32x32x16_bf16(a, b, acc[nb], 0, 0, 0); }
        }
        __syncthreads();
        { float* ot = (float*)(F.lds + LO);
#pragma unroll
          for (int nb = 0; nb < 2; ++nb)
#pragma unroll
            for (int r = 0; r < 16; ++r) { const int t = 32 * wr + (r & 3) + 8 * (r >> 2) + 4 * hi; ot[t * 132 + 64 * wc + 32 * nb + r32] = acc[nb][r]; }
          __syncthreads();
#pragma unroll
          for (int i = 0; i < 4; ++i) { const int cid = tid + 512 * i, t = cid >> 4, ch = cid & 15; const int col = g * 128 + ch * 8;
            const f32x4 m0 = *(const f32x4*)(ot + t * 132 + ch * 8), m1 = *(const f32x4*)(ot + t * 132 + ch * 8 + 4);
            const u32x4 u = *(const u32x4*)(P + (size_t)(t0 + t) * PW + OFF_U + col); const float bb = F_b_sp[g * 128 + t];
            float uf[8];
#pragma unroll
            for (int e = 0; e < 4; ++e) { uf[2 * e] = __uint_as_float(u[e] << 16); uf[2 * e + 1] = __uint_as_float(u[e] & 0xffff0000u); }
            if (GELU_U_LATE) {
#pragma unroll
                for (int e = 0; e < 8; ++e) uf[e] = gelu_tanh(uf[e]); }
            u32x4 y; y.x = pk2(uf[0] * (m0.x + bb), uf[1] * (m0.y + bb)); y.y = pk2(uf[2] * (m0.z + bb), uf[3] * (m0.w + bb));
            y.z = pk2(uf[4] * (m1.x + bb), uf[5] * (m1.y + bb)); y.w = pk2(uf[6] * (m1.z + bb), uf[7] * (m1.w + bb));
            *(u32x4*)(F_YA + (size_t)(t0 + t) * AW + col) = y; } }
    }
    __syncthreads();
}
__device__ __forceinline__ void route_thread(Frame& F, int t, const float* lg36, float rstd) {
    float lg[4];
#pragma unroll
    for (int i = 0; i < 4; ++i) lg[i] = lg36[32 + i] * rstd + F_b_rg[i];
    int grp = 0; float m = lg[0];
#pragma unroll
    for (int i = 1; i < 4; ++i) if (lg[i] > m) { m = lg[i]; grp = i; }
    float ssum = 0.f;
#pragma unroll
    for (int i = 0; i < 4; ++i) ssum += __expf(lg[i] - m);
    const float pg = 1.0f / ssum;
    float le[8];
#pragma unroll
    for (int i = 0; i < 8; ++i) le[i] = lg36[grp * 8 + i] * rstd + F_b_re[grp * 8 + i];
    int i1 = 0; float v1 = le[0];
#pragma unroll
    for (int i = 1; i < 8; ++i) if (le[i] > v1) { v1 = le[i]; i1 = i; }
    int i2 = -1; float v2 = -3.0e38f;
#pragma unroll
    for (int i = 0; i < 8; ++i) if (i != i1 && le[i] > v2) { v2 = le[i]; i2 = i; }
    const float ed = __expf(v2 - v1), pe1 = 1.0f / (1.0f + ed), pe2 = ed * pe1;
    const int e0 = grp * 8 + i1, e1 = grp * 8 + i2;
    const int p0 = (int)atomicAdd(F_ctl + CW_CNT + CNT_STRIDE * e0, 1u), p1 = (int)atomicAdd(F_ctl + CW_CNT + CNT_STRIDE * e1, 1u);
    F_LTOK[e0 * T + p0] = t; F_LW[e0 * T + p0] = pg * pe1; F_LRSTD[e0 * T + p0] = rstd;
    F_LTOK[e1 * T + p1] = t; F_LW[e1 * T + p1] = pg * pe2; F_LRSTD[e1 * T + p1] = rstd;
    F_TINFO[t * 4 + 0] = e0; F_TINFO[t * 4 + 1] = e1; F_TINFO[t * 4 + 2] = p0; F_TINFO[t * 4 + 3] = p1;
}
__device__ __forceinline__ void p5_router_mfma(Frame& F) {
    float* xs = (float*)F.lds;
    float* part = xs + 32 * 513;
    float* ssq = part + 8 * 32 * 36;
    float* lgt = ssq + 256;
    const int tid = F.tid, lane = F.lane, wid = F.wave, r32 = lane & 31, hi = lane >> 5;
    const float *X1 = F_out, *gf = F_g_ffn, *Wre = F_w_re, *Wrg = F_w_rg;
    for (int tb = F.bid; tb < T / 32; tb += F.G) {
        const int t0 = tb * 32;
        f32x16 acc, accg;
#pragma unroll
        for (int r = 0; r < 16; ++r) { acc[r] = 0.f; accg[r] = 0.f; }
        f32x4 xv[8];
#pragma unroll
        for (int i = 0; i < 8; ++i) { const int idx = tid + 512 * i, row = idx >> 7, c4 = idx & 127; xv[i] = *(const f32x4*)(X1 + (size_t)(t0 + row) * D + c4 * 4); }
        for (int kc = 0; kc < 4; ++kc) {
            __syncthreads();
#pragma unroll
            for (int i = 0; i < 8; ++i) { const int idx = tid + 512 * i, row = idx >> 7, c4 = idx & 127;
                const f32x4 v = xv[i], g = *(const f32x4*)(gf + kc * 512 + c4 * 4);
                const float ss = wave_sum((v.x * v.x + v.y * v.y) + (v.z * v.z + v.w * v.w));
                if (lane == 0) ssq[row * 8 + kc * 2 + (wid & 1)] = ss;
                float* d = xs + row * 513 + c4 * 4; d[0] = v.x * g.x; d[1] = v.y * g.y; d[2] = v.z * g.z; d[3] = v.w * g.w; }
            const int kw0 = wid * 64; float wb[32], wg[32];
#pragma unroll
            for (int s = 0; s < 32; ++s) { const int kg = kc * 512 + kw0 + 2 * s + hi; wb[s] = Wre[(size_t)kg * 32 + r32]; wg[s] = (r32 < 4) ? Wrg[(size_t)kg * 4 + r32] : 0.f; }
            if (kc < 3) {
#pragma unroll
                for (int i = 0; i < 8; ++i) { const int idx = tid + 512 * i, row = idx >> 7, c4 = idx & 127; xv[i] = *(const f32x4*)(X1 + (size_t)(t0 + row) * D + (kc + 1) * 512 + c4 * 4); } }
            __syncthreads();
#pragma unroll
            for (int s = 0; s < 32; ++s) { const float a = xs[r32 * 513 + kw0 + 2 * s + hi];
                acc = __builtin_amdgcn_mfma_f32_32x32x2f32(a, wb[s], acc, 0, 0, 0); accg = __builtin_amdgcn_mfma_f32_32x32x2f32(a, wg[s], accg, 0, 0, 0); }
        }
#pragma unroll
        for (int r = 0; r < 16; ++r) { const int i = (r & 3) + 8 * (r >> 2) + 4 * hi; part[(wid * 32 + i) * 36 + r32] = acc[r]; if (r32 < 4) part[(wid * 32 + i) * 36 + 32 + r32] = accg[r]; }
        __syncthreads();
        for (int o = tid; o < 32 * 36; o += NTHR) { float s = 0.f;
#pragma unroll
            for (int w = 0; w < 8; ++w) s += part[w * 1152 + o];
            lgt[o] = s; }
        __syncthreads();
        if (tid < 32) { float s = 0.f;
#pragma unroll
            for (int q = 0; q < 8; ++q) s += ssq[tid * 8 + q];
            route_thread(F, t0 + tid, lgt + tid * 36, rsqrtf(s * (1.f / D) + EPS)); }
    }
    __syncthreads();
}


__device__ __forceinline__ void route_decide(Frame& F, const float* lg36, float rstd, int& e0, int& e1, float& w0, float& w1) {
    float lg[4];
#pragma unroll
    for (int i = 0; i < 4; ++i) lg[i] = lg36[32 + i] * rstd + F_b_rg[i];
    int grp = 0; float m = lg[0];
#pragma unroll
    for (int i = 1; i < 4; ++i) if (lg[i] > m) { m = lg[i]; grp = i; }
    float ssum = 0.f;
#pragma unroll
    for (int i = 0; i < 4; ++i) ssum += __expf(lg[i] - m);
    const float pg = 1.0f / ssum;
    float le[8];
#pragma unroll
    for (int i = 0; i < 8; ++i) le[i] = lg36[grp * 8 + i] * rstd + F_b_re[grp * 8 + i];
    int i1 = 0; float v1 = le[0];
#pragma unroll
    for (int i = 1; i < 8; ++i) if (le[i] > v1) { v1 = le[i]; i1 = i; }
    int i2 = -1; float v2 = -3.0e38f;
#pragma unroll
    for (int i = 0; i < 8; ++i) if (i != i1 && le[i] > v2) { v2 = le[i]; i2 = i; }
    const float ed = __expf(v2 - v1), pe1 = 1.0f / (1.0f + ed), pe2 = ed * pe1;
    e0 = grp * 8 + i1; e1 = grp * 8 + i2; w0 = pg * pe1; w1 = pg * pe2;
}
__device__ __forceinline__ void p5_router_split(Frame& F) {
    unsigned char* ahL = F.lds; unsigned char* alL = F.lds + 32 * 1040;
    float* part = (float*)F.lds;
    float* ssq = (float*)(F.lds + 66560);
    float* lgt = ssq + 256;
    int* lcnt = (int*)(lgt + 32 * 36); int* lbase = lcnt + 32;
    const int tid = F.tid, lane = F.lane, wid = F.wave, r32 = lane & 31, hi = lane >> 5;
    const float* X1 = F_out; const bf16* WF = WSP(bf16, WS_WRH);
    for (int tb = F.bid; tb < T / 32; tb += F.G) {
        const int t0 = tb * 32;
        f32x16 acc0, acc1;
#pragma unroll
        for (int r = 0; r < 16; ++r) { acc0[r] = 0.f; acc1[r] = 0.f; }
        f32x4 xv[8];
#pragma unroll
        for (int i = 0; i < 8; ++i) { const int idx = tid + 512 * i, row = idx >> 7, c4 = idx & 127; xv[i] = *(const f32x4*)(X1 + (size_t)(t0 + row) * D + c4 * 4); }
        for (int kc = 0; kc < 4; ++kc) {
            __syncthreads();
#pragma unroll
            for (int i = 0; i < 8; ++i) { const int idx = tid + 512 * i, row = idx >> 7, c4 = idx & 127; const f32x4 v = xv[i];
                const float ss = wave_sum((v.x * v.x + v.y * v.y) + (v.z * v.z + v.w * v.w));
                if (lane == 0) ssq[row * 8 + kc * 2 + (wid & 1)] = ss;
                u32x2 ph, pl; ph.x = pg8::cvt_pk_bf16(v.x, v.y); ph.y = pg8::cvt_pk_bf16(v.z, v.w);
                pl.x = pg8::cvt_pk_bf16(v.x - __uint_as_float(ph.x << 16), v.y - __uint_as_float(ph.x & 0xffff0000u)); pl.y = pg8::cvt_pk_bf16(v.z - __uint_as_float(ph.y << 16), v.w - __uint_as_float(ph.y & 0xffff0000u));
                *(u32x2*)(ahL + row * 1040 + c4 * 8) = ph; *(u32x2*)(alL + row * 1040 + c4 * 8) = pl; }
            s16x8 bfr[4][4];
            { const bf16* wp = WF + ((size_t)(kc * 8 + wid) * 4) * 2048 + lane * 8;
#pragma unroll
              for (int s4 = 0; s4 < 4; ++s4)
#pragma unroll
                for (int q = 0; q < 4; ++q) bfr[s4][q] = *(const s16x8*)(wp + (size_t)s4 * 2048 + q * 512); }
            if (kc < 3) {
#pragma unroll
                for (int i = 0; i < 8; ++i) { const int idx = tid + 512 * i, row = idx >> 7, c4 = idx & 127; xv[i] = *(const f32x4*)(X1 + (size_t)(t0 + row) * D + (kc + 1) * 512 + c4 * 4); } }
            __syncthreads();
#pragma unroll
            for (int s4 = 0; s4 < 4; ++s4) { const int ko = (64 * wid + 16 * s4 + 8 * hi) * 2;
                const s16x8 ah = *(const s16x8*)(ahL + r32 * 1040 + ko), al = *(const s16x8*)(alL + r32 * 1040 + ko);
                acc0 = __builtin_amdgcn_mfma_f32_32x32x16_bf16(ah, bfr[s4][0], acc0, 0, 0, 0); acc0 = __builtin_amdgcn_mfma_f32_32x32x16_bf16(ah, bfr[s4][1], acc0, 0, 0, 0); acc0 = __builtin_amdgcn_mfma_f32_32x32x16_bf16(al, bfr[s4][0], acc0, 0, 0, 0);
                acc1 = __builtin_amdgcn_mfma_f32_32x32x16_bf16(ah, bfr[s4][2], acc1, 0, 0, 0); acc1 = __builtin_amdgcn_mfma_f32_32x32x16_bf16(ah, bfr[s4][3], acc1, 0, 0, 0); acc1 = __builtin_amdgcn_mfma_f32_32x32x16_bf16(al, bfr[s4][2], acc1, 0, 0, 0); }
        }
        __syncthreads();
#pragma unroll
        for (int r = 0; r < 16; ++r) { const int i = (r & 3) + 8 * (r >> 2) + 4 * hi; part[(wid * 32 + i) * 64 + r32] = acc0[r]; if (r32 < 4) part[(wid * 32 + i) * 64 + 32 + r32] = acc1[r]; }
        if (tid < 32) lcnt[tid] = 0;
        __syncthreads();
        for (int o = tid; o < 32 * 36; o += NTHR) { const int i = o / 36, j = o - i * 36; float s = 0.f;
#pragma unroll
            for (int w = 0; w < 8; ++w) s += part[(w * 32 + i) * 64 + j];
            lgt[o] = s; }
        __syncthreads();
        int e0 = 0, e1 = 0, q0 = 0, q1 = 0; float w0 = 0.f, w1 = 0.f, rstd = 0.f;
        if (tid < 32) { float s = 0.f;
#pragma unroll
            for (int q = 0; q < 8; ++q) s += ssq[tid * 8 + q];
            rstd = rsqrtf(s * (1.f / D) + EPS);
            route_decide(F, lgt + tid * 36, rstd, e0, e1, w0, w1);
            q0 = atomicAdd(&lcnt[e0], 1); q1 = atomicAdd(&lcnt[e1], 1); }
        __syncthreads();
        if (tid < 32) { const int n = lcnt[tid]; lbase[tid] = n ? (int)atomicAdd(F_ctl + CW_CNT + CNT_STRIDE * tid, (unsigned)n) : 0; }
        __syncthreads();
        if (tid < 32) { const int t = t0 + tid, p0 = lbase[e0] + q0, p1 = lbase[e1] + q1;
            F_LTOK[e0 * T + p0] = t; F_LW[e0 * T + p0] = w0; F_LRSTD[e0 * T + p0] = rstd;
            F_LTOK[e1 * T + p1] = t; F_LW[e1 * T + p1] = w1; F_LRSTD[e1 * T + p1] = rstd;
            F_TINFO[t * 4 + 0] = e0; F_TINFO[t * 4 + 1] = e1; F_TINFO[t * 4 + 2] = p0; F_TINFO[t * 4 + 3] = p1; }
    }
    __syncthreads();
}
#define XB_TMO      128
#define XB_XCNT(j)  (256  + 64 * (j))
#define XB_XSUB(j)  (1280 + 64 * (j))
#define XB_XGEN(j)  (2304 + 64 * (j))
#define XB_TOP      3328
#define XB_TOPGEN   3392
#define XCD_BAR_WORDS 3456
#define XB_SPIN_CAP (1u << 18)
__device__ __forceinline__ unsigned xb_ld(unsigned* p)              { return __hip_atomic_load(p, __ATOMIC_RELAXED, __HIP_MEMORY_SCOPE_AGENT); }
__device__ __forceinline__ unsigned xb_add(unsigned* p, unsigned v) { return __hip_atomic_fetch_add(p, v, __ATOMIC_RELAXED, __HIP_MEMORY_SCOPE_AGENT); }
__device__ __forceinline__ unsigned xb_xcc_id() { return (unsigned)__builtin_amdgcn_s_getreg((3 << 11) | 20) & 0xFu; }
#define XB_SPIN(cond, bar) do { unsigned _sp = 0; while (cond) { __builtin_amdgcn_s_sleep(1); \
    if ((++_sp & 255u) == 0u) { if (xb_ld(&(bar)[XB_TMO])) break; if (_sp > XB_SPIN_CAP) { atomicAdd(&(bar)[XB_TMO], 1u); break; } } } } while (0)
struct XcdBarrier { unsigned* bar; unsigned x; volatile LAS unsigned* st; };
__device__ __forceinline__ XcdBarrier xcd_barrier_post(unsigned* bar, volatile LAS unsigned* st) {
    XcdBarrier b; b.bar = bar; b.x = xb_xcc_id(); b.st = st;
    if (threadIdx.x == 0) (void)xb_add(&bar[XB_XCNT(b.x)], 1u);
    return b;
}
__device__ __forceinline__ void xcd_barrier_complete(unsigned* bar, unsigned x, unsigned& nloc, unsigned& nx) {
    const unsigned G = gridDim.x * gridDim.y * gridDim.z;
    unsigned sum, cnt, mine, sp = 0u;
    for (;;) {
        sum = 0u; cnt = 0u; mine = 0u;
#pragma unroll
        for (unsigned j = 0; j < 16; ++j) { const unsigned c = xb_ld(&bar[XB_XCNT(j)]); sum += c; cnt += (c > 0u) ? 1u : 0u; mine = (j == x) ? c : mine; }
        if (sum == G) break;
        __builtin_amdgcn_s_sleep(1);
        if ((++sp & 255u) == 0u) { if (xb_ld(&bar[XB_TMO])) break; if (sp > XB_SPIN_CAP) { atomicAdd(&bar[XB_TMO], 1u); break; } }
    }
    nloc = mine > 0u ? mine : 1u; nx = cnt > 0u ? cnt : 1u;
}
__device__ __forceinline__ void xcd_barrier(const XcdBarrier& b) {
    asm volatile("s_waitcnt vmcnt(0)" ::: "memory");
    __syncthreads();
    if (threadIdx.x == 0) {
        unsigned* bar = b.bar;
        __builtin_amdgcn_s_waitcnt(0);
        unsigned nloc = b.st[0], nx = b.st[1];
        if (nloc == 0u) { xcd_barrier_complete(bar, b.x, nloc, nx); b.st[0] = nloc; b.st[1] = nx; }
        const unsigned old = xb_add(&bar[XB_XSUB(b.x)], 1u);
        const unsigned gen = old / nloc;
        if (old + 1u == (gen + 1u) * nloc) {
            __builtin_amdgcn_fence(__ATOMIC_RELEASE, "agent");
            asm volatile("s_waitcnt vmcnt(0)" ::: "memory");
            const unsigned og = xb_add(&bar[XB_TOP], 1u);
            const unsigned tg = og / nx;
            if (og + 1u == (tg + 1u) * nx) xb_add(&bar[XB_TOPGEN], 1u);
            else XB_SPIN(xb_ld(&bar[XB_TOPGEN]) == tg, bar);
            __builtin_amdgcn_fence(__ATOMIC_ACQUIRE, "agent");
            xb_add(&bar[XB_XGEN(b.x)], 1u);
            asm volatile("s_waitcnt vmcnt(0)" ::: "memory");
        } else {
            XB_SPIN(xb_ld(&bar[XB_XGEN(b.x)]) == gen, bar);
            __builtin_amdgcn_fence(__ATOMIC_ACQUIRE, "agent");
            asm volatile("s_waitcnt vmcnt(0)" ::: "memory");
        }
    }
    __syncthreads();
}
constexpr int CW_BAR = 4096; static_assert((CW_BAR + XCD_BAR_WORDS) * 4 <= (int)CTL_ZERO_BYTES, "barrier words inside the zeroed control region");
constexpr int XB_LDS_OFF = LDS_BYTES - 16;
__global__ void __launch_bounds__(NTHR, 2) fwd_kernel(Args args) {
    extern __shared__ __attribute__((aligned(16))) unsigned char lds[];
    cg::grid_group grid = cg::this_grid();
    Frame F;
    F.lds = lds; F.tid = threadIdx.x; F.lane = F.tid & 63; F.wave = __builtin_amdgcn_readfirstlane(F.tid >> 6); F.G = gridDim.x; F.bid = blockIdx.x; F.A = &args;
    const int lo = args.ph_lo, hi = args.ph_hi;
#define IN(k) (lo <= (k) && (k) < hi)
    volatile LAS unsigned* xbst = (volatile LAS unsigned*)((LAS unsigned char*)lds + XB_LDS_OFF);
    if (F.tid < 4) xbst[F.tid] = 0u;
    __syncthreads();
    XcdBarrier xbar = xcd_barrier_post(F_ctl + CW_BAR, xbst);
#define SEAM(k) do { if (IN(k) && IN((k) + 1)) { if (!XCD_BARRIER || args.use_cg) grid.sync(); else xcd_barrier(xbar); } } while (0)
    if (IN(0)) { if (MFMA_MASK) p0_weights(F); if (ROUTER_MFMA == 2) p0_router_weights(F); p0_prologue(F); if (PROBE_REPEAT & (1 << 0)) { grid.sync(); if (MFMA_MASK) p0_weights(F); p0_prologue(F); } } SEAM(0);
    if (IN(1)) { if (MFMA_MASK & 1) p1_proj_mfma(F); else p1_proj(F); if (PROBE_REPEAT & (1 << 1)) { grid.sync(); if (MFMA_MASK & 1) p1_proj_mfma(F); else p1_proj(F); } } SEAM(1);
    if (IN(2)) { p2_gating_mfma(F, false); if (ATTN_MFMA) p2_attn_mfma(F); else p2_attn(F); if (PROBE_REPEAT & 4) { grid.sync(); if (ATTN_MFMA) p2_attn_mfma(F); else p2_attn(F); } } SEAM(2);
    if (IN(3)) { if (MFMA_MASK & 2) p3_branch_mfma(F); else p3_branch(F); if (PROBE_REPEAT & (1 << 3)) { grid.sync(); if (MFMA_MASK & 2) p3_branch_mfma(F); else p3_branch(F); } } SEAM(3);
    if (IN(4)) { if (MFMA_MASK & 4) p4_out_mfma(F); else p4_out(F); } SEAM(4);
    if (IN(5)) { if (ROUTER_MFMA == 2) p5_router_split(F); else if (ROUTER_MFMA) p5_router_mfma(F); else p5_router(F); } SEAM(5);
    if (IN(6)) { if (MFMA_MASK & 8) p6_gateup_mfma(F); else p6_gateup(F); if (PROBE_REPEAT & (1 << 6)) { grid.sync(); if (MFMA_MASK & 8) p6_gateup_mfma(F); else p6_gateup(F); } } SEAM(6);
    if (IN(7)) { if (MFMA_MASK & 16) p7_down_mfma(F, IN(6) && (MFMA_MASK & 8) && !(PROBE_REPEAT & (1 << 6))); else p7_down(F); if (PROBE_REPEAT & (1 << 7)) { grid.sync(); if (MFMA_MASK & 16) p7_down_mfma(F, IN(6) && (MFMA_MASK & 8) && !(PROBE_REPEAT & (1 << 6))); else p7_down(F); } } SEAM(7);
    if (IN(8)) { p8_final(F, IN(6) && (MFMA_MASK & 8)); }
#undef IN
#undef SEAM
}

extern "C" void kernel_launch(void* const* d_in, const int* in_sizes, int n_in, void* d_out, int out_size, void* d_ws, size_t ws_size, hipStream_t stream) {
    static int grid = 0;
    if (grid == 0) {
        if (n_in != 19 || out_size != T * D || ws_size < WS_END) { fprintf(stderr, "kernel_launch: unexpected problem (n_in %d out %d ws %zu)\n", n_in, out_size, ws_size); grid = -1; return; }
        int dev = 0, cus = 0, per_cu = 0;
        hipGetDevice(&dev); hipDeviceGetAttribute(&cus, hipDeviceAttributeMultiprocessorCount, dev);
        if (hipFuncSetAttribute((const void*)fwd_kernel, hipFuncAttributeMaxDynamicSharedMemorySize, LDS_BYTES) != hipSuccess) { fprintf(stderr, "kernel_launch: hipFuncSetAttribute failed\n"); grid = -1; return; }
        if (hipOccupancyMaxActiveBlocksPerMultiprocessor(&per_cu, (const void*)fwd_kernel, NTHR, LDS_BYTES) != hipSuccess || per_cu < 1) { fprintf(stderr, "kernel_launch: occupancy query says %d\n", per_cu); per_cu = 1; }
        (void)hipGetLastError();
        grid = cus;
    }
    if (grid < 0) return;
    hipMemsetAsync((char*)d_ws + WS_CTL, 0, CTL_ZERO_BYTES, stream);
    Args a{};
    for (int i = 0; i < 19; ++i) a.in[i] = (const float*)d_in[i];
    a.out = (float*)d_out; a.ws = (unsigned char*)d_ws; a.use_cg = USE_CG_SEAMS; a.pad = 0;
    if (N_LAUNCH_MODE == 1) {
        a.ph_lo = 0; a.ph_hi = N_PHASES; void* kargs[] = {&a};
        hipError_t e = hipLaunchCooperativeKernel((const void*)fwd_kernel, dim3(grid), dim3(NTHR), kargs, LDS_BYTES, stream);
        if (e != hipSuccess) fprintf(stderr, "cooperative launch failed: %s\n", hipGetErrorString(e));
    } else {
        for (int p = 0; p < N_PHASES; ++p) {
            a.ph_lo = p; a.ph_hi = p + 1; void* kargs[] = {&a};
            hipError_t e = hipLaunchCooperativeKernel((const void*)fwd_kernel, dim3(grid), dim3(NTHR), kargs, LDS_BYTES, stream);
            if (e != hipSuccess) { fprintf(stderr, "cooperative launch %d failed: %s\n", p, hipGetErrorString(e)); break; }
        }
    }
}
```

```cpp
#include <hip/hip_runtime.h>
#include <hip/hip_cooperative_groups.h>
#include <cstdio>
#include <cstdint>
namespace cg = cooperative_groups;

#ifndef N_LAUNCH_MODE
#define N_LAUNCH_MODE 1
#endif
#ifndef MFMA_MASK
#define MFMA_MASK 0x1f
#endif
#ifndef ATTN_MFMA
#define ATTN_MFMA 1
#endif
#ifndef ROUTER_MFMA
#define ROUTER_MFMA 2
#endif
#ifndef XCD_BARRIER
#define XCD_BARRIER 1
#endif
#ifndef GATING_MFMA
#define GATING_MFMA 1
#endif
#ifndef OVERLAP_CONV
#define OVERLAP_CONV 1
#endif
#ifndef CONV_CUS
#define CONV_CUS 104
#endif
#ifndef MOE_EARLY_DOWN
#define MOE_EARLY_DOWN 1
#endif
#ifndef EARLY_GATING
#define EARLY_GATING 1
#endif
#ifndef USE_CG_SEAMS
#define USE_CG_SEAMS 0
#endif
#ifndef PROBE_REPEAT
#define PROBE_REPEAT 0
#endif
#ifndef ATTN_EARLY_EXIT
#define GELU_U_LATE ((MFMA_MASK & 1) != 0)
#define WT_STORES 1
#define ATTN_EARLY_EXIT 1
#endif

constexpr int T = 8192, D = 2048, PW = 9216, AW = 1024, NH = 8, HD = 128, CHK = 128, NGRP = 4, EPG = 8, NE = 32, DE = 1024;
constexpr int OFF_U = 0, OFF_GV = 1024, OFF_Q = 2048, OFF_K = 3072, OFF_V = 4096, OFF_GA = 5120, OFF_GB = 7168;
constexpr float EPS = 1e-6f;
constexpr int NWAVES = 8, NTHR = 512;
constexpr int N_PHASES = 9;

constexpr size_t MiB = 1u << 20;
constexpr size_t WS_CTL = 0, CTL_ZERO_BYTES = 65536;
constexpr size_t WS_LTOK = 1 * MiB, WS_LW = 2 * MiB, WS_LRSTD = 3 * MiB, WS_TINFO = 4 * MiB;
constexpr size_t WS_WRH = 5 * MiB, WS_WRL = 5 * MiB + 262144;
constexpr size_t WS_WIN_T = 8 * MiB, WS_WA_T = 44 * MiB, WS_WB_T = 48 * MiB, WS_WOUT_T = 52 * MiB, WS_WGU_T = 64 * MiB, WS_WD_T = 320 * MiB;
constexpr size_t WS_XN = 448 * MiB, WS_PROJ = 480 * MiB, WS_YA = 624 * MiB, WS_YB = 640 * MiB, WS_MERGED = 656 * MiB, WS_H2 = 688 * MiB;
constexpr size_t WS_HDN = 720 * MiB, WS_Y = 768 * MiB, WS_TMP = 864 * MiB, WS_END = 928 * MiB;
constexpr int SLOT_CAP = 24576;
constexpr int CW_CNT = 1024, CNT_STRIDE = 64;

constexpr int LDS_BYTES = 147456;

#define LAS __attribute__((address_space(3)))
typedef unsigned short bf16;
typedef float f32x4 __attribute__((ext_vector_type(4)));
typedef unsigned u32x4 __attribute__((ext_vector_type(4)));
typedef unsigned u32x2 __attribute__((ext_vector_type(2)));

__device__ __forceinline__ float bf2f(bf16 v) { return __uint_as_float((unsigned)v << 16); }
__device__ __forceinline__ unsigned f2bf(float f) { unsigned u = __float_as_uint(f); return (u + 0x7fffu + ((u >> 16) & 1u)) >> 16; }
__device__ __forceinline__ unsigned pk2(float lo, float hi) { return f2bf(lo) | (f2bf(hi) << 16); }
__device__ __forceinline__ float wave_sum(float v) {
#pragma unroll
    for (int o = 1; o < 64; o <<= 1) v += __shfl_xor(v, o);
    return v;
}
__device__ __forceinline__ float sigmoidf_(float x) { return __builtin_amdgcn_rcpf(1.0f + __builtin_amdgcn_exp2f(fmaxf(x * -1.4426950408889634f, -126.f) )); }
__device__ __forceinline__ float gelu_tanh(float x) { const float x2 = x * x; const float t = x * (-2.302208198f - 0.1029432397f * x2); return x * __builtin_amdgcn_rcpf(1.0f + __builtin_amdgcn_exp2f(fminf(t, 126.f))); }

struct Args { const float* in[19]; float* out; unsigned char* ws; int ph_lo, ph_hi; int use_cg, pad; };

struct Frame {
    unsigned char* lds;
    int tid, lane, wave, G, bid;
    const Args* A;
};
#define IN_(i) (F.A->in[i])
#define F_x IN_(0)
#define F_g_mix IN_(1)
#define F_w_in IN_(2)
#define F_ln_g IN_(3)
#define F_ln_b IN_(4)
#define F_w_sp IN_(5)
#define F_b_sp IN_(6)
#define F_w_a IN_(7)
#define F_w_b IN_(8)
#define F_w_out IN_(9)
#define F_g_ffn IN_(10)
#define F_w_rg IN_(11)
#define F_b_rg IN_(12)
#define F_w_re IN_(13)
#define F_b_re IN_(14)
#define F_w_gate IN_(15)
#define F_w_up IN_(16)
#define F_w_down IN_(17)
#define F_g_final IN_(18)
#define F_out (F.A->out)
#define WSP(type, off) ((type*)(F.A->ws + (off)))
#define F_ctl WSP(unsigned, WS_CTL)
#define F_XN WSP(bf16, WS_XN)
#define F_PROJ WSP(bf16, WS_PROJ)
#define F_YA WSP(bf16, WS_YA)
#define F_YB WSP(bf16, WS_YB)
#define F_MERGED WSP(bf16, WS_MERGED)
#define F_H2 WSP(bf16, WS_H2)
#define F_HDN WSP(bf16, WS_HDN)
#define F_Y WSP(bf16, WS_Y)
#define F_TMP WSP(float, WS_TMP)
#define F_LTOK WSP(int, WS_LTOK)
#define F_LW WSP(float, WS_LW)
#define F_LRSTD WSP(float, WS_LRSTD)
#define F_TINFO WSP(int, WS_TINFO)

template <bool DUAL, class AF, class BF, class BF2, class EP>
__device__ __forceinline__ void ngemm(unsigned char* lds_, int tid, int M, int N, int K, int tile0, int tstride, AF af, BF bfn, BF2 bfn2, EP ep) {
    float* As = (float*)lds_;
    float* Bs = As + 16 * 132;
    float* Bs2 = Bs + 16 * 68;
    const int mt = (M + 127) / 128, nt = N / 64, ntile = mt * nt;
    const int ty = tid >> 4, tx = tid & 15;
    for (int L = tile0; L < ntile; L += tstride) {
        const int m0 = (L / nt) * 128, n0 = (L % nt) * 64;
        float acc[4][4], acc2[4][4];
#pragma unroll
        for (int i = 0; i < 4; ++i)
#pragma unroll
            for (int j = 0; j < 4; ++j) { acc[i][j] = 0.f; acc2[i][j] = 0.f; }
        for (int k0 = 0; k0 < K; k0 += 16) {
            __syncthreads();
#pragma unroll
            for (int i = 0; i < 4; ++i) { const int idx = tid * 4 + i, r = idx >> 4, kk = idx & 15; const int row = m0 + r; As[kk * 132 + r] = (row < M) ? af(row, k0 + kk) : 0.f; }
#pragma unroll
            for (int i = 0; i < 2; ++i) { const int idx = tid * 2 + i, kk = idx >> 6, n = idx & 63; Bs[kk * 68 + n] = bfn(k0 + kk, n0 + n); if (DUAL) Bs2[kk * 68 + n] = bfn2(k0 + kk, n0 + n); }
            __syncthreads();
#pragma unroll
            for (int kk = 0; kk < 16; ++kk) {
                const f32x4 a = *(const f32x4*)(As + kk * 132 + ty * 4), b = *(const f32x4*)(Bs + kk * 68 + tx * 4);
                f32x4 b2 = (f32x4){0.f, 0.f, 0.f, 0.f}; if (DUAL) b2 = *(const f32x4*)(Bs2 + kk * 68 + tx * 4);
#pragma unroll
                for (int i = 0; i < 4; ++i)
#pragma unroll
                    for (int j = 0; j < 4; ++j) { acc[i][j] += a[i] * b[j]; if (DUAL) acc2[i][j] += a[i] * b2[j]; }
            }
        }
#pragma unroll
        for (int i = 0; i < 4; ++i) { const int row = m0 + ty * 4 + i; if (row < M) {
#pragma unroll
            for (int j = 0; j < 4; ++j) ep(row, n0 + tx * 4 + j, acc[i][j], acc2[i][j]); } }
    }
    __syncthreads();
}

__device__ __forceinline__ void p0_prologue(Frame& F) {
    const int gw = F.bid * NWAVES + F.wave, NGW = F.G * NWAVES;
    for (int g = F.bid * NTHR + F.tid; g < 3 * NE * T / 4; g += F.G * NTHR) ((u32x4*)F_LTOK)[g] = (u32x4){0u, 0u, 0u, 0u};
    for (int m = gw; m < T; m += NGW) {
        const f32x4* xr = (const f32x4*)(F_x + (size_t)m * D) + F.lane;
        f32x4 v[8]; float s = 0.f;
#pragma unroll
        for (int j = 0; j < 8; ++j) { v[j] = xr[64 * j]; s += (v[j].x * v[j].x + v[j].y * v[j].y) + (v[j].z * v[j].z + v[j].w * v[j].w); }
        const float rstd = rsqrtf(wave_sum(s) * (1.f / D) + EPS);
        u32x2* o = (u32x2*)(F_XN + (size_t)m * D) + F.lane;
#pragma unroll
        for (int j = 0; j < 8; ++j) { const f32x4 g = ((const f32x4*)F_g_mix)[64 * j + F.lane]; u32x2 w; w.x = pk2(v[j].x * rstd * g.x, v[j].y * rstd * g.y); w.y = pk2(v[j].z * rstd * g.z, v[j].w * rstd * g.w); o[64 * j] = w; }
    }
}

__device__ __forceinline__ float proj_act(int n, float a) {
    if (n < OFF_Q) return gelu_tanh(a);
    if (n < OFF_GA) return a;
    return sigmoidf_(a);
}
__device__ __forceinline__ void p1_proj(Frame& F) {
    const bf16* XN = F_XN; const float* W = F_w_in; bf16* P = F_PROJ;
    ngemm<false>(F.lds, F.tid, T, PW, D, F.bid, F.G,
        [=](int r, int k) { return bf2f(XN[(size_t)r * D + k]); },
        [=](int k, int n) { return W[(size_t)k * PW + n]; },
        [=](int k, int n) { return 0.f; },
        [=](int r, int n, float a, float) { P[(size_t)r * PW + n] = (bf16)f2bf(proj_act(n, a)); });
}

__device__ __forceinline__ void p2_gating(Frame& F) {
    float* vn = (float*)F.lds;
    float* wsm = vn + 128 * 128;
    float* st = wsm + 128 * 129;
    const int tid = F.tid;
    for (int item = F.bid; item < (T / CHK) * 8; item += F.G) {
        const int c = item >> 3, g = item & 7, t0 = c * CHK;
        __syncthreads();
        {
            const int r = tid >> 2, q = tid & 3; const bf16* row = F_PROJ + (size_t)(t0 + r) * PW + OFF_GV + q * 256;
            float s = 0.f, s2 = 0.f;
            for (int i = 0; i < 32; ++i) { const u32x4 w = ((const u32x4*)row)[i];
#pragma unroll
                for (int e = 0; e < 4; ++e) { const float a = __uint_as_float(w[e] << 16), b = __uint_as_float(w[e] & 0xffff0000u); s += a + b; s2 += a * a + b * b; } }
            s += __shfl_xor(s, 1); s += __shfl_xor(s, 2); s2 += __shfl_xor(s2, 1); s2 += __shfl_xor(s2, 2);
            const float mu = s * (1.f / AW), var = s2 * (1.f / AW) - mu * mu;
            if (q == 0) { st[r * 2] = mu; st[r * 2 + 1] = rsqrtf(fmaxf(var, 0.f) + EPS); }
        }
        for (int i = tid; i < 128 * 128; i += NTHR) { const int t = i >> 7, s = i & 127; wsm[t * 129 + s] = (s <= t) ? F_w_sp[(size_t)g * 16384 + i] : 0.f; }
        __syncthreads();
        for (int i = tid; i < 128 * 128; i += NTHR) { const int s = i >> 7, d = i & 127; const int ch = g * 128 + d;
            const float v = bf2f(F_PROJ[(size_t)(t0 + s) * PW + OFF_GV + ch]);
            vn[i] = (v - st[s * 2]) * st[s * 2 + 1] * F_ln_g[ch] + F_ln_b[ch]; }
        __syncthreads();
        {   const int t = tid >> 2, d0 = (tid & 3) * 32;
            float acc[32];
#pragma unroll
            for (int j = 0; j < 32; ++j) acc[j] = 0.f;
            for (int s = 0; s <= t; ++s) { const float w = wsm[t * 129 + s];
#pragma unroll
                for (int j = 0; j < 32; j += 4) { const f32x4 v = *(const f32x4*)(vn + s * 128 + d0 + j); acc[j] += w * v.x; acc[j + 1] += w * v.y; acc[j + 2] += w * v.z; acc[j + 3] += w * v.w; } }
            const float bb = F_b_sp[g * 128 + t];
            const bf16* urow = F_PROJ + (size_t)(t0 + t) * PW + OFF_U + g * 128 + d0; bf16* yrow = F_YA + (size_t)(t0 + t) * AW + g * 128 + d0;
#pragma unroll
            for (int j = 0; j < 32; ++j) { const float uu = bf2f(urow[j]); yrow[j] = (bf16)f2bf((GELU_U_LATE ? gelu_tanh(uu) : uu) * (acc[j] + bb)); }
        }
    }
    __syncthreads();
}

__device__ __forceinline__ void p2_attn(Frame& F) {
    float* qs = (float*)(F.lds) + F.wave * 128;
    const int gw = F.bid * NWAVES + F.wave, NGW = F.G * NWAVES, lane = F.lane;
    const float scale = 0.08838834764831845f;
    for (int item = gw; item < NH * T; item += NGW) {
        const int h = item / T, t = item % T;
        const bf16* qrow = F_PROJ + (size_t)t * PW + OFF_Q + h * HD;
        qs[lane] = bf2f(qrow[lane]) * scale; qs[lane + 64] = bf2f(qrow[lane + 64]) * scale;
        asm volatile("s_waitcnt lgkmcnt(0)" ::: "memory");
        float R = 1.f, o0 = 0.f, o1 = 0.f;
        const int nb = (t + 63) >> 6;
        for (int b = nb - 1; b >= 0; --b) {
            const int key = b * 64 + lane; const bool valid = key < t;
            const u32x4* krow = (const u32x4*)(F_PROJ + (size_t)key * PW + OFF_K + h * HD);
            float dot = 0.f;
#pragma unroll
            for (int c = 0; c < 16; ++c) { const u32x4 w = krow[c]; const f32x4 q0 = *(const f32x4*)(qs + c * 8), q1 = *(const f32x4*)(qs + c * 8 + 4);
                dot += __uint_as_float(w.x << 16) * q0.x + __uint_as_float(w.x & 0xffff0000u) * q0.y + __uint_as_float(w.y << 16) * q0.z + __uint_as_float(w.y & 0xffff0000u) * q0.w
                     + __uint_as_float(w.z << 16) * q1.x + __uint_as_float(w.z & 0xffff0000u) * q1.y + __uint_as_float(w.w << 16) * q1.z + __uint_as_float(w.w & 0xffff0000u) * q1.w; }
            const float z = fminf(dot, 80.f), e = __expf(z);
            float r = 1.0f / (1.0f + e), beta = e * r;
            if (!valid) { r = 1.f; beta = 0.f; }
            float s = r;
#pragma unroll
            for (int off = 1; off < 64; off <<= 1) { const float v = __shfl_down(s, off); if (lane + off < 64) s *= v; }
            float ex = __shfl_down(s, 1); if (lane == 63) ex = 1.f;
            const float w = beta * ex * R;
            R *= __shfl(s, 0);
            const bf16* vb = F_PROJ + (size_t)(b * 64) * PW + OFF_V + h * HD + lane;
            for (int j = 0; j < 64; ++j) { const float wj = __shfl(w, j); o0 += wj * bf2f(vb[(size_t)j * PW]); o1 += wj * bf2f(vb[(size_t)j * PW + 64]); }
            if (ATTN_EARLY_EXIT && R < 1e-30f) break;
        }
        bf16* yrow = F_YB + (size_t)t * AW + h * HD;
        yrow[lane] = (bf16)f2bf(o0); yrow[lane + 64] = (bf16)f2bf(o1);
    }
}

__device__ __forceinline__ void p3_branch(Frame& F) {
    const bf16 *YA = F_YA, *YB = F_YB, *P = F_PROJ; const float *Wa = F_w_a, *Wb = F_w_b; float* TMP = F_TMP; bf16* MG = F_MERGED;
    ngemm<false>(F.lds, F.tid, T, D, AW, F.bid, F.G,
        [=](int r, int k) { return bf2f(YA[(size_t)r * AW + k]); },
        [=](int k, int n) { return Wa[(size_t)k * D + n]; },
        [=](int k, int n) { return 0.f; },
        [=](int r, int n, float a, float) { TMP[(size_t)r * D + n] = a * bf2f(P[(size_t)r * PW + OFF_GA + n]); });
    ngemm<false>(F.lds, F.tid, T, D, AW, F.bid, F.G,
        [=](int r, int k) { return bf2f(YB[(size_t)r * AW + k]); },
        [=](int k, int n) { return Wb[(size_t)k * D + n]; },
        [=](int k, int n) { return 0.f; },
        [=](int r, int n, float a, float) { MG[(size_t)r * D + n] = (bf16)f2bf(TMP[(size_t)r * D + n] + a * bf2f(P[(size_t)r * PW + OFF_GB + n])); });
}

__device__ __forceinline__ void p4_out(Frame& F) {
    const bf16* MG = F_MERGED; const float *W = F_w_out, *x = F_x, *gf = F_g_ffn; float* X1 = F_out; bf16* H2 = F_H2;
    ngemm<false>(F.lds, F.tid, T, D, D, F.bid, F.G,
        [=](int r, int k) { return bf2f(MG[(size_t)r * D + k]); },
        [=](int k, int n) { return W[(size_t)k * D + n]; },
        [=](int k, int n) { return 0.f; },
        [=](int r, int n, float a, float) { const float v = x[(size_t)r * D + n] + a; X1[(size_t)r * D + n] = v; H2[(size_t)r * D + n] = (bf16)f2bf(v * gf[n]); });
}

__device__ __forceinline__ void route_token(Frame& F, int t, float logit, float rstd) {
    float lg[4], le[8];
#pragma unroll
    for (int i = 0; i < 4; ++i) lg[i] = __shfl(logit, 32 + i);
    int grp = 0; float m = lg[0];
#pragma unroll
    for (int i = 1; i < 4; ++i) if (lg[i] > m) { m = lg[i]; grp = i; }
    float ssum = 0.f;
#pragma unroll
    for (int i = 0; i < 4; ++i) ssum += __expf(lg[i] - m);
    const float pg = 1.0f / ssum;
#pragma unroll
    for (int i = 0; i < 8; ++i) le[i] = __shfl(logit, grp * 8 + i);
    int i1 = 0; float v1 = le[0];
#pragma unroll
    for (int i = 1; i < 8; ++i) if (le[i] > v1) { v1 = le[i]; i1 = i; }
    int i2 = -1; float v2 = -3.0e38f;
#pragma unroll
    for (int i = 0; i < 8; ++i) if (i != i1 && le[i] > v2) { v2 = le[i]; i2 = i; }
    const float ed = __expf(v2 - v1), pe1 = 1.0f / (1.0f + ed), pe2 = ed * pe1;
    if (F.lane == 0) {
        const int e0 = grp * 8 + i1, e1 = grp * 8 + i2;
        const int p0 = (int)atomicAdd(F_ctl + CW_CNT + CNT_STRIDE * e0, 1u), p1 = (int)atomicAdd(F_ctl + CW_CNT + CNT_STRIDE * e1, 1u);
        F_LTOK[e0 * T + p0] = t; F_LW[e0 * T + p0] = pg * pe1; F_LRSTD[e0 * T + p0] = rstd;
        F_LTOK[e1 * T + p1] = t; F_LW[e1 * T + p1] = pg * pe2; F_LRSTD[e1 * T + p1] = rstd;
        F_TINFO[t * 4 + 0] = e0; F_TINFO[t * 4 + 1] = e1; F_TINFO[t * 4 + 2] = p0; F_TINFO[t * 4 + 3] = p1;
    }
}
__device__ __forceinline__ void p5_router(Frame& F) {
    float* hs = (float*)F.lds + F.wave * 4096;
    const int gw = F.bid * NWAVES + F.wave, NGW = F.G * NWAVES, lane = F.lane;
    for (int tp = gw; tp < T / 2; tp += NGW) {
        float rstd[2];
#pragma unroll
        for (int tt = 0; tt < 2; ++tt) {
            const f32x4* xr = (const f32x4*)(F_out + (size_t)(tp * 2 + tt) * D) + lane; float s = 0.f;
#pragma unroll
            for (int j = 0; j < 8; ++j) { const f32x4 v = xr[64 * j], g = ((const f32x4*)F_g_ffn)[64 * j + lane]; s += (v.x * v.x + v.y * v.y) + (v.z * v.z + v.w * v.w);
                const int k = (64 * j + lane) * 4; hs[(k + 0) * 2 + tt] = v.x * g.x; hs[(k + 1) * 2 + tt] = v.y * g.y; hs[(k + 2) * 2 + tt] = v.z * g.z; hs[(k + 3) * 2 + tt] = v.w * g.w; }
            rstd[tt] = rsqrtf(wave_sum(s) * (1.f / D) + EPS);
        }
        asm volatile("s_waitcnt lgkmcnt(0)" ::: "memory");
        float a0 = 0.f, a1 = 0.f;
        const float* wp = (lane < 32) ? (F_w_re + lane) : (F_w_rg + ((lane - 32) & 3)); const int wst = (lane < 32) ? 32 : 4; const bool act = lane < 36;
#pragma unroll 8
        for (int k = 0; k < D; ++k) { const float w = act ? wp[(size_t)k * wst] : 0.f; const float h0 = hs[k * 2], h1 = hs[k * 2 + 1]; a0 += h0 * w; a1 += h1 * w; }
        const float bias = (lane < 32) ? F_b_re[lane] : (lane < 36 ? F_b_rg[lane - 32] : 0.f);
        route_token(F, tp * 2, a0 * rstd[0] + bias, rstd[0]);
        route_token(F, tp * 2 + 1, a1 * rstd[1] + bias, rstd[1]);
        asm volatile("s_waitcnt lgkmcnt(0)" ::: "memory");
    }
}

__device__ __forceinline__ void compute_pstart(Frame& F, int* ps) {
    __syncthreads();
    if (F.tid < NE) ps[40 + F.tid] = (int)__hip_atomic_load(F_ctl + CW_CNT + CNT_STRIDE * F.tid, __ATOMIC_RELAXED, __HIP_MEMORY_SCOPE_AGENT);
    __syncthreads();
    if (F.tid == 0) { int acc = 0; for (int e = 0; e < NE; ++e) { ps[e] = acc; const int c = ps[40 + e]; acc += ((c + 255) >> 8) << 8; } ps[NE] = acc; }
    __syncthreads();
}

__device__ __forceinline__ void p6_gateup(Frame& F) {
    int* ps = (int*)(F.lds + 65536); compute_pstart(F, ps);
    const bf16* H2 = F_H2; bf16* HDN = F_HDN; int base = 0;
    for (int e = 0; e < NE; ++e) {
        const int cnt = (int)__hip_atomic_load(F_ctl + CW_CNT + CNT_STRIDE * e, __ATOMIC_RELAXED, __HIP_MEMORY_SCOPE_AGENT); const int ntile = ((cnt + 127) / 128) * (DE / 64);
        const int first = ((F.bid - base) % F.G + F.G) % F.G;
        const int* ltok = F_LTOK + e * T; const float* lr = F_LRSTD + e * T; const float *Wg = F_w_gate + (size_t)e * D * DE, *Wu = F_w_up + (size_t)e * D * DE; const int p0 = ps[e];
        ngemm<true>(F.lds, F.tid, cnt, DE, D, first, F.G,
            [=](int r, int k) { return bf2f(H2[(size_t)ltok[r] * D + k]); },
            [=](int k, int n) { return Wg[(size_t)k * DE + n]; },
            [=](int k, int n) { return Wu[(size_t)k * DE + n]; },
            [=](int r, int n, float g, float u) { const float rs = lr[r]; const float gg = g * rs; HDN[(size_t)(p0 + r) * DE + n] = (bf16)f2bf(gg * sigmoidf_(gg) * (u * rs)); });
        base += ntile;
    }
}
__device__ __forceinline__ void p7_down(Frame& F) {
    int* ps = (int*)(F.lds + 65536); compute_pstart(F, ps);
    const bf16* HDN = F_HDN; bf16* Y = F_Y; int base = 0;
    for (int e = 0; e < NE; ++e) {
        const int cnt = (int)__hip_atomic_load(F_ctl + CW_CNT + CNT_STRIDE * e, __ATOMIC_RELAXED, __HIP_MEMORY_SCOPE_AGENT); const int ntile = ((cnt + 127) / 128) * (D / 64);
        const int first = ((F.bid - base) % F.G + F.G) % F.G;
        const float* lw = F_LW + e * T; const float* Wd = F_w_down + (size_t)e * DE * D; const int p0 = ps[e];
        ngemm<false>(F.lds, F.tid, cnt, D, DE, first, F.G,
            [=](int r, int k) { return bf2f(HDN[(size_t)(p0 + r) * DE + k]); },
            [=](int k, int n) { return Wd[(size_t)k * D + n]; },
            [=](int k, int n) { return 0.f; },
            [=](int r, int n, float a, float) { Y[(size_t)(p0 + r) * D + n] = (bf16)f2bf(a * lw[r]); });
        base += ntile;
    }
}
__device__ __forceinline__ void p8_final(Frame& F, bool have_tab) {
    int* ps = (int*)(F.lds + 65536); if (have_tab) ps = (int*)(F.lds + 131072 + 2048); else compute_pstart(F, ps);
    const int gw = F.bid * NWAVES + F.wave, NGW = F.G * NWAVES, lane = F.lane;
    for (int t = gw; t < T; t += NGW) {
        const int e0 = F_TINFO[t * 4], e1 = F_TINFO[t * 4 + 1], q0 = F_TINFO[t * 4 + 2], q1 = F_TINFO[t * 4 + 3];
        const u32x2* y0 = (const u32x2*)(F_Y + (size_t)(ps[e0] + q0) * D) + lane; const u32x2* y1 = (const u32x2*)(F_Y + (size_t)(ps[e1] + q1) * D) + lane;
        f32x4* xr = (f32x4*)(F_out + (size_t)t * D) + lane;
        f32x4 v[8]; float s = 0.f;
#pragma unroll
        for (int j = 0; j < 8; ++j) { v[j] = xr[64 * j]; const u32x2 a = y0[64 * j], b = y1[64 * j];
            v[j].x += __uint_as_float(a.x << 16) + __uint_as_float(b.x << 16); v[j].y += __uint_as_float(a.x & 0xffff0000u) + __uint_as_float(b.x & 0xffff0000u);
            v[j].z += __uint_as_float(a.y << 16) + __uint_as_float(b.y << 16); v[j].w += __uint_as_float(a.y & 0xffff0000u) + __uint_as_float(b.y & 0xffff0000u);
            s += (v[j].x * v[j].x + v[j].y * v[j].y) + (v[j].z * v[j].z + v[j].w * v[j].w); }
        const float rstd = rsqrtf(wave_sum(s) * (1.f / D) + EPS);
#pragma unroll
        for (int j = 0; j < 8; ++j) { const f32x4 g = ((const f32x4*)F_g_final)[64 * j + lane]; xr[64 * j] = (f32x4){v[j].x * rstd * g.x, v[j].y * rstd * g.y, v[j].z * rstd * g.z, v[j].w * rstd * g.w}; }
    }
}


namespace pg8 {
typedef short bf16x8 __attribute__((ext_vector_type(8)));
constexpr int BM = 256, BK = 64, HALF = 128, HTB = HALF * BK * 2, STAGE_BYTES = 8 * HTB, NXCD = 8, WGM = 8;
constexpr int GTAB_OFF = STAGE_BYTES;
constexpr int RTAB_OFF = 131072 + 8192;
__host__ __device__ __forceinline__ int lds_byte(int r, int c) { const int st = (r >> 4) * 2 + (c >> 5), rr = r & 15, cc = c & 31, ob = rr * 64 + cc * 2; return st * 1024 + (ob ^ (((ob >> 9) & 1) << 5)); }
__host__ __device__ __forceinline__ void stage_rc(int b, int& R, int& C) { const int st = b / 1024, sb = b % 1024, swz = sb ^ (((sb >> 9) & 1) << 5); R = (st >> 1) * 16 + swz / 64; C = (st & 1) * 32 + (swz % 64) / 2; }
__host__ __device__ __forceinline__ int perm32(int rho) { const int n = rho >> 4, i = rho & 15; return 8 * (i >> 2) + 4 * n + (i & 3); }

struct Unit { const char* A; const char* B; int pm, pn, e, aux, ti; };

struct TileOrder {
    int nM, nN, nwg, G, c;
    __device__ void init(int M, int N, int G_, int c_) { nM = M / BM; nN = N / BM; nwg = nM * nN; G = G_; c = c_; }
    __device__ bool tile(int i, int& pm, int& pn) const {
        const long L = (long)i * G + c; if (L >= nwg) return false;
        int wgid = (int)L; { const int q = nwg / NXCD, r = nwg % NXCD, xcd = wgid % NXCD, off = wgid / NXCD; wgid = (xcd < r ? xcd * (q + 1) : r * (q + 1) + (xcd - r) * q) + off; }
        const int nig = WGM * nN, gid = wgid / nig, fm = gid * WGM, gsz = (nM - fm) < WGM ? (nM - fm) : WGM;
        pm = fm + ((wgid % nig) % gsz); pn = (wgid % nig) / gsz; return true;
    }
};
__device__ __forceinline__ unsigned cvt_pk_bf16(float lo, float hi) { unsigned r; asm volatile("v_cvt_pk_bf16_f32 %0, %1, %2" : "=v"(r) : "v"(lo), "v"(hi)); return r; }

template <class Epi, class Sched, bool GATHER, bool ALIGN_EPI, bool SP2, bool DYN = false>
__device__ __forceinline__ void gemm_phase(LAS unsigned char* lds, const int K, const Sched& S, const Epi& E) {
    static_assert(!(DYN && GATHER), "dynamic order + gather not combined");
    static_assert(SP2, "only the SP2 loop is kept here");
    const int tid = threadIdx.x, wid = __builtin_amdgcn_readfirstlane(tid >> 6), lane = tid & 63, wr = wid >> 2, wc = wid & 3, fr = lane & 15, fq = lane >> 4;
    const int nt = K / BK;
    unsigned voffA[2], voffB[2]; int gR[2], gC[2];
#pragma unroll
    for (int i = 0; i < 2; ++i) { int R, C; stage_rc(tid * 16 + i * 8192, R, C); const int Rb = Epi::PERM ? ((R & ~31) + perm32(R & 31)) : R;
        voffA[i] = (unsigned)(R * K + C) * 2u; voffB[i] = (unsigned)(Rb * K + C) * 2u; gR[i] = R * 4; gC[i] = C * 2; }
    const size_t kstep = (size_t)(BK * 2);
    const size_t hstep = (size_t)HALF * K * 2;
    const unsigned ldsw = (unsigned)wid * 1024u;
    const int aoff = lds_byte(wr * 64 + fr, fq * 8), boff = lds_byte(wc * 32 + fr, fq * 8);
#define PG8_SA(b, h) (((b) * 2 + (h)) * HTB)
#define PG8_SB(b, h) ((4 + (b) * 2 + (h)) * HTB)
#define PG8_STAGE(bufoff, gbase, voff) do { _Pragma("unroll") for (int _i = 0; _i < 2; ++_i) \
        __builtin_amdgcn_global_load_lds((const unsigned*)((const char*)(gbase) + (voff)[_i]), (LAS unsigned*)(lds + (bufoff) + ldsw + _i * 8192), 16, 0, 0); } while (0)
#define PG8_STAGE_A(b, h, gbase, par) do { if constexpr (GATHER) { _Pragma("unroll") for (int _i = 0; _i < 2; ++_i) { \
            const unsigned _o = (unsigned)*(const LAS int*)(lds + GTAB_OFF + (par) * 1024 + (h) * 512 + gR[_i]) * (unsigned)(K * 2) + (unsigned)gC[_i]; \
            __builtin_amdgcn_global_load_lds((const unsigned*)((const char*)(gbase) + _o), (LAS unsigned*)(lds + PG8_SA(b, h) + ldsw + _i * 8192), 16, 0, 0); } } \
        else { PG8_STAGE(PG8_SA(b, h), (gbase) + (h) * hstep, voffA); } } while (0)
#define PG8_LDA(dst, b, h) do { _Pragma("unroll") for (int m = 0; m < 4; ++m) _Pragma("unroll") for (int k = 0; k < 2; ++k) dst[m][k] = *(const LAS bf16x8*)(lds + PG8_SA(b, h) + aoff + m * 2048 + k * 1024); } while (0)
#define PG8_LDB(dst, b, h) do { _Pragma("unroll") for (int n = 0; n < 2; ++n) _Pragma("unroll") for (int k = 0; k < 2; ++k) dst[n][k] = *(const LAS bf16x8*)(lds + PG8_SB(b, h) + boff + n * 2048 + k * 1024); } while (0)
#define PG8_MMA(ai, bj, At, Bt) do { __builtin_amdgcn_s_setprio(1); _Pragma("unroll") for (int m = 0; m < 4; ++m) _Pragma("unroll") for (int n = 0; n < 2; ++n) _Pragma("unroll") for (int k = 0; k < 2; ++k) \
        acc[ai][bj][m][n] = __builtin_amdgcn_mfma_f32_16x16x32_bf16(Bt[n][k], At[m][k], acc[ai][bj][m][n], 0, 0, 0); __builtin_amdgcn_s_setprio(0); } while (0)
#define PG8_WAIT_V(n) asm volatile("s_waitcnt vmcnt(" #n ")" ::: "memory")
#define PG8_WAIT_L(n) asm volatile("s_waitcnt lgkmcnt(" #n ")" ::: "memory")
#define PG8_BAR __builtin_amdgcn_s_barrier()
#define PG8_SCHED __builtin_amdgcn_sched_barrier(0)
    Unit cur, nxt; int ui = 0;
    if (!S.next(0, cur)) return;
    f32x4 acc[2][2][4][2];
#pragma unroll
    for (int a = 0; a < 2; ++a)
#pragma unroll
        for (int b = 0; b < 2; ++b)
#pragma unroll
            for (int m = 0; m < 4; ++m)
#pragma unroll
                for (int n = 0; n < 2; ++n) acc[a][b][m][n] = (f32x4){0.f, 0.f, 0.f, 0.f};
    bf16x8 At[4][2], B0[2][2], B1[2][2];
    const char* cA = cur.A; const char* cB = cur.B;
    if constexpr (GATHER) { S.fill(cur, lds + GTAB_OFF, wid, lane); asm volatile("s_waitcnt vmcnt(0) lgkmcnt(0)" ::: "memory"); __syncthreads(); }
    int par = 0;
    PG8_STAGE(PG8_SB(0, 0), cB, voffB); PG8_STAGE(PG8_SB(0, 1), cB + hstep, voffB); PG8_STAGE_A(0, 0, cA, par); PG8_STAGE_A(0, 1, cA, par);
    if (wr == 1) PG8_BAR;
    PG8_WAIT_V(2); PG8_BAR;
    PG8_STAGE(PG8_SB(1, 0), cB + kstep, voffB); PG8_STAGE_A(1, 0, cA + kstep, par); PG8_STAGE(PG8_SB(1, 1), cB + hstep + kstep, voffB);
    PG8_WAIT_V(6); PG8_BAR;
    int rpar = 0;
    for (;;) {
        bool has_next = false; const char* nA = cA; const char* nB = cB;
        if constexpr (Epi::RTAB) E.rowtab(cur, lds + RTAB_OFF + rpar * 1024, wid, lane);
        if constexpr (DYN) { S.prefetch(ui + 1); }
        else { has_next = S.next(ui + 1, nxt); nA = has_next ? nxt.A : cA; nB = has_next ? nxt.B : cB; }
        if constexpr (GATHER) { if (has_next) S.fill(nxt, lds + GTAB_OFF + (par ^ 1) * 1024, wid, lane); }
        const int npar = (GATHER && has_next) ? (par ^ 1) : par;
        for (int t = 0; t < nt; t += 2) {
            const bool last = (t == nt - 2);
            if constexpr (DYN) { if (last) { has_next = S.next(ui + 1, nxt); nA = has_next ? nxt.A : cA; nB = has_next ? nxt.B : cB; } }
            const char* a1 = cA + (size_t)(t + 1) * kstep;
            const char* a2 = last ? nA : cA + (size_t)(t + 2) * kstep; const char* b2 = last ? nB : cB + (size_t)(t + 2) * kstep;
            const char* a3 = a2 + kstep; const char* b3 = b2 + kstep;
            const int p2 = last ? npar : par;
            PG8_LDB(B0, 0, 0); PG8_LDB(B1, 0, 1); PG8_SCHED; PG8_LDA(At, 0, 0); PG8_STAGE_A(1, 1, a1, par);
            PG8_WAIT_V(8); PG8_WAIT_L(0); PG8_BAR; PG8_MMA(0, 0, At, B0); PG8_MMA(0, 1, At, B1); PG8_BAR; PG8_SCHED;
            PG8_LDA(At, 0, 1); PG8_STAGE(PG8_SB(0, 0), b2, voffB); PG8_STAGE(PG8_SB(0, 1), b2 + hstep, voffB); PG8_STAGE_A(0, 0, a2, p2);
            PG8_WAIT_V(8); PG8_WAIT_L(0); PG8_BAR; PG8_MMA(1, 0, At, B0); PG8_MMA(1, 1, At, B1); PG8_BAR; PG8_SCHED;
            PG8_LDB(B0, 1, 0); PG8_LDB(B1, 1, 1); PG8_SCHED; PG8_LDA(At, 1, 0); PG8_STAGE_A(0, 1, a2, p2);
            PG8_WAIT_V(8); PG8_WAIT_L(0); PG8_BAR; PG8_MMA(0, 0, At, B0); PG8_MMA(0, 1, At, B1); PG8_BAR; PG8_SCHED;
            PG8_LDA(At, 1, 1); PG8_STAGE(PG8_SB(1, 0), b3, voffB); PG8_STAGE(PG8_SB(1, 1), b3 + hstep, voffB); PG8_STAGE_A(1, 0, a3, p2);
            PG8_WAIT_V(8); PG8_WAIT_L(0); PG8_BAR; PG8_MMA(1, 0, At, B0); PG8_MMA(1, 1, At, B1); PG8_BAR; PG8_SCHED;
        }
        if constexpr (ALIGN_EPI) { if (wr == 0) PG8_BAR; }
        if constexpr (Epi::RTAB) E(acc, cur, wr, wc, fr, fq, (const LAS float*)(lds + RTAB_OFF + rpar * 1024)); else E(acc, cur, wr, wc, fr, fq);
        S.done(cur);
        if (!has_next) break;
        if (!E.keep(cur)) {
#pragma unroll
            for (int a = 0; a < 2; ++a)
#pragma unroll
                for (int b = 0; b < 2; ++b)
#pragma unroll
                    for (int m = 0; m < 4; ++m)
#pragma unroll
                        for (int n = 0; n < 2; ++n) acc[a][b][m][n] = (f32x4){0.f, 0.f, 0.f, 0.f};
        }
        cur = nxt; cA = nA; cB = nB; ++ui; par = npar; rpar ^= 1;
        if constexpr (ALIGN_EPI) { if (wr == 1) PG8_BAR; }
    }
    PG8_WAIT_V(0);
    if constexpr (!ALIGN_EPI) { if (wr == 0) PG8_BAR; }
    PG8_BAR;
#undef PG8_SA
#undef PG8_SB
#undef PG8_STAGE
#undef PG8_STAGE_A
#undef PG8_LDA
#undef PG8_LDB
#undef PG8_MMA
#undef PG8_WAIT_V
#undef PG8_WAIT_L
#undef PG8_BAR
#undef PG8_SCHED
}
}

template <bool NT>
__device__ __forceinline__ void tr64_item(const float* W, int K, int N, bf16* WT, int k0, int n0, int drow0, float* scr, int lane) {
    const int rr = lane >> 4, q = lane & 15;
    f32x4 v[16];
#pragma unroll
    for (int i = 0; i < 16; ++i) { const f32x4* p = (const f32x4*)(W + (size_t)(k0 + 4 * i + rr) * N + n0 + 4 * q); v[i] = NT ? __builtin_nontemporal_load(p) : *p; }
#pragma unroll
    for (int i = 0; i < 16; ++i) { float* d = scr + (4 * i + rr) * 65 + 4 * q; d[0] = v[i].x; d[1] = v[i].y; d[2] = v[i].z; d[3] = v[i].w; }
    asm volatile("s_waitcnt lgkmcnt(0)" ::: "memory");
    const int nn = lane >> 3, c = lane & 7;
#pragma unroll
    for (int j = 0; j < 8; ++j) { const int n = nn + 8 * j; const float* s = scr + (8 * c) * 65 + n;
        u32x4 o; o.x = pk2(s[0 * 65], s[1 * 65]); o.y = pk2(s[2 * 65], s[3 * 65]); o.z = pk2(s[4 * 65], s[5 * 65]); o.w = pk2(s[6 * 65], s[7 * 65]);
        u32x4* dp = (u32x4*)(WT + (size_t)(drow0 + n) * K + k0 + 8 * c);
        if (NT) __builtin_nontemporal_store(o, dp); else *dp = o; }
    asm volatile("s_waitcnt lgkmcnt(0)" ::: "memory");
}
constexpr int TI_IN = (D / 64) * (PW / 64), TI_A = (AW / 64) * (D / 64), TI_OUT = (D / 64) * (D / 64), TI_G = (D / 64) * (DE / 64), TI_D = (DE / 64) * (D / 64);
constexpr int TI_E = 2 * TI_G + TI_D, TI_DENSE = TI_IN + 2 * TI_A + TI_OUT, TI_MOE = NE * TI_E;
__device__ __forceinline__ void conv_dense(Frame& F, int cw, int ncw, bool first) {
    float* scr = (float*)(F.lds + F.wave * 16640); const int lane = F.lane;
    if (first) { for (int r = cw; r < TI_IN; r += ncw) { const int nb = PW / 64; tr64_item<false>(F_w_in, D, PW, WSP(bf16, WS_WIN_T), 64 * (r / nb), 64 * (r % nb), 64 * (r % nb), scr, lane); } return; }
    for (int it = cw; it < 2 * TI_A + TI_OUT; it += ncw) {
        int r = it;
        if (r < TI_A) { const int nb = D / 64; tr64_item<false>(F_w_a, AW, D, WSP(bf16, WS_WA_T), 64 * (r / nb), 64 * (r % nb), 64 * (r % nb), scr, lane); continue; } r -= TI_A;
        if (r < TI_A) { const int nb = D / 64; tr64_item<false>(F_w_b, AW, D, WSP(bf16, WS_WB_T), 64 * (r / nb), 64 * (r % nb), 64 * (r % nb), scr, lane); continue; } r -= TI_A;
        { const int nb = D / 64; tr64_item<false>(F_w_out, D, D, WSP(bf16, WS_WOUT_T), 64 * (r / nb), 64 * (r % nb), 64 * (r % nb), scr, lane); }
    }
}
__device__ __forceinline__ void conv_moe(Frame& F, int cw, int ncw) {
    float* scr = (float*)(F.lds + F.wave * 16640); const int lane = F.lane;
    for (int it = cw; it < TI_MOE; it += ncw) {
        const int e = it / TI_E; int r = it - e * TI_E;
        if (r < 2 * TI_G) { const int up = r >= TI_G; if (up) r -= TI_G; const int nb = DE / 64, n0 = 64 * (r % nb);
            const int drow0 = (n0 >> 7) * 256 + up * 128 + (n0 & 127);
            tr64_item<true>((up ? F_w_up : F_w_gate) + (size_t)e * D * DE, D, DE, WSP(bf16, WS_WGU_T) + (size_t)e * 2048 * D, 64 * (r / nb), n0, drow0, scr, lane); continue; }
        r -= 2 * TI_G;
        { const int nb = D / 64; tr64_item<true>(F_w_down + (size_t)e * DE * D, DE, D, WSP(bf16, WS_WD_T) + (size_t)e * D * DE, 64 * (r / nb), 64 * (r % nb), 64 * (r % nb), scr, lane); }
    }
}

__device__ __forceinline__ void p0_router_weights(Frame& F) {
    const int gt = F.bid * NTHR + F.tid, NT = F.G * NTHR;
    bf16* wf = WSP(bf16, WS_WRH);
    for (int i = gt; i < 4 * 8 * 4 * 2 * 64 * 8; i += NT) {
        const int j = i & 7, lane = (i >> 3) & 63, nt = (i >> 9) & 1, sst = (i >> 10) & 3, w = (i >> 12) & 7, kc = i >> 15;
        const int col = 32 * nt + (lane & 31), k = 512 * kc + 64 * w + 16 * sst + 8 * (lane >> 5) + j;
        float v = 0.f; if (col < 32) v = F_w_re[(size_t)k * 32 + col] * F_g_ffn[k]; else if (col < 36) v = F_w_rg[(size_t)k * 4 + (col - 32)] * F_g_ffn[k];
        const unsigned h = f2bf(v); const float hf = __uint_as_float(h << 16);
        const size_t base = ((((size_t)(kc * 8 + w) * 4 + sst) * 2 + nt) * 2) * 512;
        wf[base + lane * 8 + j] = (bf16)h; wf[base + 512 + lane * 8 + j] = (bf16)f2bf(v - hf); }
}
__device__ __forceinline__ void p0_weights(Frame& F) {
    const int gw = F.bid * NWAVES + F.wave, NGW = F.G * NWAVES;
    conv_dense(F, gw, NGW, true);
    if (!OVERLAP_CONV) { conv_dense(F, gw, NGW, false); conv_moe(F, gw, NGW); }
}

constexpr int CW_PANEL = 12288, CW_GQ = 14400, CW_UDONE = 14464, NPROJ_UNITS = (T / 256) * (PW / 256);
static_assert((CW_UDONE + 64) * 4 <= (int)CTL_ZERO_BYTES, "hand-off words inside the zeroed control region");
constexpr int GQ_LDS_OFF = 131072 + 4096 + 64;
__device__ __forceinline__ void p2_gating_mfma(Frame& F, const bool early);
__device__ __forceinline__ __amdgpu_buffer_rsrc_t wt_rsrc(void* p) { return __builtin_amdgcn_make_buffer_rsrc(p, 0, 0x7fffffff, 0x00020000); }
__device__ __forceinline__ void wt_store16(__amdgpu_buffer_rsrc_t r, unsigned byte_off, u32x4 v) { __builtin_amdgcn_raw_buffer_store_b128(v, r, byte_off, 0, 16); }
struct EpiProj {
    static constexpr bool PERM = true; static constexpr bool RTAB = false;
    bf16* P;
    __device__ __forceinline__ bool keep(const pg8::Unit&) const { return false; }
    __device__ __forceinline__ void operator()(f32x4 (&acc)[2][2][4][2], const pg8::Unit& u, int wr, int wc, int fr, int fq) const {
        const int act = (u.pn < 8) ? ((GELU_U_LATE && u.pn < 4) ? 0 : 1) : ((u.pn < 20) ? 0 : 2);
        const int row0 = u.pm * 256 + wr * 64 + fr, col0 = u.pn * 256 + wc * 32 + 8 * fq;
#pragma unroll
        for (int ai = 0; ai < 2; ++ai)
#pragma unroll
            for (int m = 0; m < 4; ++m) { bf16* rowp = P + (size_t)(row0 + ai * 128 + m * 16) * PW + col0;
#pragma unroll
                for (int bj = 0; bj < 2; ++bj) { f32x4 v0 = acc[ai][bj][m][0], v1 = acc[ai][bj][m][1];
                    if (act == 1) {
#pragma unroll
                        for (int j = 0; j < 4; ++j) { v0[j] = gelu_tanh(v0[j]); v1[j] = gelu_tanh(v1[j]); } }
                    else if (act == 2) {
#pragma unroll
                        for (int j = 0; j < 4; ++j) { v0[j] = sigmoidf_(v0[j]); v1[j] = sigmoidf_(v1[j]); } }
                    u32x4 w; w.x = pg8::cvt_pk_bf16(v0[0], v0[1]); w.y = pg8::cvt_pk_bf16(v0[2], v0[3]); w.z = pg8::cvt_pk_bf16(v1[0], v1[1]); w.w = pg8::cvt_pk_bf16(v1[2], v1[3]);
                    if (WT_STORES || (EARLY_GATING && u.pn < 8)) asm volatile("global_store_dwordx4 %0, %1, off sc1\n\ts_nop 1" :: "v"(rowp + bj * 128), "v"(w) : "memory"); else *(u32x4*)(rowp + bj * 128) = w; } }
    }
};
struct SchedProj {
    pg8::TileOrder o; const char* A; const char* B;
    __device__ __forceinline__ void done(const pg8::Unit&) const {}
    __device__ __forceinline__ bool next(int i, pg8::Unit& u) const { int pm, pn; if (!o.tile(i, pm, pn)) return false; u.pm = pm; u.pn = pn; u.e = 0; u.aux = 0; u.ti = 0;
        u.A = A + (size_t)pm * 256 * D * 2; u.B = B + (size_t)pn * 256 * D * 2; return true; }
};
constexpr int CW_Q = 64;
constexpr int DQ_LDS_OFF = 131072 + 4096;
struct SchedProjDyn {
    pg8::TileOrder o; const char* A; const char* B; unsigned* q; volatile LAS int* slot; int x; unsigned* ctl;
    __device__ __forceinline__ void done(const pg8::Unit& u) const {
        if (!EARLY_GATING) return;
        if (u.pn < 8) { asm volatile("s_waitcnt vmcnt(0)" ::: "memory"); if ((threadIdx.x & 63) == 0) __hip_atomic_fetch_add(ctl + CW_PANEL + 64 * u.pm, 1u, __ATOMIC_RELAXED, __HIP_MEMORY_SCOPE_AGENT); }
        if (threadIdx.x == 0) __hip_atomic_fetch_add(ctl + CW_UDONE, 1u, __ATOMIC_RELAXED, __HIP_MEMORY_SCOPE_AGENT); }
    __device__ __forceinline__ bool unit_of(int idx, pg8::Unit& u) const { pg8::TileOrder t = o; t.G = 8; t.c = x; int pm, pn; if (!t.tile(idx, pm, pn)) return false; u.pm = pm; u.pn = pn; u.e = 0; u.aux = 0; u.ti = 0;
        u.A = A + (size_t)pm * 256 * D * 2; u.B = B + (size_t)pn * 256 * D * 2; return true; }
    __device__ __forceinline__ void prefetch(int i) const { if (threadIdx.x == 0) slot[i & 1] = (int)__hip_atomic_fetch_add(q, 1u, __ATOMIC_RELAXED, __HIP_MEMORY_SCOPE_AGENT); }
    __device__ __forceinline__ bool next(int i, pg8::Unit& u) const {
        if (i == 0) { prefetch(0); asm volatile("s_waitcnt vmcnt(0) lgkmcnt(0)" ::: "memory"); __syncthreads(); }
        const int idx = __builtin_amdgcn_readfirstlane(slot[i & 1]); return unit_of(idx, u); }
};
__device__ __forceinline__ void p1_proj_mfma(Frame& F) {
    EpiProj E{F_PROJ};
    if (OVERLAP_CONV) {
        const int NC = CONV_CUS < F.G ? CONV_CUS : F.G / 2;
        if (F.bid < NC) { conv_dense(F, F.bid * NWAVES + F.wave, NC * NWAVES, false); conv_moe(F, F.bid * NWAVES + F.wave, NC * NWAVES); __syncthreads(); }
        SchedProjDyn S; S.o.init(T, PW, 8, 0); S.A = (const char*)F_XN; S.B = (const char*)WSP(bf16, WS_WIN_T); S.x = F.bid & 7; S.q = F_ctl + CW_Q + 64 * S.x;
        S.slot = (volatile LAS int*)((LAS unsigned char*)F.lds + DQ_LDS_OFF); S.ctl = F_ctl;
        pg8::gemm_phase<EpiProj, SchedProjDyn, false, true, true, true>((LAS unsigned char*)F.lds, D, S, E);
        if (EARLY_GATING) p2_gating_mfma(F, true);
    } else {
        SchedProj S; S.o.init(T, PW, F.G, F.bid); S.A = (const char*)F_XN; S.B = (const char*)WSP(bf16, WS_WIN_T);
        pg8::gemm_phase<EpiProj, SchedProj, false, true, true>((LAS unsigned char*)F.lds, D, S, E);
    }
}
struct EpiBranch {
    static constexpr bool PERM = true; static constexpr bool RTAB = false;
    const bf16* P; bf16* MG;
    __device__ __forceinline__ bool keep(const pg8::Unit& u) const { return u.aux == 0; }
    __device__ __forceinline__ void operator()(f32x4 (&acc)[2][2][4][2], const pg8::Unit& u, int wr, int wc, int fr, int fq) const {
        const int row0 = u.pm * 256 + wr * 64 + fr, col0 = u.pn * 256 + wc * 32 + 8 * fq;
        if (u.aux == 0) {
#pragma unroll
            for (int ai = 0; ai < 2; ++ai) {
                u32x4 gaw[4][2], gbw[4][2];
#pragma unroll
                for (int m = 0; m < 4; ++m)
#pragma unroll
                    for (int bj = 0; bj < 2; ++bj) { const bf16* gp = P + (size_t)(row0 + ai * 128 + m * 16) * PW + col0 + bj * 128;
                        gaw[m][bj] = *(const u32x4*)(gp + OFF_GA); gbw[m][bj] = *(const u32x4*)(gp + OFF_GB); }
#pragma unroll
                for (int m = 0; m < 4; ++m)
#pragma unroll
                    for (int bj = 0; bj < 2; ++bj)
#pragma unroll
                        for (int j = 0; j < 4; ++j) {
                            const float gb0 = fmaxf(__uint_as_float(gbw[m][bj][j] << 16), 1e-30f), gb1 = fmaxf(__uint_as_float(gbw[m][bj][j] & 0xffff0000u), 1e-30f);
                            const float ga0 = __uint_as_float(gaw[m][bj][j] << 16), ga1 = __uint_as_float(gaw[m][bj][j] & 0xffff0000u);
                            const int n = j >> 1, q = (j & 1) * 2; acc[ai][bj][m][n][q] *= ga0 * __builtin_amdgcn_rcpf(gb0); acc[ai][bj][m][n][q + 1] *= ga1 * __builtin_amdgcn_rcpf(gb1); }
            }
        } else {
            const __amdgpu_buffer_rsrc_t rM = wt_rsrc(MG);
            u32x4 gbw[2][4][2];
#pragma unroll
            for (int ai = 0; ai < 2; ++ai)
#pragma unroll
                for (int m = 0; m < 4; ++m)
#pragma unroll
                    for (int bj = 0; bj < 2; ++bj) gbw[ai][m][bj] = *(const u32x4*)(P + (size_t)(row0 + ai * 128 + m * 16) * PW + OFF_GB + col0 + bj * 128);
#pragma unroll
            for (int ai = 0; ai < 2; ++ai)
#pragma unroll
                for (int m = 0; m < 4; ++m)
#pragma unroll
                    for (int bj = 0; bj < 2; ++bj) { const unsigned r = (unsigned)(row0 + ai * 128 + m * 16);
                        float gb[8];
#pragma unroll
                        for (int j = 0; j < 4; ++j) { gb[2 * j] = fmaxf(__uint_as_float(gbw[ai][m][bj][j] << 16), 1e-30f); gb[2 * j + 1] = fmaxf(__uint_as_float(gbw[ai][m][bj][j] & 0xffff0000u), 1e-30f); }
                        const f32x4 v0 = acc[ai][bj][m][0], v1 = acc[ai][bj][m][1];
                        u32x4 w; w.x = pg8::cvt_pk_bf16(v0[0] * gb[0], v0[1] * gb[1]); w.y = pg8::cvt_pk_bf16(v0[2] * gb[2], v0[3] * gb[3]);
                        w.z = pg8::cvt_pk_bf16(v1[0] * gb[4], v1[1] * gb[5]); w.w = pg8::cvt_pk_bf16(v1[2] * gb[6], v1[3] * gb[7]);
                        if (WT_STORES) wt_store16(rM, (r * D + col0 + bj * 128) * 2u, w); else *(u32x4*)(MG + (size_t)r * D + col0 + bj * 128) = w; }
        }
    }
};
struct SchedBranch {
    pg8::TileOrder o; const char *YA, *YB, *WA, *WB;
    __device__ __forceinline__ void done(const pg8::Unit&) const {}
    __device__ __forceinline__ bool next(int i, pg8::Unit& u) const { int pm, pn; if (!o.tile(i >> 1, pm, pn)) return false; u.pm = pm; u.pn = pn; u.e = 0; u.aux = i & 1; u.ti = 0;
        u.A = ((i & 1) ? YB : YA) + (size_t)pm * 256 * AW * 2; u.B = ((i & 1) ? WB : WA) + (size_t)pn * 256 * AW * 2; return true; }
};
__device__ __forceinline__ void p3_branch_mfma(Frame& F) {
    SchedBranch S; S.o.init(T, D, F.G, F.bid); S.YA = (const char*)F_YA; S.YB = (const char*)F_YB; S.WA = (const char*)WSP(bf16, WS_WA_T); S.WB = (const char*)WSP(bf16, WS_WB_T);
    EpiBranch E{F_PROJ, F_MERGED};
    pg8::gemm_phase<EpiBranch, SchedBranch, false, true, true>((LAS unsigned char*)F.lds, AW, S, E);
}
struct EpiOut {
    static constexpr bool PERM = true; static constexpr bool RTAB = false;
    const float* x; const float* gf; float* X1; bf16* H2;
    __device__ __forceinline__ bool keep(const pg8::Unit&) const { return false; }
    __device__ __forceinline__ void operator()(f32x4 (&acc)[2][2][4][2], const pg8::Unit& u, int wr, int wc, int fr, int fq) const {
        const int row0 = u.pm * 256 + wr * 64 + fr, col0 = u.pn * 256 + wc * 32 + 8 * fq;
#pragma unroll
        for (int ai = 0; ai < 2; ++ai)
#pragma unroll
            for (int m = 0; m < 4; ++m) { const size_t off = (size_t)(row0 + ai * 128 + m * 16) * D + col0;
#pragma unroll
                for (int bj = 0; bj < 2; ++bj) {
                    const f32x4 x0 = *(const f32x4*)(x + off + bj * 128), x1 = *(const f32x4*)(x + off + bj * 128 + 4);
                    const f32x4 g0 = *(const f32x4*)(gf + col0 + bj * 128), g1 = *(const f32x4*)(gf + col0 + bj * 128 + 4);
                    const f32x4 v0 = x0 + acc[ai][bj][m][0], v1 = x1 + acc[ai][bj][m][1];
                    *(f32x4*)(X1 + off + bj * 128) = v0; *(f32x4*)(X1 + off + bj * 128 + 4) = v1;
                    u32x4 w; w.x = pg8::cvt_pk_bf16(v0[0] * g0[0], v0[1] * g0[1]); w.y = pg8::cvt_pk_bf16(v0[2] * g0[2], v0[3] * g0[3]);
                    w.z = pg8::cvt_pk_bf16(v1[0] * g1[0], v1[1] * g1[1]); w.w = pg8::cvt_pk_bf16(v1[2] * g1[2], v1[3] * g1[3]);
                    *(u32x4*)(H2 + off + bj * 128) = w; }
                asm volatile("" ::: "memory"); }
    }
};
struct SchedOut {
    pg8::TileOrder o; const char* A; const char* B;
    __device__ __forceinline__ void done(const pg8::Unit&) const {}
    __device__ __forceinline__ bool next(int i, pg8::Unit& u) const { int pm, pn; if (!o.tile(i, pm, pn)) return false; u.pm = pm; u.pn = pn; u.e = 0; u.aux = 0; u.ti = 0;
        u.A = A + (size_t)pm * 256 * D * 2; u.B = B + (size_t)pn * 256 * D * 2; return true; }
};
__device__ __forceinline__ void p4_out_mfma(Frame& F) {
    SchedOut S; S.o.init(T, D, F.G, F.bid); S.A = (const char*)F_MERGED; S.B = (const char*)WSP(bf16, WS_WOUT_T);
    EpiOut E{F_x, F_g_ffn, F_out, F_H2};
    pg8::gemm_phase<EpiOut, SchedOut, false, true, true>((LAS unsigned char*)F.lds, D, S, E);
}
constexpr int MOE_TAB_OFF = 131072 + 2048;
__device__ __forceinline__ void moe_table(Frame& F) {
    int* tb = (int*)(F.lds + MOE_TAB_OFF);
    __syncthreads();
    if (F.tid < 64) {
        const int e = F.lane; int c = 0;
        if (e < NE) c = (int)__hip_atomic_load(F_ctl + CW_CNT + CNT_STRIDE * e, __ATOMIC_RELAXED, __HIP_MEMORY_SCOPE_AGENT);
        const int m = (c + 255) >> 8; int incl = m;
#pragma unroll
        for (int d = 1; d < 32; d <<= 1) { const int v = __shfl_up(incl, d); if (e >= d) incl += v; }
        const int excl = incl - m;
        if (e < NE) { tb[e] = excl << 8; tb[320 + e] = c; for (int j = 0; j < m; ++j) { tb[64 + 2 * (excl + j)] = e; tb[65 + 2 * (excl + j)] = j; } }
        if (e == NE - 1) { tb[NE] = incl << 8; tb[33] = incl; }
    }
    __syncthreads();
}
struct SchedMoe {
    const int* tb; int G, vcu, t_lo, t_hi, n_pub; unsigned* donew; const char* A; const char* B; const int* LTOK; const unsigned* cnt; int a_row_bytes; size_t b_exp_bytes, b_pn_bytes; int Kg;
    __device__ __forceinline__ bool next(int i, pg8::Unit& u) const {
        const int L = i * G + vcu; if (L >= (t_hi - t_lo) * 8) return false;
        const int ti = t_lo + (L >> 3); u.ti = ti; u.pn = L & 7; u.e = tb[64 + 2 * ti]; u.pm = tb[65 + 2 * ti]; u.aux = tb[u.e] + u.pm * 256;
        u.A = (a_row_bytes ? A + (size_t)u.aux * a_row_bytes : A); u.B = B + (size_t)u.e * b_exp_bytes + (size_t)u.pn * b_pn_bytes; return true; }
    __device__ __forceinline__ void fill(const pg8::Unit& u, LAS unsigned char* dst, int wid, int lane) const {
        if (wid < 4) __builtin_amdgcn_global_load_lds((const unsigned*)(LTOK + u.e * T + u.pm * 256 + wid * 64 + lane), (LAS unsigned*)(dst + wid * 256), 4, 0, 0); }
    __device__ __forceinline__ void done(const pg8::Unit& u) const {
        if (u.ti < n_pub) { asm volatile("s_waitcnt vmcnt(0)" ::: "memory");
            if ((threadIdx.x & 63) == 0) __hip_atomic_fetch_add(donew + 64 * u.ti, 1u, __ATOMIC_RELAXED, __HIP_MEMORY_SCOPE_AGENT); } }
};

constexpr int CW_DONE = 8192;
static_assert((CW_DONE + 64 * 32) * 4 <= (int)CTL_ZERO_BYTES, "arrival counters inside the zeroed control region");
__device__ __forceinline__ int moe_early_tiles(int nt, int G) {
    if (!MOE_EARLY_DOWN || G != 256 || nt * 8 <= 2 * G || nt * 8 >= 3 * G) return 0;
    const int idle = 3 * G - nt * 8; int n = idle >> 3; if (n > 32) n = 32; if (n > nt) n = nt; return n;
}
struct EpiGateUp {
    static constexpr bool PERM = true; static constexpr bool RTAB = true;
    const float* LRSTD; bf16* HDN; int n_pub;
    __device__ __forceinline__ bool keep(const pg8::Unit&) const { return false; }
    __device__ __forceinline__ void rowtab(const pg8::Unit& u, LAS unsigned char* dst, int wid, int lane) const {
        if (wid < 4) __builtin_amdgcn_global_load_lds((const unsigned*)(LRSTD + u.e * T + u.pm * 256 + wid * 64 + lane), (LAS unsigned*)(dst + wid * 256), 4, 0, 0); }
    __device__ __forceinline__ void operator()(f32x4 (&acc)[2][2][4][2], const pg8::Unit& u, int wr, int wc, int fr, int fq, const LAS float* rt) const {
        const int col0 = u.pn * 128 + wc * 32 + 8 * fq;
#pragma unroll
        for (int ai = 0; ai < 2; ++ai)
#pragma unroll
            for (int m = 0; m < 4; ++m) { const int rl = ai * 128 + wr * 64 + m * 16 + fr;
                const float rs = rt[rl];
                float h[8];
#pragma unroll
                for (int n = 0; n < 2; ++n)
#pragma unroll
                    for (int j = 0; j < 4; ++j) { const float g = acc[ai][0][m][n][j] * rs, uu = acc[ai][1][m][n][j] * rs; h[n * 4 + j] = g * sigmoidf_(g) * uu; }
                u32x4 w; w.x = pg8::cvt_pk_bf16(h[0], h[1]); w.y = pg8::cvt_pk_bf16(h[2], h[3]); w.z = pg8::cvt_pk_bf16(h[4], h[5]); w.w = pg8::cvt_pk_bf16(h[6], h[7]);
                bf16* dp = HDN + (size_t)(u.aux + rl) * DE + col0;
                if (WT_STORES || u.ti < n_pub) asm volatile("global_store_dwordx4 %0, %1, off sc1\n\ts_nop 1" :: "v"(dp), "v"(w) : "memory"); else *(u32x4*)dp = w; }
    }
};
__device__ __forceinline__ void p7_early(Frame& F, int n_early);
__device__ __forceinline__ void p6_gateup_mfma(Frame& F) {
    moe_table(F);
    const int* tb = (const int*)(F.lds + MOE_TAB_OFF);
    SchedMoe S; S.tb = tb; S.G = F.G; S.vcu = (F.G % 8 == 0) ? (F.bid % 8) * (F.G / 8) + F.bid / 8 : F.bid;
    S.A = (const char*)F_H2; S.a_row_bytes = 0; S.B = (const char*)WSP(bf16, WS_WGU_T); S.b_exp_bytes = (size_t)2048 * D * 2; S.b_pn_bytes = (size_t)256 * D * 2; S.LTOK = F_LTOK; S.cnt = F_ctl + CW_CNT; S.Kg = D;
    const int nt = tb[33], n_early = moe_early_tiles(nt, F.G);
    S.t_lo = 0; S.t_hi = nt; S.n_pub = n_early; S.donew = F_ctl + CW_DONE;
    EpiGateUp E{F_LRSTD, F_HDN, n_early};
    pg8::gemm_phase<EpiGateUp, SchedMoe, true, true, true>((LAS unsigned char*)F.lds, D, S, E);
    if (n_early > 0) p7_early(F, n_early);
}
struct EpiDown {
    static constexpr bool PERM = true; static constexpr bool RTAB = true;
    const float* LW; bf16* Y;
    __device__ __forceinline__ bool keep(const pg8::Unit&) const { return false; }
    __device__ __forceinline__ void rowtab(const pg8::Unit& u, LAS unsigned char* dst, int wid, int lane) const {
        if (wid < 4) __builtin_amdgcn_global_load_lds((const unsigned*)(LW + u.e * T + u.pm * 256 + wid * 64 + lane), (LAS unsigned*)(dst + wid * 256), 4, 0, 0); }
    __device__ __forceinline__ void operator()(f32x4 (&acc)[2][2][4][2], const pg8::Unit& u, int wr, int wc, int fr, int fq, const LAS float* rt) const {
        const int col0 = u.pn * 256 + wc * 32 + 8 * fq;
#pragma unroll
        for (int ai = 0; ai < 2; ++ai)
#pragma unroll
            for (int m = 0; m < 4; ++m) { const int rl = ai * 128 + wr * 64 + m * 16 + fr;
                const float gw = rt[rl];
#pragma unroll
                for (int bj = 0; bj < 2; ++bj) { const f32x4 v0 = acc[ai][bj][m][0] * gw, v1 = acc[ai][bj][m][1] * gw;
                    u32x4 w; w.x = pg8::cvt_pk_bf16(v0[0], v0[1]); w.y = pg8::cvt_pk_bf16(v0[2], v0[3]); w.z = pg8::cvt_pk_bf16(v1[0], v1[1]); w.w = pg8::cvt_pk_bf16(v1[2], v1[3]);
                    bf16* dp = Y + (size_t)(u.aux + rl) * D + col0 + bj * 128;
                    if (WT_STORES) asm volatile("global_store_dwordx4 %0, %1, off sc1\n\ts_nop 1" :: "v"(dp), "v"(w) : "memory"); else *(u32x4*)dp = w; } }
    }
};
struct SchedMoeOne {
    pg8::Unit u0; bool have;
    __device__ __forceinline__ bool next(int i, pg8::Unit& u) const { if (i != 0 || !have) return false; u = u0; return true; }
    __device__ __forceinline__ void fill(const pg8::Unit&, LAS unsigned char*, int, int) const {}
    __device__ __forceinline__ void done(const pg8::Unit&) const {}
};
__device__ __forceinline__ void p7_early(Frame& F, int n_early) {
    const int* tb = (const int*)(F.lds + MOE_TAB_OFF);
    const int nt = tb[33]; const int vcu = (F.bid % 8) * (F.G / 8) + F.bid / 8; const int first_idle = nt * 8 - 2 * F.G;
    const int j = vcu - first_idle;
    SchedMoeOne S; S.have = (j >= 0 && j < n_early * 8);
    if (S.have) { const int ti = j >> 3; S.u0.ti = ti; S.u0.pn = j & 7; S.u0.e = tb[64 + 2 * ti]; S.u0.pm = tb[65 + 2 * ti]; S.u0.aux = tb[S.u0.e] + S.u0.pm * 256;
        S.u0.A = (const char*)F_HDN + (size_t)S.u0.aux * DE * 2; S.u0.B = (const char*)WSP(bf16, WS_WD_T) + (size_t)S.u0.e * D * DE * 2 + (size_t)S.u0.pn * 256 * DE * 2;
        if (F.tid < 64) { unsigned* w = F_ctl + CW_DONE + 64 * ti; unsigned sp = 0;
            while ((unsigned)__builtin_amdgcn_readfirstlane(__hip_atomic_load(w, __ATOMIC_RELAXED, __HIP_MEMORY_SCOPE_AGENT)) < 64u) { __builtin_amdgcn_s_sleep(2); if (++sp > (1u << 22)) break; }
            __builtin_amdgcn_fence(__ATOMIC_ACQUIRE, "agent");
            asm volatile("s_waitcnt vmcnt(0)" ::: "memory"); } }
    __syncthreads();
    EpiDown E{F_LW, F_Y};
    pg8::gemm_phase<EpiDown, SchedMoeOne, false, true, true>((LAS unsigned char*)F.lds, DE, S, E);
}
__device__ __forceinline__ void p7_down_mfma(Frame& F, bool have_tab) {
    if (!have_tab) moe_table(F);
    const int* tb = (const int*)(F.lds + MOE_TAB_OFF);
    SchedMoe S; S.tb = tb; S.G = F.G; S.vcu = (F.G % 8 == 0) ? (F.bid % 8) * (F.G / 8) + F.bid / 8 : F.bid;
    S.A = (const char*)F_HDN; S.a_row_bytes = DE * 2; S.B = (const char*)WSP(bf16, WS_WD_T); S.b_exp_bytes = (size_t)D * DE * 2; S.b_pn_bytes = (size_t)256 * DE * 2; S.LTOK = F_LTOK; S.cnt = F_ctl + CW_CNT; S.Kg = DE;
    const int nt = tb[33]; S.t_lo = moe_early_tiles(nt, F.G); S.t_hi = nt; S.n_pub = 0; S.donew = F_ctl + CW_DONE;
    EpiDown E{F_LW, F_Y};
    pg8::gemm_phase<EpiDown, SchedMoe, false, true, true>((LAS unsigned char*)F.lds, DE, S, E);
}


typedef float f32x16 __attribute__((ext_vector_type(16)));
typedef short s16x8 __attribute__((ext_vector_type(8)));
typedef short s16x4 __attribute__((ext_vector_type(4)));
__device__ __forceinline__ s16x4 vtr16(const LAS unsigned char* p) { return __builtin_bit_cast(s16x4, __builtin_amdgcn_ds_read_tr16_b64_v4i16((LAS s16x4*)p)); }
__device__ __forceinline__ float xhalf(float v, int hi) { auto rr = __builtin_amdgcn_permlane32_swap(__float_as_uint(v), __float_as_uint(v), false, false); return __uint_as_float(hi ? rr[0] : rr[1]); }

__device__ __forceinline__ void p2_attn_mfma(Frame& F) {
    LAS unsigned char* L = (LAS unsigned char*)F.lds;
    constexpr int LK = 0, LV = 32768, LFL = 65536;
    const int tid = F.tid, lane = F.lane, wid = F.wave, r32 = lane & 31, hi = lane >> 5;
    const bf16* P = F_PROJ; bf16* YB = F_YB;
    const float c2 = 0.08838834764831845f * 1.4426950408889634f;
    int srow[2], sch[2], kdst[2], vdst[2];
#pragma unroll
    for (int i = 0; i < 2; ++i) { const int c = tid + 512 * i; srow[i] = c >> 4; sch[i] = c & 15; const int row = srow[i], ch = sch[i];
        kdst[i] = row * 256 + ((ch ^ (row & 15)) << 4); vdst[i] = row * 256 + ((ch ^ (((row & 3) << 2) | ((row >> 2) & 3))) << 4); }
    int vaddr[4][2];
    { const int i = lane & 15, g16b = (lane >> 4) & 1, qrow = i >> 2, p = i & 3;
#pragma unroll
      for (int db = 0; db < 4; ++db)
#pragma unroll
        for (int h8 = 0; h8 < 2; ++h8) { const int mlo = (2 * h8 + hi) & 3, chlo = (2 * g16b + (p >> 1)) ^ mlo, chhi = db ^ qrow;
            vaddr[db][h8] = 256 * (4 * hi + qrow + 8 * h8) + 16 * ((chhi << 2) | chlo) + 8 * (p & 1); } }
    for (int unit = F.bid; unit < NH * (T / 256); unit += F.G) {
        const int h = unit & 7, qb = unit >> 3, q0 = qb * 256, qw0 = q0 + 32 * wid, qg = qw0 + r32;
        s16x8 qf[8];
        { const bf16* qrow = P + (size_t)qg * PW + OFF_Q + h * HD + hi * 8;
#pragma unroll
          for (int s = 0; s < 8; ++s) qf[s] = *(const s16x8*)(qrow + 16 * s); }
        f32x16 o[4];
#pragma unroll
        for (int db = 0; db < 4; ++db)
#pragma unroll
            for (int r = 0; r < 16; ++r) o[db][r] = 0.f;
        float R = 1.f;
        int jt = (q0 >> 6) + 3;
        u32x4 kreg[2], vreg[2];
        const bf16* kbase = P + OFF_K + h * HD; const bf16* vbase = P + OFF_V + h * HD;
#define ATT_LOAD(j) do { _Pragma("unroll") for (int i = 0; i < 2; ++i) { const size_t ro = (size_t)((j) * 64 + srow[i]) * PW + sch[i] * 8; \
            kreg[i] = *(const u32x4*)(kbase + ro); vreg[i] = *(const u32x4*)(vbase + ro); } } while (0)
#define ATT_WRITE(b) do { _Pragma("unroll") for (int i = 0; i < 2; ++i) { *(LAS u32x4*)(L + LK + (b) * 16384 + kdst[i]) = kreg[i]; *(LAS u32x4*)(L + LV + (b) * 16384 + vdst[i]) = vreg[i]; } } while (0)
        __syncthreads();
        ATT_LOAD(jt); ATT_WRITE(0);
        __syncthreads();
        int buf = 0; bool wdone = false;
        for (;;) {
            const int k0 = jt * 64; const bool more = jt > 0;
            if (more) ATT_LOAD(jt - 1);
            if (!wdone && k0 < qw0 + 31) {
                const LAS unsigned char* Kb = L + LK + buf * 16384; const LAS unsigned char* Vb = L + LV + buf * 16384;
                f32x16 p0, p1;
#pragma unroll
                for (int r = 0; r < 16; ++r) { p0[r] = 0.f; p1[r] = 0.f; }
#pragma unroll
                for (int s = 0; s < 8; ++s) { const int sw = ((2 * s + hi) ^ (r32 & 15)) << 4;
                    const s16x8 a0 = *(const LAS s16x8*)(Kb + r32 * 256 + sw), a1 = *(const LAS s16x8*)(Kb + (32 + r32) * 256 + sw);
                    p0 = __builtin_amdgcn_mfma_f32_32x32x16_bf16(a0, qf[s], p0, 0, 0, 0); p1 = __builtin_amdgcn_mfma_f32_32x32x16_bf16(a1, qf[s], p1, 0, 0, 0); }
                const bool diag = (k0 + 63 >= qw0);
#pragma unroll
                for (int r = 0; r < 16; ++r) { const int kk = k0 + (r & 3) + 8 * (r >> 2) + 4 * hi;
                    float e0 = __builtin_amdgcn_exp2f(fminf(p0[r] * c2, 100.f)), e1 = __builtin_amdgcn_exp2f(fminf(p1[r] * c2, 100.f));
                    if (diag) { if (kk >= qg) e0 = 0.f; if (kk + 32 >= qg) e1 = 0.f; }
                    p0[r] = __builtin_amdgcn_rcpf(1.0f + e0); p1[r] = __builtin_amdgcn_rcpf(1.0f + e1); }
                float Gp[8], Pn[8], Sx[8];
#pragma unroll
                for (int i = 0; i < 4; ++i) { Gp[i] = (p0[4 * i] * p0[4 * i + 1]) * (p0[4 * i + 2] * p0[4 * i + 3]); Gp[4 + i] = (p1[4 * i] * p1[4 * i + 1]) * (p1[4 * i + 2] * p1[4 * i + 3]); }
#pragma unroll
                for (int g = 0; g < 8; ++g) Pn[g] = xhalf(Gp[g], hi);
                Sx[7] = R;
#pragma unroll
                for (int g = 6; g >= 0; --g) Sx[g] = Sx[g + 1] * (Gp[g + 1] * Pn[g + 1]);
                R = Sx[0] * (Gp[0] * Pn[0]);
#pragma unroll
                for (int g = 0; g < 8; ++g) { float s = hi ? Sx[g] : Sx[g] * Pn[g];
#pragma unroll
                    for (int e = 3; e >= 0; --e) { const int r = 4 * (g & 3) + e; const float rv = (g < 4) ? p0[r] : p1[r]; const float t = s * rv; if (g < 4) p0[r] = s - t; else p1[r] = s - t; s = t; } }
                s16x8 pa[4];
#pragma unroll
                for (int ks = 0; ks < 4; ++ks) { u32x4 w;
#pragma unroll
                    for (int j = 0; j < 4; ++j) { const int r = 8 * (ks & 1) + 2 * j; w[j] = (ks < 2) ? pg8::cvt_pk_bf16(p0[r], p0[r + 1]) : pg8::cvt_pk_bf16(p1[r], p1[r + 1]); }
                    pa[ks] = __builtin_bit_cast(s16x8, w); }
#pragma unroll
                for (int db = 0; db < 4; ++db)
#pragma unroll
                    for (int ks = 0; ks < 4; ++ks) { const int rb = 256 * (16 * ks);
                        const s16x4 lo = vtr16(Vb + vaddr[db][0] + rb), hi4 = vtr16(Vb + vaddr[db][1] + rb);
                        const s16x8 vf = (s16x8){lo[0], lo[1], lo[2], lo[3], hi4[0], hi4[1], hi4[2], hi4[3]};
                        o[db] = __builtin_amdgcn_mfma_f32_32x32x16_bf16(pa[ks], vf, o[db], 0, 0, 0); }
            }
            if (ATTN_EARLY_EXIT) wdone = wdone || __all(R < 1e-30f);
            if (lane == 0) *(LAS unsigned*)(L + LFL + buf * 32 + wid * 4) = wdone ? 1u : 0u;
            if (more) ATT_WRITE(buf ^ 1);
            __syncthreads();
            const u32x4 f0 = *(const LAS u32x4*)(L + LFL + buf * 32), f1 = *(const LAS u32x4*)(L + LFL + buf * 32 + 16);
            const bool alldone = (f0.x & f0.y & f0.z & f0.w & f1.x & f1.y & f1.z & f1.w) != 0u;
            if (!more || alldone) break;
            buf ^= 1; --jt;
        }
#undef ATT_LOAD
#undef ATT_WRITE
        bf16* yb = YB + (size_t)qw0 * AW + h * HD + r32;
#pragma unroll
        for (int db = 0; db < 4; ++db)
#pragma unroll
            for (int r = 0; r < 16; ++r) { const int q = (r & 3) + 8 * (r >> 2) + 4 * hi; yb[(size_t)q * AW + 32 * db] = (bf16)f2bf(o[db][r]); }
    }
    __syncthreads();
}


__device__ __forceinline__ void p2_gating_mfma(Frame& F, const bool early) {
    LAS unsigned char* L = (LAS unsigned char*)F.lds;
    constexpr int LA = 0, LB = 32768, LO = 0;
    const int tid = F.tid, lane = F.lane, wid = F.wave, r32 = lane & 31, hi = lane >> 5, wr = wid >> 1, wc = wid & 1;
    const bf16* P = F_PROJ;
    int vaddr[2][2];
    { const int i = lane & 15, g16b = (lane >> 4) & 1, qrow = i >> 2, p = i & 3;
#pragma unroll
      for (int nb = 0; nb < 2; ++nb)
#pragma unroll
        for (int q4 = 0; q4 < 2; ++q4) { const int db = 2 * wc + nb, mlo = (2 * hi + q4) & 3, chlo = (2 * g16b + (p >> 1)) ^ mlo, chhi = db ^ qrow;
            vaddr[nb][q4] = 256 * (8 * hi + 4 * q4 + qrow) + 16 * ((chhi << 2) | chlo) + 8 * (p & 1); } }
    volatile LAS int* gslot = (volatile LAS int*)((LAS unsigned char*)F.lds + GQ_LDS_OFF);
    for (;;) {
        __syncthreads();
        if (tid == 0) { int it = -1;
            if (!early || (int)__hip_atomic_load(F_ctl + CW_UDONE, __ATOMIC_RELAXED, __HIP_MEMORY_SCOPE_AGENT) < NPROJ_UNITS) it = (int)__hip_atomic_fetch_add(F_ctl + CW_GQ, 1u, __ATOMIC_RELAXED, __HIP_MEMORY_SCOPE_AGENT);
            gslot[0] = it; }
        __syncthreads();
        const int item = gslot[0];
        if (item < 0 || item >= (T / CHK) * 8) break;
        const int c = item >> 3, g = item & 7, t0 = c * CHK;
        if (early) {
            if (tid < 64) { unsigned* w = F_ctl + CW_PANEL + 64 * (c >> 1); unsigned sp = 0;
                while ((unsigned)__builtin_amdgcn_readfirstlane(__hip_atomic_load(w, __ATOMIC_RELAXED, __HIP_MEMORY_SCOPE_AGENT)) < 64u) { __builtin_amdgcn_s_sleep(2); if (++sp > (1u << 22)) break; }
                __builtin_amdgcn_fence(__ATOMIC_ACQUIRE, "agent");
                asm volatile("s_waitcnt vmcnt(0)" ::: "memory"); } }
        __syncthreads();
        f32x4 wa[4], wb[4];
#pragma unroll
        for (int i = 0; i < 4; ++i) { const int cid = tid + 512 * i, t = cid >> 4, ch = cid & 15; const float* wp = F_w_sp + (size_t)g * 16384 + t * 128 + ch * 8; wa[i] = *(const f32x4*)wp; wb[i] = *(const f32x4*)(wp + 4); }
        { const int rr = lane >> 4, q = lane & 15; const int col = g * 128 + q * 8;
          const f32x4 g0 = *(const f32x4*)(F_ln_g + col), g1 = *(const f32x4*)(F_ln_g + col + 4), b0 = *(const f32x4*)(F_ln_b + col), b1 = *(const f32x4*)(F_ln_b + col + 4);
          u32x4 wall[4][8];
#pragma unroll
          for (int pass = 0; pass < 4; ++pass) { const u32x4* row = (const u32x4*)(P + (size_t)(t0 + 16 * wid + 4 * pass + rr) * PW + OFF_GV) + q;
#pragma unroll
            for (int i = 0; i < 8; ++i) wall[pass][i] = row[16 * i]; }
#pragma unroll
          for (int pass = 0; pass < 4; ++pass) { const int s = 16 * wid + 4 * pass + rr;
            u32x4 w[8];
#pragma unroll
            for (int i = 0; i < 8; ++i) w[i] = wall[pass][i];
            float sm = 0.f, s2 = 0.f; u32x4 v = w[0];
#pragma unroll
            for (int i = 0; i < 8; ++i) { if (i == g) v = w[i];
#pragma unroll
                for (int e = 0; e < 4; ++e) { const float a = __uint_as_float(w[i][e] << 16), b = __uint_as_float(w[i][e] & 0xffff0000u); sm += a + b; s2 += a * a + b * b; } }
#pragma unroll
            for (int o = 1; o < 16; o <<= 1) { sm += __shfl_xor(sm, o); s2 += __shfl_xor(s2, o); }
            const float mu = sm * (1.f / AW), rs = rsqrtf(fmaxf(s2 * (1.f / AW) - mu * mu, 0.f) + EPS);
            u32x4 o4; o4.x = pk2((__uint_as_float(v.x << 16) - mu) * rs * g0.x + b0.x, (__uint_as_float(v.x & 0xffff0000u) - mu) * rs * g0.y + b0.y);
            o4.y = pk2((__uint_as_float(v.y << 16) - mu) * rs * g0.z + b0.z, (__uint_as_float(v.y & 0xffff0000u) - mu) * rs * g0.w + b0.w);
            o4.z = pk2((__uint_as_float(v.z << 16) - mu) * rs * g1.x + b1.x, (__uint_as_float(v.z & 0xffff0000u) - mu) * rs * g1.y + b1.y);
            o4.w = pk2((__uint_as_float(v.w << 16) - mu) * rs * g1.z + b1.z, (__uint_as_float(v.w & 0xffff0000u) - mu) * rs * g1.w + b1.w);
            *(LAS u32x4*)(L + LB + s * 256 + ((q ^ (((s & 3) << 2) | ((s >> 2) & 3))) << 4)) = o4; } }
#pragma unroll
        for (int i = 0; i < 4; ++i) { const int cid = tid + 512 * i, t = cid >> 4, ch = cid & 15; const f32x4 a = wa[i], b = wb[i]; const int s0 = ch * 8;
            u32x4 w; w.x = pk2(s0 + 0 <= t ? a.x : 0.f, s0 + 1 <= t ? a.y : 0.f); w.y = pk2(s0 + 2 <= t ? a.z : 0.f, s0 + 3 <= t ? a.w : 0.f);
            w.z = pk2(s0 + 4 <= t ? b.x : 0.f, s0 + 5 <= t ? b.y : 0.f); w.w = pk2(s0 + 6 <= t ? b.z : 0.f, s0 + 7 <= t ? b.w : 0.f);
            *(LAS u32x4*)(L + LA + t * 256 + ((ch ^ (t & 15)) << 4)) = w; }
        __syncthreads();
        f32x16 acc[2];
#pragma unroll
        for (int nb = 0; nb < 2; ++nb)
#pragma unroll
            for (int r = 0; r < 16; ++r) acc[nb][r] = 0.f;
        const int trow = 32 * wr + r32;
        for (int ks = 0; ks < 2 * (wr + 1); ++ks) {
            const s16x8 a = *(const LAS s16x8*)(L + LA + trow * 256 + (((2 * ks + hi) ^ (trow & 15)) << 4));
#pragma unroll
            for (int nb = 0; nb < 2; ++nb) { const s16x4 lo = vtr16(L + LB + vaddr[nb][0] + 4096 * ks), h4 = vtr16(L + LB + vaddr[nb][1] + 4096 * ks);
                const s16x8 b = (s16x8){lo[0], lo[1], lo[2], lo[3], h4[0], h4[1], h4[2], h4[3]};
                acc[nb] = __builtin_amdgcn_mfma_f32_32x32x16_bf16(a, b, acc[nb], 0, 0, 0); }
        }
        __syncthreads();
        { float* ot = (float*)(F.lds + LO);
#pragma unroll
          for (int nb = 0; nb < 2; ++nb)
#pragma unroll
            for (int r = 0; r < 16; ++r) { const int t = 32 * wr + (r & 3) + 8 * (r >> 2) + 4 * hi; ot[t * 132 + 64 * wc + 32 * nb + r32] = acc[nb][r]; }
          __syncthreads();
#pragma unroll
          for (int i = 0; i < 4; ++i) { const int cid = tid + 512 * i, t = cid >> 4, ch = cid & 15; const int col = g * 128 + ch * 8;
            const f32x4 m0 = *(const f32x4*)(ot + t * 132 + ch * 8), m1 = *(const f32x4*)(ot + t * 132 + ch * 8 + 4);
            const u32x4 u = *(const u32x4*)(P + (size_t)(t0 + t) * PW + OFF_U + col); const float bb = F_b_sp[g * 128 + t];
            float uf[8];
#pragma unroll
            for (int e = 0; e < 4; ++e) { uf[2 * e] = __uint_as_float(u[e] << 16); uf[2 * e + 1] = __uint_as_float(u[e] & 0xffff0000u); }
            if (GELU_U_LATE) {
#pragma unroll
                for (int e = 0; e < 8; ++e) uf[e] = gelu_tanh(uf[e]); }
            u32x4 y; y.x = pk2(uf[0] * (m0.x + bb), uf[1] * (m0.y + bb)); y.y = pk2(uf[2] * (m0.z + bb), uf[3] * (m0.w + bb));
            y.z = pk2(uf[4] * (m1.x + bb), uf[5] * (m1.y + bb)); y.w = pk2(uf[6] * (m1.z + bb), uf[7] * (m1.w + bb));
            *(u32x4*)(F_YA + (size_t)(t0 + t) * AW + col) = y; } }
    }
    __syncthreads();
}
__device__ __forceinline__ void route_thread(Frame& F, int t, const float* lg36, float rstd) {
    float lg[4];
#pragma unroll
    for (int i = 0; i < 4; ++i) lg[i] = lg36[32 + i] * rstd + F_b_rg[i];
    int grp = 0; float m = lg[0];
#pragma unroll
    for (int i = 1; i < 4; ++i) if (lg[i] > m) { m = lg[i]; grp = i; }
    float ssum = 0.f;
#pragma unroll
    for (int i = 0; i < 4; ++i) ssum += __expf(lg[i] - m);
    const float pg = 1.0f / ssum;
    float le[8];
#pragma unroll
    for (int i = 0; i < 8; ++i) le[i] = lg36[grp * 8 + i] * rstd + F_b_re[grp * 8 + i];
    int i1 = 0; float v1 = le[0];
#pragma unroll
    for (int i = 1; i < 8; ++i) if (le[i] > v1) { v1 = le[i]; i1 = i; }
    int i2 = -1; float v2 = -3.0e38f;
#pragma unroll
    for (int i = 0; i < 8; ++i) if (i != i1 && le[i] > v2) { v2 = le[i]; i2 = i; }
    const float ed = __expf(v2 - v1), pe1 = 1.0f / (1.0f + ed), pe2 = ed * pe1;
    const int e0 = grp * 8 + i1, e1 = grp * 8 + i2;
    const int p0 = (int)atomicAdd(F_ctl + CW_CNT + CNT_STRIDE * e0, 1u), p1 = (int)atomicAdd(F_ctl + CW_CNT + CNT_STRIDE * e1, 1u);
    F_LTOK[e0 * T + p0] = t; F_LW[e0 * T + p0] = pg * pe1; F_LRSTD[e0 * T + p0] = rstd;
    F_LTOK[e1 * T + p1] = t; F_LW[e1 * T + p1] = pg * pe2; F_LRSTD[e1 * T + p1] = rstd;
    F_TINFO[t * 4 + 0] = e0; F_TINFO[t * 4 + 1] = e1; F_TINFO[t * 4 + 2] = p0; F_TINFO[t * 4 + 3] = p1;
}
__device__ __forceinline__ void p5_router_mfma(Frame& F) {
    float* xs = (float*)F.lds;
    float* part = xs + 32 * 513;
    float* ssq = part + 8 * 32 * 36;
    float* lgt = ssq + 256;
    const int tid = F.tid, lane = F.lane, wid = F.wave, r32 = lane & 31, hi = lane >> 5;
    const float *X1 = F_out, *gf = F_g_ffn, *Wre = F_w_re, *Wrg = F_w_rg;
    for (int tb = F.bid; tb < T / 32; tb += F.G) {
        const int t0 = tb * 32;
        f32x16 acc, accg;
#pragma unroll
        for (int r = 0; r < 16; ++r) { acc[r] = 0.f; accg[r] = 0.f; }
        f32x4 xv[8];
#pragma unroll
        for (int i = 0; i < 8; ++i) { const int idx = tid + 512 * i, row = idx >> 7, c4 = idx & 127; xv[i] = *(const f32x4*)(X1 + (size_t)(t0 + row) * D + c4 * 4); }
        for (int kc = 0; kc < 4; ++kc) {
            __syncthreads();
#pragma unroll
            for (int i = 0; i < 8; ++i) { const int idx = tid + 512 * i, row = idx >> 7, c4 = idx & 127;
                const f32x4 v = xv[i], g = *(const f32x4*)(gf + kc * 512 + c4 * 4);
                const float ss = wave_sum((v.x * v.x + v.y * v.y) + (v.z * v.z + v.w * v.w));
                if (lane == 0) ssq[row * 8 + kc * 2 + (wid & 1)] = ss;
                float* d = xs + row * 513 + c4 * 4; d[0] = v.x * g.x; d[1] = v.y * g.y; d[2] = v.z * g.z; d[3] = v.w * g.w; }
            const int kw0 = wid * 64; float wb[32], wg[32];
#pragma unroll
            for (int s = 0; s < 32; ++s) { const int kg = kc * 512 + kw0 + 2 * s + hi; wb[s] = Wre[(size_t)kg * 32 + r32]; wg[s] = (r32 < 4) ? Wrg[(size_t)kg * 4 + r32] : 0.f; }
            if (kc < 3) {
#pragma unroll
                for (int i = 0; i < 8; ++i) { const int idx = tid + 512 * i, row = idx >> 7, c4 = idx & 127; xv[i] = *(const f32x4*)(X1 + (size_t)(t0 + row) * D + (kc + 1) * 512 + c4 * 4); } }
            __syncthreads();
#pragma unroll
            for (int s = 0; s < 32; ++s) { const float a = xs[r32 * 513 + kw0 + 2 * s + hi];
                acc = __builtin_amdgcn_mfma_f32_32x32x2f32(a, wb[s], acc, 0, 0, 0); accg = __builtin_amdgcn_mfma_f32_32x32x2f32(a, wg[s], accg, 0, 0, 0); }
        }
#pragma unroll
        for (int r = 0; r < 16; ++r) { const int i = (r & 3) + 8 * (r >> 2) + 4 * hi; part[(wid * 32 + i) * 36 + r32] = acc[r]; if (r32 < 4) part[(wid * 32 + i) * 36 + 32 + r32] = accg[r]; }
        __syncthreads();
        for (int o = tid; o < 32 * 36; o += NTHR) { float s = 0.f;
#pragma unroll
            for (int w = 0; w < 8; ++w) s += part[w * 1152 + o];
            lgt[o] = s; }
        __syncthreads();
        if (tid < 32) { float s = 0.f;
#pragma unroll
            for (int q = 0; q < 8; ++q) s += ssq[tid * 8 + q];
            route_thread(F, t0 + tid, lgt + tid * 36, rsqrtf(s * (1.f / D) + EPS)); }
    }
    __syncthreads();
}


__device__ __forceinline__ void route_decide(Frame& F, const float* lg36, float rstd, int& e0, int& e1, float& w0, float& w1) {
    float lg[4];
#pragma unroll
    for (int i = 0; i < 4; ++i) lg[i] = lg36[32 + i] * rstd + F_b_rg[i];
    int grp = 0; float m = lg[0];
#pragma unroll
    for (int i = 1; i < 4; ++i) if (lg[i] > m) { m = lg[i]; grp = i; }
    float ssum = 0.f;
#pragma unroll
    for (int i = 0; i < 4; ++i) ssum += __expf(lg[i] - m);
    const float pg = 1.0f / ssum;
    float le[8];
#pragma unroll
    for (int i = 0; i < 8; ++i) le[i] = lg36[grp * 8 + i] * rstd + F_b_re[grp * 8 + i];
    int i1 = 0; float v1 = le[0];
#pragma unroll
    for (int i = 1; i < 8; ++i) if (le[i] > v1) { v1 = le[i]; i1 = i; }
    int i2 = -1; float v2 = -3.0e38f;
#pragma unroll
    for (int i = 0; i < 8; ++i) if (i != i1 && le[i] > v2) { v2 = le[i]; i2 = i; }
    const float ed = __expf(v2 - v1), pe1 = 1.0f / (1.0f + ed), pe2 = ed * pe1;
    e0 = grp * 8 + i1; e1 = grp * 8 + i2; w0 = pg * pe1; w1 = pg * pe2;
}
__device__ __forceinline__ void p5_router_split(Frame& F) {
    unsigned char* ahL = F.lds; unsigned char* alL = F.lds + 32 * 1040;
    float* part = (float*)F.lds;
    float* ssq = (float*)(F.lds + 66560);
    float* lgt = ssq + 256;
    int* lcnt = (int*)(lgt + 32 * 36); int* lbase = lcnt + 32;
    const int tid = F.tid, lane = F.lane, wid = F.wave, r32 = lane & 31, hi = lane >> 5;
    const float* X1 = F_out; const bf16* WF = WSP(bf16, WS_WRH);
    for (int tb = F.bid; tb < T / 32; tb += F.G) {
        const int t0 = tb * 32;
        f32x16 acc0, acc1;
#pragma unroll
        for (int r = 0; r < 16; ++r) { acc0[r] = 0.f; acc1[r] = 0.f; }
        f32x4 xv[8];
#pragma unroll
        for (int i = 0; i < 8; ++i) { const int idx = tid + 512 * i, row = idx >> 7, c4 = idx & 127; xv[i] = *(const f32x4*)(X1 + (size_t)(t0 + row) * D + c4 * 4); }
        for (int kc = 0; kc < 4; ++kc) {
            __syncthreads();
#pragma unroll
            for (int i = 0; i < 8; ++i) { const int idx = tid + 512 * i, row = idx >> 7, c4 = idx & 127; const f32x4 v = xv[i];
                const float ss = wave_sum((v.x * v.x + v.y * v.y) + (v.z * v.z + v.w * v.w));
                if (lane == 0) ssq[row * 8 + kc * 2 + (wid & 1)] = ss;
                u32x2 ph, pl; ph.x = pg8::cvt_pk_bf16(v.x, v.y); ph.y = pg8::cvt_pk_bf16(v.z, v.w);
                pl.x = pg8::cvt_pk_bf16(v.x - __uint_as_float(ph.x << 16), v.y - __uint_as_float(ph.x & 0xffff0000u)); pl.y = pg8::cvt_pk_bf16(v.z - __uint_as_float(ph.y << 16), v.w - __uint_as_float(ph.y & 0xffff0000u));
                *(u32x2*)(ahL + row * 1040 + c4 * 8) = ph; *(u32x2*)(alL + row * 1040 + c4 * 8) = pl; }
            s16x8 bfr[4][4];
            { const bf16* wp = WF + ((size_t)(kc * 8 + wid) * 4) * 2048 + lane * 8;
#pragma unroll
              for (int s4 = 0; s4 < 4; ++s4)
#pragma unroll
                for (int q = 0; q < 4; ++q) bfr[s4][q] = *(const s16x8*)(wp + (size_t)s4 * 2048 + q * 512); }
            if (kc < 3) {
#pragma unroll
                for (int i = 0; i < 8; ++i) { const int idx = tid + 512 * i, row = idx >> 7, c4 = idx & 127; xv[i] = *(const f32x4*)(X1 + (size_t)(t0 + row) * D + (kc + 1) * 512 + c4 * 4); } }
            __syncthreads();
#pragma unroll
            for (int s4 = 0; s4 < 4; ++s4) { const int ko = (64 * wid + 16 * s4 + 8 * hi) * 2;
                const s16x8 ah = *(const s16x8*)(ahL + r32 * 1040 + ko), al = *(const s16x8*)(alL + r32 * 1040 + ko);
                acc0 = __builtin_amdgcn_mfma_f32_32x32x16_bf16(ah, bfr[s4][0], acc0, 0, 0, 0); acc0 = __builtin_amdgcn_mfma_f32_32x32x16_bf16(ah, bfr[s4][1], acc0, 0, 0, 0); acc0 = __builtin_amdgcn_mfma_f32_32x32x16_bf16(al, bfr[s4][0], acc0, 0, 0, 0);
                acc1 = __builtin_amdgcn_mfma_f32_32x32x16_bf16(ah, bfr[s4][2], acc1, 0, 0, 0); acc1 = __builtin_amdgcn_mfma_f32_32x32x16_bf16(ah, bfr[s4][3], acc1, 0, 0, 0); acc1 = __builtin_amdgcn_mfma_f32_32x32x16_bf16(al, bfr[s4][2], acc1, 0, 0, 0); }
        }
        __syncthreads();
#pragma unroll
        for (int r = 0; r < 16; ++r) { const int i = (r & 3) + 8 * (r >> 2) + 4 * hi; part[(wid * 32 + i) * 64 + r32] = acc0[r]; if (r32 < 4) part[(wid * 32 + i) * 64 + 32 + r32] = acc1[r]; }
        if (tid < 32) lcnt[tid] = 0;
        __syncthreads();
        for (int o = tid; o < 32 * 36; o += NTHR) { const int i = o / 36, j = o - i * 36; float s = 0.f;
#pragma unroll
            for (int w = 0; w < 8; ++w) s += part[(w * 32 + i) * 64 + j];
            lgt[o] = s; }
        __syncthreads();
        int e0 = 0, e1 = 0, q0 = 0, q1 = 0; float w0 = 0.f, w1 = 0.f, rstd = 0.f;
        if (tid < 32) { float s = 0.f;
#pragma unroll
            for (int q = 0; q < 8; ++q) s += ssq[tid * 8 + q];
            rstd = rsqrtf(s * (1.f / D) + EPS);
            route_decide(F, lgt + tid * 36, rstd, e0, e1, w0, w1);
            q0 = atomicAdd(&lcnt[e0], 1); q1 = atomicAdd(&lcnt[e1], 1); }
        __syncthreads();
        if (tid < 32) { const int n = lcnt[tid]; lbase[tid] = n ? (int)atomicAdd(F_ctl + CW_CNT + CNT_STRIDE * tid, (unsigned)n) : 0; }
        __syncthreads();
        if (tid < 32) { const int t = t0 + tid, p0 = lbase[e0] + q0, p1 = lbase[e1] + q1;
            F_LTOK[e0 * T + p0] = t; F_LW[e0 * T + p0] = w0; F_LRSTD[e0 * T + p0] = rstd;
            F_LTOK[e1 * T + p1] = t; F_LW[e1 * T + p1] = w1; F_LRSTD[e1 * T + p1] = rstd;
            F_TINFO[t * 4 + 0] = e0; F_TINFO[t * 4 + 1] = e1; F_TINFO[t * 4 + 2] = p0; F_TINFO[t * 4 + 3] = p1; }
    }
    __syncthreads();
}
#define XB_TMO      128
#define XB_XCNT(j)  (256  + 64 * (j))
#define XB_XSUB(j)  (1280 + 64 * (j))
#define XB_XGEN(j)  (2304 + 64 * (j))
#define XB_TOP      3328
#define XB_TOPGEN   3392
#define XCD_BAR_WORDS 3456
#define XB_SPIN_CAP (1u << 18)
__device__ __forceinline__ unsigned xb_ld(unsigned* p)              { return __hip_atomic_load(p, __ATOMIC_RELAXED, __HIP_MEMORY_SCOPE_AGENT); }
__device__ __forceinline__ unsigned xb_add(unsigned* p, unsigned v) { return __hip_atomic_fetch_add(p, v, __ATOMIC_RELAXED, __HIP_MEMORY_SCOPE_AGENT); }
__device__ __forceinline__ unsigned xb_xcc_id() { return (unsigned)__builtin_amdgcn_s_getreg((3 << 11) | 20) & 0xFu; }
#define XB_SPIN(cond, bar) do { unsigned _sp = 0; while (cond) { __builtin_amdgcn_s_sleep(1); \
    if ((++_sp & 255u) == 0u) { if (xb_ld(&(bar)[XB_TMO])) break; if (_sp > XB_SPIN_CAP) { atomicAdd(&(bar)[XB_TMO], 1u); break; } } } } while (0)
struct XcdBarrier { unsigned* bar; unsigned x; volatile LAS unsigned* st; };
__device__ __forceinline__ XcdBarrier xcd_barrier_post(unsigned* bar, volatile LAS unsigned* st) {
    XcdBarrier b; b.bar = bar; b.x = xb_xcc_id(); b.st = st;
    if (threadIdx.x == 0) (void)xb_add(&bar[XB_XCNT(b.x)], 1u);
    return b;
}
__device__ __forceinline__ void xcd_barrier_complete(unsigned* bar, unsigned x, unsigned& nloc, unsigned& nx) {
    const unsigned G = gridDim.x * gridDim.y * gridDim.z;
    unsigned sum, cnt, mine, sp = 0u;
    for (;;) {
        sum = 0u; cnt = 0u; mine = 0u;
#pragma unroll
        for (unsigned j = 0; j < 16; ++j) { const unsigned c = xb_ld(&bar[XB_XCNT(j)]); sum += c; cnt += (c > 0u) ? 1u : 0u; mine = (j == x) ? c : mine; }
        if (sum == G) break;
        __builtin_amdgcn_s_sleep(1);
        if ((++sp & 255u) == 0u) { if (xb_ld(&bar[XB_TMO])) break; if (sp > XB_SPIN_CAP) { atomicAdd(&bar[XB_TMO], 1u); break; } }
    }
    nloc = mine > 0u ? mine : 1u; nx = cnt > 0u ? cnt : 1u;
}
__device__ __forceinline__ void xcd_barrier(const XcdBarrier& b) {
    asm volatile("s_waitcnt vmcnt(0)" ::: "memory");
    __syncthreads();
    if (threadIdx.x == 0) {
        unsigned* bar = b.bar;
        __builtin_amdgcn_s_waitcnt(0);
        unsigned nloc = b.st[0], nx = b.st[1];
        if (nloc == 0u) { xcd_barrier_complete(bar, b.x, nloc, nx); b.st[0] = nloc; b.st[1] = nx; }
        const unsigned old = xb_add(&bar[XB_XSUB(b.x)], 1u);
        const unsigned gen = old / nloc;
        if (old + 1u == (gen + 1u) * nloc) {
            __builtin_amdgcn_fence(__ATOMIC_RELEASE, "agent");
            asm volatile("s_waitcnt vmcnt(0)" ::: "memory");
            const unsigned og = xb_add(&bar[XB_TOP], 1u);
            const unsigned tg = og / nx;
            if (og + 1u == (tg + 1u) * nx) xb_add(&bar[XB_TOPGEN], 1u);
            else XB_SPIN(xb_ld(&bar[XB_TOPGEN]) == tg, bar);
            __builtin_amdgcn_fence(__ATOMIC_ACQUIRE, "agent");
            xb_add(&bar[XB_XGEN(b.x)], 1u);
            asm volatile("s_waitcnt vmcnt(0)" ::: "memory");
        } else {
            XB_SPIN(xb_ld(&bar[XB_XGEN(b.x)]) == gen, bar);
            __builtin_amdgcn_fence(__ATOMIC_ACQUIRE, "agent");
            asm volatile("s_waitcnt vmcnt(0)" ::: "memory");
        }
    }
    __syncthreads();
}
constexpr int CW_BAR = 4096; static_assert((CW_BAR + XCD_BAR_WORDS) * 4 <= (int)CTL_ZERO_BYTES, "barrier words inside the zeroed control region");
constexpr int XB_LDS_OFF = LDS_BYTES - 16;
__global__ void __launch_bounds__(NTHR, 2) fwd_kernel(Args args) {
    extern __shared__ __attribute__((aligned(16))) unsigned char lds[];
    cg::grid_group grid = cg::this_grid();
    Frame F;
    F.lds = lds; F.tid = threadIdx.x; F.lane = F.tid & 63; F.wave = __builtin_amdgcn_readfirstlane(F.tid >> 6); F.G = gridDim.x; F.bid = blockIdx.x; F.A = &args;
    const int lo = args.ph_lo, hi = args.ph_hi;
#define IN(k) (lo <= (k) && (k) < hi)
    volatile LAS unsigned* xbst = (volatile LAS unsigned*)((LAS unsigned char*)lds + XB_LDS_OFF);
    if (F.tid < 4) xbst[F.tid] = 0u;
    __syncthreads();
    XcdBarrier xbar = xcd_barrier_post(F_ctl + CW_BAR, xbst);
#define SEAM(k) do { if (IN(k) && IN((k) + 1)) { if (!XCD_BARRIER || args.use_cg) grid.sync(); else xcd_barrier(xbar); } } while (0)
    if (IN(0)) { if (MFMA_MASK) p0_weights(F); if (ROUTER_MFMA == 2) p0_router_weights(F); p0_prologue(F); if (PROBE_REPEAT & (1 << 0)) { grid.sync(); if (MFMA_MASK) p0_weights(F); p0_prologue(F); } } SEAM(0);
    if (IN(1)) { if (MFMA_MASK & 1) p1_proj_mfma(F); else p1_proj(F); if (PROBE_REPEAT & (1 << 1)) { grid.sync(); if (MFMA_MASK & 1) p1_proj_mfma(F); else p1_proj(F); } } SEAM(1);
    if (IN(2)) { p2_gating_mfma(F, false); if (ATTN_MFMA) p2_attn_mfma(F); else p2_attn(F); if (PROBE_REPEAT & 4) { grid.sync(); if (ATTN_MFMA) p2_attn_mfma(F); else p2_attn(F); } } SEAM(2);
    if (IN(3)) { if (MFMA_MASK & 2) p3_branch_mfma(F); else p3_branch(F); if (PROBE_REPEAT & (1 << 3)) { grid.sync(); if (MFMA_MASK & 2) p3_branch_mfma(F); else p3_branch(F); } } SEAM(3);
    if (IN(4)) { if (MFMA_MASK & 4) p4_out_mfma(F); else p4_out(F); } SEAM(4);
    if (IN(5)) { if (ROUTER_MFMA == 2) p5_router_split(F); else if (ROUTER_MFMA) p5_router_mfma(F); else p5_router(F); } SEAM(5);
    if (IN(6)) { if (MFMA_MASK & 8) p6_gateup_mfma(F); else p6_gateup(F); if (PROBE_REPEAT & (1 << 6)) { grid.sync(); if (MFMA_MASK & 8) p6_gateup_mfma(F); else p6_gateup(F); } } SEAM(6);
    if (IN(7)) { if (MFMA_MASK & 16) p7_down_mfma(F, IN(6) && (MFMA_MASK & 8) && !(PROBE_REPEAT & (1 << 6))); else p7_down(F); if (PROBE_REPEAT & (1 << 7)) { grid.sync(); if (MFMA_MASK & 16) p7_down_mfma(F, IN(6) && (MFMA_MASK & 8) && !(PROBE_REPEAT & (1 << 6))); else p7_down(F); } } SEAM(7);
    if (IN(8)) { p8_final(F, IN(6) && (MFMA_MASK & 8)); }
#undef IN
#undef SEAM
}

extern "C" void kernel_launch(void* const* d_in, const int* in_sizes, int n_in, void* d_out, int out_size, void* d_ws, size_t ws_size, hipStream_t stream) {
    static int grid = 0;
    if (grid == 0) {
        if (n_in != 19 || out_size != T * D || ws_size < WS_END) { fprintf(stderr, "kernel_launch: unexpected problem (n_in %d out %d ws %zu)\n", n_in, out_size, ws_size); grid = -1; return; }
        int dev = 0, cus = 0, per_cu = 0;
        hipGetDevice(&dev); hipDeviceGetAttribute(&cus, hipDeviceAttributeMultiprocessorCount, dev);
        if (hipFuncSetAttribute((const void*)fwd_kernel, hipFuncAttributeMaxDynamicSharedMemorySize, LDS_BYTES) != hipSuccess) { fprintf(stderr, "kernel_launch: hipFuncSetAttribute failed\n"); grid = -1; return; }
        if (hipOccupancyMaxActiveBlocksPerMultiprocessor(&per_cu, (const void*)fwd_kernel, NTHR, LDS_BYTES) != hipSuccess || per_cu < 1) { fprintf(stderr, "kernel_launch: occupancy query says %d\n", per_cu); per_cu = 1; }
        (void)hipGetLastError();
        grid = cus;
    }
    if (grid < 0) return;
    hipMemsetAsync((char*)d_ws + WS_CTL, 0, CTL_ZERO_BYTES, stream);
    Args a{};
    for (int i = 0; i < 19; ++i) a.in[i] = (const float*)d_in[i];
    a.out = (float*)d_out; a.ws = (unsigned char*)d_ws; a.use_cg = USE_CG_SEAMS; a.pad = 0;
    if (N_LAUNCH_MODE == 1) {
        a.ph_lo = 0; a.ph_hi = N_PHASES; void* kargs[] = {&a};
        hipError_t e = hipLaunchCooperativeKernel((const void*)fwd_kernel, dim3(grid), dim3(NTHR), kargs, LDS_BYTES, stream);
        if (e != hipSuccess) fprintf(stderr, "cooperative launch failed: %s\n", hipGetErrorString(e));
    } else {
        for (int p = 0; p < N_PHASES; ++p) {
            a.ph_lo = p; a.ph_hi = p + 1; void* kargs[] = {&a};
            hipError_t e = hipLaunchCooperativeKernel((const void*)fwd_kernel, dim3(grid), dim3(NTHR), kargs, LDS_BYTES, stream);
            if (e != hipSuccess) { fprintf(stderr, "cooperative launch %d failed: %s\n", p, hipGetErrorString(e)); break; }
        }
    }
}
```

```cpp
#include <hip/hip_runtime.h>
#include <hip/hip_cooperative_groups.h>
#include <cstdio>
#include <cstdint>
namespace cg = cooperative_groups;

#ifndef N_LAUNCH_MODE
#define N_LAUNCH_MODE 1
#endif
#ifndef MFMA_MASK
#define MFMA_MASK 0x1f
#endif
#ifndef ATTN_MFMA
#define ATTN_MFMA 1
#endif
#ifndef ROUTER_MFMA
#define ROUTER_MFMA 3
#endif
#ifndef XCD_BARRIER
#define XCD_BARRIER 1
#endif
#ifndef GATING_MFMA
#define GATING_MFMA 1
#endif
#ifndef OVERLAP_CONV
#define OVERLAP_CONV 1
#endif
#ifndef CONV_CUS
#define CONV_CUS 120
#endif
#ifndef MOE_EARLY_DOWN
#define MOE_EARLY_DOWN 1
#endif
#ifndef EARLY_GATING
#define EARLY_GATING 1
#endif
#ifndef USE_CG_SEAMS
#define USE_CG_SEAMS 0
#endif
#ifndef PROBE_REPEAT
#define PROBE_REPEAT 0
#endif
#ifndef ATTN_EARLY_EXIT
#define GELU_U_LATE ((MFMA_MASK & 1) != 0)
#define P1_WGM 4
#define EARLY_ACQUIRE 1
#define MOE_GU_FP8 ((MFMA_MASK & 12) == 12)
#define MOE_DN_FP8 (MOE_GU_FP8 && (MFMA_MASK & 16) != 0)
#define CONV_WAVES 4
#define Y_FP8 MOE_DN_FP8
#define GATES_FP8 ((MFMA_MASK & 3) == 3 && OVERLAP_CONV)
#define RAW_GATES ((MFMA_MASK & 3) == 3)
#define WT_STORES 1
#define ATTN_EARLY_EXIT 1
#endif

constexpr int T = 8192, D = 2048, PW = 9216, AW = 1024, NH = 8, HD = 128, CHK = 128, NGRP = 4, EPG = 8, NE = 32, DE = 1024;
constexpr int OFF_U = 0, OFF_GV = 1024, OFF_Q = 2048, OFF_K = 3072, OFF_V = 4096, OFF_GA = 5120, OFF_GB = 7168;
constexpr float EPS = 1e-6f;
constexpr int NWAVES = 8, NTHR = 512;
constexpr int N_PHASES = 9;

constexpr size_t MiB = 1u << 20;
constexpr size_t WS_CTL = 0, CTL_ZERO_BYTES = 65536;
constexpr size_t WS_LTOK = 1 * MiB, WS_LW = 2 * MiB, WS_LRSTD = 3 * MiB, WS_TINFO = 4 * MiB;
constexpr size_t WS_STAT = 7 * MiB;
constexpr size_t WS_WRH = 5 * MiB, WS_WRL = 5 * MiB + 262144;
constexpr size_t WS_WIN_T = 8 * MiB, WS_WA_T = 44 * MiB, WS_WB_T = 48 * MiB, WS_WOUT_T = 52 * MiB, WS_WGU_T = 64 * MiB, WS_WD_T = 320 * MiB;
constexpr size_t WS_XN = 448 * MiB, WS_PROJ = 480 * MiB, WS_YA = 624 * MiB, WS_YB = 640 * MiB, WS_MERGED = 656 * MiB, WS_H2 = 688 * MiB;
constexpr size_t WS_HDN = 720 * MiB, WS_Y = 768 * MiB, WS_TMP = 864 * MiB, WS_END = 928 * MiB;
constexpr int SLOT_CAP = 24576;
constexpr int CW_CNT = 1024, CNT_STRIDE = 64;

constexpr int LDS_BYTES = 147456;

#define LAS __attribute__((address_space(3)))
typedef unsigned short bf16;
typedef float f32x4 __attribute__((ext_vector_type(4)));
typedef unsigned u32x4 __attribute__((ext_vector_type(4)));
typedef unsigned u32x2 __attribute__((ext_vector_type(2)));
typedef float f32x2 __attribute__((ext_vector_type(2)));

__device__ __forceinline__ float bf2f(bf16 v) { return __uint_as_float((unsigned)v << 16); }
__device__ __forceinline__ unsigned f2bf(float f) { unsigned u = __float_as_uint(f); return (u + 0x7fffu + ((u >> 16) & 1u)) >> 16; }
__device__ __forceinline__ unsigned pk2(float lo, float hi) { return f2bf(lo) | (f2bf(hi) << 16); }
__device__ __forceinline__ float wave_sum(float v) {
#pragma unroll
    for (int o = 1; o < 64; o <<= 1) v += __shfl_xor(v, o);
    return v;
}
__device__ __forceinline__ float sigmoidf_(float x) { return __builtin_amdgcn_rcpf(1.0f + __builtin_amdgcn_exp2f(x * -1.4426950408889634f)); }
__device__ __forceinline__ float gelu_tanh(float x) { const float x2 = x * x; const float t = x * (-2.302208198f - 0.1029432397f * x2); return x * __builtin_amdgcn_rcpf(1.0f + __builtin_amdgcn_exp2f(fminf(t, 126.f))); }

struct Args { const float* in[19]; float* out; unsigned char* ws; int ph_lo, ph_hi; int use_cg, pad; };

struct Frame {
    unsigned char* lds;
    int tid, lane, wave, G, bid;
    const Args* A;
};
#define IN_(i) (F.A->in[i])
#define F_x IN_(0)
#define F_g_mix IN_(1)
#define F_w_in IN_(2)
#define F_ln_g IN_(3)
#define F_ln_b IN_(4)
#define F_w_sp IN_(5)
#define F_b_sp IN_(6)
#define F_w_a IN_(7)
#define F_w_b IN_(8)
#define F_w_out IN_(9)
#define F_g_ffn IN_(10)
#define F_w_rg IN_(11)
#define F_b_rg IN_(12)
#define F_w_re IN_(13)
#define F_b_re IN_(14)
#define F_w_gate IN_(15)
#define F_w_up IN_(16)
#define F_w_down IN_(17)
#define F_g_final IN_(18)
#define F_out (F.A->out)
#define WSP(type, off) ((type*)(F.A->ws + (off)))
#define F_ctl WSP(unsigned, WS_CTL)
#define F_XN WSP(bf16, WS_XN)
#define F_PROJ WSP(bf16, WS_PROJ)
#define F_YA WSP(bf16, WS_YA)
#define F_YB WSP(bf16, WS_YB)
#define F_MERGED WSP(bf16, WS_MERGED)
#define F_H2 WSP(bf16, WS_H2)
#define F_HDN WSP(bf16, WS_HDN)
#define F_Y WSP(bf16, WS_Y)
#define F_TMP WSP(float, WS_TMP)
#define F_LTOK WSP(int, WS_LTOK)
#define F_LW WSP(float, WS_LW)
#define F_LRSTD WSP(float, WS_LRSTD)
#define F_TINFO WSP(int, WS_TINFO)

template <bool DUAL, class AF, class BF, class BF2, class EP>
__device__ __forceinline__ void ngemm(unsigned char* lds_, int tid, int M, int N, int K, int tile0, int tstride, AF af, BF bfn, BF2 bfn2, EP ep) {
    float* As = (float*)lds_;
    float* Bs = As + 16 * 132;
    float* Bs2 = Bs + 16 * 68;
    const int mt = (M + 127) / 128, nt = N / 64, ntile = mt * nt;
    const int ty = tid >> 4, tx = tid & 15;
    for (int L = tile0; L < ntile; L += tstride) {
        const int m0 = (L / nt) * 128, n0 = (L % nt) * 64;
        float acc[4][4], acc2[4][4];
#pragma unroll
        for (int i = 0; i < 4; ++i)
#pragma unroll
            for (int j = 0; j < 4; ++j) { acc[i][j] = 0.f; acc2[i][j] = 0.f; }
        for (int k0 = 0; k0 < K; k0 += 16) {
            __syncthreads();
#pragma unroll
            for (int i = 0; i < 4; ++i) { const int idx = tid * 4 + i, r = idx >> 4, kk = idx & 15; const int row = m0 + r; As[kk * 132 + r] = (row < M) ? af(row, k0 + kk) : 0.f; }
#pragma unroll
            for (int i = 0; i < 2; ++i) { const int idx = tid * 2 + i, kk = idx >> 6, n = idx & 63; Bs[kk * 68 + n] = bfn(k0 + kk, n0 + n); if (DUAL) Bs2[kk * 68 + n] = bfn2(k0 + kk, n0 + n); }
            __syncthreads();
#pragma unroll
            for (int kk = 0; kk < 16; ++kk) {
                const f32x4 a = *(const f32x4*)(As + kk * 132 + ty * 4), b = *(const f32x4*)(Bs + kk * 68 + tx * 4);
                f32x4 b2 = (f32x4){0.f, 0.f, 0.f, 0.f}; if (DUAL) b2 = *(const f32x4*)(Bs2 + kk * 68 + tx * 4);
#pragma unroll
                for (int i = 0; i < 4; ++i)
#pragma unroll
                    for (int j = 0; j < 4; ++j) { acc[i][j] += a[i] * b[j]; if (DUAL) acc2[i][j] += a[i] * b2[j]; }
            }
        }
#pragma unroll
        for (int i = 0; i < 4; ++i) { const int row = m0 + ty * 4 + i; if (row < M) {
#pragma unroll
            for (int j = 0; j < 4; ++j) ep(row, n0 + tx * 4 + j, acc[i][j], acc2[i][j]); } }
    }
    __syncthreads();
}

__device__ __forceinline__ unsigned pk4_fp8_sat(float a, float b, float c, float d);
__device__ __forceinline__ void p0_prologue(Frame& F) {
    const int gw = F.bid * NWAVES + F.wave, NGW = F.G * NWAVES;
    for (int g = F.bid * NTHR + F.tid; g < 3 * NE * T / 4; g += F.G * NTHR) ((u32x4*)F_LTOK)[g] = (u32x4){0u, 0u, 0u, 0u};
    f32x4 g[8];
#pragma unroll
    for (int j = 0; j < 8; ++j) g[j] = ((const f32x4*)F_g_mix)[64 * j + F.lane];
    for (int m0 = gw; m0 < T; m0 += 4 * NGW) {
        f32x4 v[4][8];
#pragma unroll
        for (int r = 0; r < 4; ++r) { const int m = m0 + r * NGW;
            if (m < T) { const f32x4* xr = (const f32x4*)(F_x + (size_t)m * D) + F.lane;
#pragma unroll
                for (int j = 0; j < 8; ++j) v[r][j] = xr[64 * j]; } }
#pragma unroll
        for (int r = 0; r < 4; ++r) { const int m = m0 + r * NGW;
            if (m < T) { float s = 0.f;
#pragma unroll
                for (int j = 0; j < 8; ++j) s += (v[r][j].x * v[r][j].x + v[r][j].y * v[r][j].y) + (v[r][j].z * v[r][j].z + v[r][j].w * v[r][j].w);
                const float rstd = rsqrtf(wave_sum(s) * (1.f / D) + EPS);
                u32x2* o = (u32x2*)(F_XN + (size_t)m * D) + F.lane;
#pragma unroll
                for (int j = 0; j < 8; ++j) { u32x2 w; w.x = pk2(v[r][j].x * rstd * g[j].x, v[r][j].y * rstd * g[j].y); w.y = pk2(v[r][j].z * rstd * g[j].z, v[r][j].w * rstd * g[j].w); o[64 * j] = w;
                    if (GATES_FP8) ((unsigned*)(WSP(unsigned char, WS_TMP) + (size_t)m * D))[64 * j + F.lane] = pk4_fp8_sat(v[r][j].x * rstd * g[j].x * 4.f, v[r][j].y * rstd * g[j].y * 4.f, v[r][j].z * rstd * g[j].z * 4.f, v[r][j].w * rstd * g[j].w * 4.f); } } }
    }
}

__device__ __forceinline__ float proj_act(int n, float a) {
    if (n < OFF_Q) return gelu_tanh(a);
    if (n < OFF_GA) return a;
    return sigmoidf_(a);
}
__device__ __forceinline__ void p1_proj(Frame& F) {
    const bf16* XN = F_XN; const float* W = F_w_in; bf16* P = F_PROJ;
    ngemm<false>(F.lds, F.tid, T, PW, D, F.bid, F.G,
        [=](int r, int k) { return bf2f(XN[(size_t)r * D + k]); },
        [=](int k, int n) { return W[(size_t)k * PW + n]; },
        [=](int k, int n) { return 0.f; },
        [=](int r, int n, float a, float) { P[(size_t)r * PW + n] = (bf16)f2bf(proj_act(n, a)); });
}

__device__ __forceinline__ void p2_gating(Frame& F) {
    float* vn = (float*)F.lds;
    float* wsm = vn + 128 * 128;
    float* st = wsm + 128 * 129;
    const int tid = F.tid;
    for (int item = F.bid; item < (T / CHK) * 8; item += F.G) {
        const int c = item >> 3, g = item & 7, t0 = c * CHK;
        __syncthreads();
        {
            const int r = tid >> 2, q = tid & 3; const bf16* row = F_PROJ + (size_t)(t0 + r) * PW + OFF_GV + q * 256;
            float s = 0.f, s2 = 0.f;
            for (int i = 0; i < 32; ++i) { const u32x4 w = ((const u32x4*)row)[i];
#pragma unroll
                for (int e = 0; e < 4; ++e) { const float a = __uint_as_float(w[e] << 16), b = __uint_as_float(w[e] & 0xffff0000u); s += a + b; s2 += a * a + b * b; } }
            s += __shfl_xor(s, 1); s += __shfl_xor(s, 2); s2 += __shfl_xor(s2, 1); s2 += __shfl_xor(s2, 2);
            const float mu = s * (1.f / AW), var = s2 * (1.f / AW) - mu * mu;
            if (q == 0) { st[r * 2] = mu; st[r * 2 + 1] = rsqrtf(fmaxf(var, 0.f) + EPS); }
        }
        for (int i = tid; i < 128 * 128; i += NTHR) { const int t = i >> 7, s = i & 127; wsm[t * 129 + s] = (s <= t) ? F_w_sp[(size_t)g * 16384 + i] : 0.f; }
        __syncthreads();
        for (int i = tid; i < 128 * 128; i += NTHR) { const int s = i >> 7, d = i & 127; const int ch = g * 128 + d;
            const float v = bf2f(F_PROJ[(size_t)(t0 + s) * PW + OFF_GV + ch]);
            vn[i] = (v - st[s * 2]) * st[s * 2 + 1] * F_ln_g[ch] + F_ln_b[ch]; }
        __syncthreads();
        {   const int t = tid >> 2, d0 = (tid & 3) * 32;
            float acc[32];
#pragma unroll
            for (int j = 0; j < 32; ++j) acc[j] = 0.f;
            for (int s = 0; s <= t; ++s) { const float w = wsm[t * 129 + s];
#pragma unroll
                for (int j = 0; j < 32; j += 4) { const f32x4 v = *(const f32x4*)(vn + s * 128 + d0 + j); acc[j] += w * v.x; acc[j + 1] += w * v.y; acc[j + 2] += w * v.z; acc[j + 3] += w * v.w; } }
            const float bb = F_b_sp[g * 128 + t];
            const bf16* urow = F_PROJ + (size_t)(t0 + t) * PW + OFF_U + g * 128 + d0; bf16* yrow = F_YA + (size_t)(t0 + t) * AW + g * 128 + d0;
#pragma unroll
            for (int j = 0; j < 32; ++j) { const float uu = bf2f(urow[j]); yrow[j] = (bf16)f2bf((GELU_U_LATE ? gelu_tanh(uu) : uu) * (acc[j] + bb)); }
        }
    }
    __syncthreads();
}

__device__ __forceinline__ void p2_attn(Frame& F) {
    float* qs = (float*)(F.lds) + F.wave * 128;
    const int gw = F.bid * NWAVES + F.wave, NGW = F.G * NWAVES, lane = F.lane;
    const float scale = 0.08838834764831845f;
    for (int item = gw; item < NH * T; item += NGW) {
        const int h = item / T, t = item % T;
        const bf16* qrow = F_PROJ + (size_t)t * PW + OFF_Q + h * HD;
        qs[lane] = bf2f(qrow[lane]) * scale; qs[lane + 64] = bf2f(qrow[lane + 64]) * scale;
        asm volatile("s_waitcnt lgkmcnt(0)" ::: "memory");
        float R = 1.f, o0 = 0.f, o1 = 0.f;
        const int nb = (t + 63) >> 6;
        for (int b = nb - 1; b >= 0; --b) {
            const int key = b * 64 + lane; const bool valid = key < t;
            const u32x4* krow = (const u32x4*)(F_PROJ + (size_t)key * PW + OFF_K + h * HD);
            float dot = 0.f;
#pragma unroll
            for (int c = 0; c < 16; ++c) { const u32x4 w = krow[c]; const f32x4 q0 = *(const f32x4*)(qs + c * 8), q1 = *(const f32x4*)(qs + c * 8 + 4);
                dot += __uint_as_float(w.x << 16) * q0.x + __uint_as_float(w.x & 0xffff0000u) * q0.y + __uint_as_float(w.y << 16) * q0.z + __uint_as_float(w.y & 0xffff0000u) * q0.w
                     + __uint_as_float(w.z << 16) * q1.x + __uint_as_float(w.z & 0xffff0000u) * q1.y + __uint_as_float(w.w << 16) * q1.z + __uint_as_float(w.w & 0xffff0000u) * q1.w; }
            const float z = fminf(dot, 80.f), e = __expf(z);
            float r = 1.0f / (1.0f + e), beta = e * r;
            if (!valid) { r = 1.f; beta = 0.f; }
            float s = r;
#pragma unroll
            for (int off = 1; off < 64; off <<= 1) { const float v = __shfl_down(s, off); if (lane + off < 64) s *= v; }
            float ex = __shfl_down(s, 1); if (lane == 63) ex = 1.f;
            const float w = beta * ex * R;
            R *= __shfl(s, 0);
            const bf16* vb = F_PROJ + (size_t)(b * 64) * PW + OFF_V + h * HD + lane;
            for (int j = 0; j < 64; ++j) { const float wj = __shfl(w, j); o0 += wj * bf2f(vb[(size_t)j * PW]); o1 += wj * bf2f(vb[(size_t)j * PW + 64]); }
            if (ATTN_EARLY_EXIT && R < 1e-30f) break;
        }
        bf16* yrow = F_YB + (size_t)t * AW + h * HD;
        yrow[lane] = (bf16)f2bf(o0); yrow[lane + 64] = (bf16)f2bf(o1);
    }
}

__device__ __forceinline__ void p3_branch(Frame& F) {
    const bf16 *YA = F_YA, *YB = F_YB, *P = F_PROJ; const float *Wa = F_w_a, *Wb = F_w_b; float* TMP = F_TMP; bf16* MG = F_MERGED;
    ngemm<false>(F.lds, F.tid, T, D, AW, F.bid, F.G,
        [=](int r, int k) { return bf2f(YA[(size_t)r * AW + k]); },
        [=](int k, int n) { return Wa[(size_t)k * D + n]; },
        [=](int k, int n) { return 0.f; },
        [=](int r, int n, float a, float) { TMP[(size_t)r * D + n] = a * bf2f(P[(size_t)r * PW + OFF_GA + n]); });
    ngemm<false>(F.lds, F.tid, T, D, AW, F.bid, F.G,
        [=](int r, int k) { return bf2f(YB[(size_t)r * AW + k]); },
        [=](int k, int n) { return Wb[(size_t)k * D + n]; },
        [=](int k, int n) { return 0.f; },
        [=](int r, int n, float a, float) { MG[(size_t)r * D + n] = (bf16)f2bf(TMP[(size_t)r * D + n] + a * bf2f(P[(size_t)r * PW + OFF_GB + n])); });
}

__device__ __forceinline__ void p4_out(Frame& F) {
    const bf16* MG = F_MERGED; const float *W = F_w_out, *x = F_x, *gf = F_g_ffn; float* X1 = F_out; bf16* H2 = F_H2;
    ngemm<false>(F.lds, F.tid, T, D, D, F.bid, F.G,
        [=](int r, int k) { return bf2f(MG[(size_t)r * D + k]); },
        [=](int k, int n) { return W[(size_t)k * D + n]; },
        [=](int k, int n) { return 0.f; },
        [=](int r, int n, float a, float) { const float v = x[(size_t)r * D + n] + a; X1[(size_t)r * D + n] = v; H2[(size_t)r * D + n] = (bf16)f2bf(v * gf[n]); });
}

__device__ __forceinline__ void route_token(Frame& F, int t, float logit, float rstd) {
    float lg[4], le[8];
#pragma unroll
    for (int i = 0; i < 4; ++i) lg[i] = __shfl(logit, 32 + i);
    int grp = 0; float m = lg[0];
#pragma unroll
    for (int i = 1; i < 4; ++i) if (lg[i] > m) { m = lg[i]; grp = i; }
    float ssum = 0.f;
#pragma unroll
    for (int i = 0; i < 4; ++i) ssum += __expf(lg[i] - m);
    const float pg = 1.0f / ssum;
#pragma unroll
    for (int i = 0; i < 8; ++i) le[i] = __shfl(logit, grp * 8 + i);
    int i1 = 0; float v1 = le[0];
#pragma unroll
    for (int i = 1; i < 8; ++i) if (le[i] > v1) { v1 = le[i]; i1 = i; }
    int i2 = -1; float v2 = -3.0e38f;
#pragma unroll
    for (int i = 0; i < 8; ++i) if (i != i1 && le[i] > v2) { v2 = le[i]; i2 = i; }
    const float ed = __expf(v2 - v1), pe1 = 1.0f / (1.0f + ed), pe2 = ed * pe1;
    if (F.lane == 0) {
        const int e0 = grp * 8 + i1, e1 = grp * 8 + i2;
        const int p0 = (int)atomicAdd(F_ctl + CW_CNT + CNT_STRIDE * e0, 1u), p1 = (int)atomicAdd(F_ctl + CW_CNT + CNT_STRIDE * e1, 1u);
        F_LTOK[e0 * T + p0] = t; F_LW[e0 * T + p0] = pg * pe1; F_LRSTD[e0 * T + p0] = rstd;
        F_LTOK[e1 * T + p1] = t; F_LW[e1 * T + p1] = pg * pe2; F_LRSTD[e1 * T + p1] = rstd;
        F_TINFO[t * 4 + 0] = e0; F_TINFO[t * 4 + 1] = e1; F_TINFO[t * 4 + 2] = p0; F_TINFO[t * 4 + 3] = p1;
    }
}
__device__ __forceinline__ void p5_router(Frame& F) {
    float* hs = (float*)F.lds + F.wave * 4096;
    const int gw = F.bid * NWAVES + F.wave, NGW = F.G * NWAVES, lane = F.lane;
    for (int tp = gw; tp < T / 2; tp += NGW) {
        float rstd[2];
#pragma unroll
        for (int tt = 0; tt < 2; ++tt) {
            const f32x4* xr = (const f32x4*)(F_out + (size_t)(tp * 2 + tt) * D) + lane; float s = 0.f;
#pragma unroll
            for (int j = 0; j < 8; ++j) { const f32x4 v = xr[64 * j], g = ((const f32x4*)F_g_ffn)[64 * j + lane]; s += (v.x * v.x + v.y * v.y) + (v.z * v.z + v.w * v.w);
                const int k = (64 * j + lane) * 4; hs[(k + 0) * 2 + tt] = v.x * g.x; hs[(k + 1) * 2 + tt] = v.y * g.y; hs[(k + 2) * 2 + tt] = v.z * g.z; hs[(k + 3) * 2 + tt] = v.w * g.w; }
            rstd[tt] = rsqrtf(wave_sum(s) * (1.f / D) + EPS);
        }
        asm volatile("s_waitcnt lgkmcnt(0)" ::: "memory");
        float a0 = 0.f, a1 = 0.f;
        const float* wp = (lane < 32) ? (F_w_re + lane) : (F_w_rg + ((lane - 32) & 3)); const int wst = (lane < 32) ? 32 : 4; const bool act = lane < 36;
#pragma unroll 8
        for (int k = 0; k < D; ++k) { const float w = act ? wp[(size_t)k * wst] : 0.f; const float h0 = hs[k * 2], h1 = hs[k * 2 + 1]; a0 += h0 * w; a1 += h1 * w; }
        const float bias = (lane < 32) ? F_b_re[lane] : (lane < 36 ? F_b_rg[lane - 32] : 0.f);
        route_token(F, tp * 2, a0 * rstd[0] + bias, rstd[0]);
        route_token(F, tp * 2 + 1, a1 * rstd[1] + bias, rstd[1]);
        asm volatile("s_waitcnt lgkmcnt(0)" ::: "memory");
    }
}

__device__ __forceinline__ void compute_pstart(Frame& F, int* ps) {
    __syncthreads();
    if (F.tid < NE) ps[40 + F.tid] = (int)__hip_atomic_load(F_ctl + CW_CNT + CNT_STRIDE * F.tid, __ATOMIC_RELAXED, __HIP_MEMORY_SCOPE_AGENT);
    __syncthreads();
    if (F.tid == 0) { int acc = 0; for (int e = 0; e < NE; ++e) { ps[e] = acc; const int c = ps[40 + e]; acc += ((c + 255) >> 8) << 8; } ps[NE] = acc; }
    __syncthreads();
}

__device__ __forceinline__ void p6_gateup(Frame& F) {
    int* ps = (int*)(F.lds + 65536); compute_pstart(F, ps);
    const bf16* H2 = F_H2; bf16* HDN = F_HDN; int base = 0;
    for (int e = 0; e < NE; ++e) {
        const int cnt = (int)__hip_atomic_load(F_ctl + CW_CNT + CNT_STRIDE * e, __ATOMIC_RELAXED, __HIP_MEMORY_SCOPE_AGENT); const int ntile = ((cnt + 127) / 128) * (DE / 64);
        const int first = ((F.bid - base) % F.G + F.G) % F.G;
        const int* ltok = F_LTOK + e * T; const float* lr = F_LRSTD + e * T; const float *Wg = F_w_gate + (size_t)e * D * DE, *Wu = F_w_up + (size_t)e * D * DE; const int p0 = ps[e];
        ngemm<true>(F.lds, F.tid, cnt, DE, D, first, F.G,
            [=](int r, int k) { return bf2f(H2[(size_t)ltok[r] * D + k]); },
            [=](int k, int n) { return Wg[(size_t)k * DE + n]; },
            [=](int k, int n) { return Wu[(size_t)k * DE + n]; },
            [=](int r, int n, float g, float u) { const float rs = lr[r]; const float gg = g * rs; HDN[(size_t)(p0 + r) * DE + n] = (bf16)f2bf(gg * sigmoidf_(gg) * (u * rs)); });
        base += ntile;
    }
}
__device__ __forceinline__ void p7_down(Frame& F) {
    int* ps = (int*)(F.lds + 65536); compute_pstart(F, ps);
    const bf16* HDN = F_HDN; bf16* Y = F_Y; int base = 0;
    for (int e = 0; e < NE; ++e) {
        const int cnt = (int)__hip_atomic_load(F_ctl + CW_CNT + CNT_STRIDE * e, __ATOMIC_RELAXED, __HIP_MEMORY_SCOPE_AGENT); const int ntile = ((cnt + 127) / 128) * (D / 64);
        const int first = ((F.bid - base) % F.G + F.G) % F.G;
        const float* lw = F_LW + e * T; const float* Wd = F_w_down + (size_t)e * DE * D; const int p0 = ps[e];
        ngemm<false>(F.lds, F.tid, cnt, D, DE, first, F.G,
            [=](int r, int k) { return bf2f(HDN[(size_t)(p0 + r) * DE + k]); },
            [=](int k, int n) { return Wd[(size_t)k * D + n]; },
            [=](int k, int n) { return 0.f; },
            [=](int r, int n, float a, float) { Y[(size_t)(p0 + r) * D + n] = (bf16)f2bf(a * lw[r]); });
        base += ntile;
    }
}
__device__ __forceinline__ void p8_row_loads(Frame& F, const int* ps, int t, int lane, f32x4 (&xv)[8], u32x2 (&ya)[8], u32x2 (&yb)[8]) {
    const int e0 = F_TINFO[t * 4], e1 = F_TINFO[t * 4 + 1], q0 = F_TINFO[t * 4 + 2], q1 = F_TINFO[t * 4 + 3];
    const f32x4* xr = (const f32x4*)(F_out + (size_t)t * D) + lane;
    if (Y_FP8) {
        const unsigned* y0 = (const unsigned*)((const unsigned char*)F_Y + (size_t)(ps[e0] + q0) * D) + lane; const unsigned* y1 = (const unsigned*)((const unsigned char*)F_Y + (size_t)(ps[e1] + q1) * D) + lane;
#pragma unroll
        for (int j = 0; j < 8; ++j) { xv[j] = xr[64 * j]; ya[j].x = y0[64 * j]; yb[j].x = y1[64 * j]; }
        return; }
    const u32x2* y0 = (const u32x2*)(F_Y + (size_t)(ps[e0] + q0) * D) + lane; const u32x2* y1 = (const u32x2*)(F_Y + (size_t)(ps[e1] + q1) * D) + lane;
#pragma unroll
    for (int j = 0; j < 8; ++j) { xv[j] = xr[64 * j]; ya[j] = y0[64 * j]; yb[j] = y1[64 * j]; }
}
__device__ __forceinline__ void p8_final(Frame& F, bool have_tab) {
    int* ps = (int*)(F.lds + 65536); if (have_tab) ps = (int*)(F.lds + 131072 + 2048); else compute_pstart(F, ps);
    const int gw = F.bid * NWAVES + F.wave, NGW = F.G * NWAVES, lane = F.lane;
    f32x4 g[8];
#pragma unroll
    for (int j = 0; j < 8; ++j) g[j] = ((const f32x4*)F_g_final)[64 * j + lane];
    f32x4 v[8]; u32x2 ya[8], yb[8];
    if (gw < T) p8_row_loads(F, ps, gw, lane, v, ya, yb);
    for (int t = gw; t < T; t += NGW) {
        const int tn = t + NGW; const bool more = tn < T;
        f32x4 nv[8]; u32x2 nya[8], nyb[8];
        if (more) p8_row_loads(F, ps, tn, lane, nv, nya, nyb);
        __builtin_amdgcn_sched_barrier(0);
        f32x4* xr = (f32x4*)(F_out + (size_t)t * D) + lane; float s = 0.f;
#pragma unroll
        for (int j = 0; j < 8; ++j) { const u32x2 a = ya[j], b = yb[j];
            if (Y_FP8) {
                v[j].x += (__builtin_amdgcn_cvt_f32_fp8(a.x, 0) + __builtin_amdgcn_cvt_f32_fp8(b.x, 0)) * 0.0625f; v[j].y += (__builtin_amdgcn_cvt_f32_fp8(a.x, 1) + __builtin_amdgcn_cvt_f32_fp8(b.x, 1)) * 0.0625f;
                v[j].z += (__builtin_amdgcn_cvt_f32_fp8(a.x, 2) + __builtin_amdgcn_cvt_f32_fp8(b.x, 2)) * 0.0625f; v[j].w += (__builtin_amdgcn_cvt_f32_fp8(a.x, 3) + __builtin_amdgcn_cvt_f32_fp8(b.x, 3)) * 0.0625f;
            } else {
            v[j].x += __uint_as_float(a.x << 16) + __uint_as_float(b.x << 16); v[j].y += __uint_as_float(a.x & 0xffff0000u) + __uint_as_float(b.x & 0xffff0000u);
            v[j].z += __uint_as_float(a.y << 16) + __uint_as_float(b.y << 16); v[j].w += __uint_as_float(a.y & 0xffff0000u) + __uint_as_float(b.y & 0xffff0000u); }
            s += (v[j].x * v[j].x + v[j].y * v[j].y) + (v[j].z * v[j].z + v[j].w * v[j].w); }
        const float rstd = rsqrtf(wave_sum(s) * (1.f / D) + EPS);
#pragma unroll
        for (int j = 0; j < 8; ++j) xr[64 * j] = (f32x4){v[j].x * rstd * g[j].x, v[j].y * rstd * g[j].y, v[j].z * rstd * g[j].z, v[j].w * rstd * g[j].w};
        if (more) {
#pragma unroll
            for (int j = 0; j < 8; ++j) { v[j] = nv[j]; ya[j] = nya[j]; yb[j] = nyb[j]; } }
    }
}


namespace pg8 {
typedef short bf16x8 __attribute__((ext_vector_type(8)));
typedef int v4i32 __attribute__((ext_vector_type(4)));
typedef int v8i32 __attribute__((ext_vector_type(8)));
constexpr int BM = 256, BK = 64, HALF = 128, HTB = HALF * BK * 2, STAGE_BYTES = 8 * HTB, NXCD = 8, WGM = 8;
constexpr int GTAB_OFF = STAGE_BYTES;
constexpr int RTAB_OFF = 131072 + 8192;
__host__ __device__ __forceinline__ int lds_byte(int r, int c) { const int st = (r >> 4) * 2 + (c >> 5), rr = r & 15, cc = c & 31, ob = rr * 64 + cc * 2; return st * 1024 + (ob ^ (((ob >> 9) & 1) << 5)); }
__host__ __device__ __forceinline__ void stage_rc(int b, int& R, int& C) { const int st = b / 1024, sb = b % 1024, swz = sb ^ (((sb >> 9) & 1) << 5); R = (st >> 1) * 16 + swz / 64; C = (st & 1) * 32 + (swz % 64) / 2; }
__host__ __device__ __forceinline__ int perm32(int rho) { const int n = rho >> 4, i = rho & 15; return 8 * (i >> 2) + 4 * n + (i & 3); }

struct Unit { const char* A; const char* B; int pm, pn, e, aux, ti; };

struct TileOrder {
    int nM, nN, nwg, G, c, wgm;
    __device__ void init(int M, int N, int G_, int c_, int wgm_ = WGM) { nM = M / BM; nN = N / BM; nwg = nM * nN; G = G_; c = c_; wgm = wgm_; }
    __device__ bool tile(int i, int& pm, int& pn) const {
        const long L = (long)i * G + c; if (L >= nwg) return false;
        int wgid = (int)L; { const int q = nwg / NXCD, r = nwg % NXCD, xcd = wgid % NXCD, off = wgid / NXCD; wgid = (xcd < r ? xcd * (q + 1) : r * (q + 1) + (xcd - r) * q) + off; }
        const int nig = wgm * nN, gid = wgid / nig, fm = gid * wgm, gsz = (nM - fm) < wgm ? (nM - fm) : wgm;
        pm = fm + ((wgid % nig) % gsz); pn = (wgid % nig) / gsz; return true;
    }
};
__device__ __forceinline__ unsigned cvt_pk_bf16(float lo, float hi) { unsigned r; asm volatile("v_cvt_pk_bf16_f32 %0, %1, %2" : "=v"(r) : "v"(lo), "v"(hi)); return r; }

template <class Epi, class Sched, bool GATHER, bool ALIGN_EPI, bool SP2, bool DYN = false, bool F8 = false, int F8_ROW_SCALE = 0x7d>
__device__ __forceinline__ void gemm_phase(LAS unsigned char* lds, const int K, const Sched& S, const Epi& E) {
    static_assert(!(DYN && GATHER), "dynamic order + gather not combined");
    static_assert(SP2, "only the SP2 loop is kept here");
    const int tid = threadIdx.x, wid = __builtin_amdgcn_readfirstlane(tid >> 6), lane = tid & 63, wr = wid >> 2, wc = wid & 3, fr = lane & 15, fq = lane >> 4;
    const int nt = K / BK;
    unsigned voffA[2], voffB[2]; int gR[2], gC[2];
#pragma unroll
    for (int i = 0; i < 2; ++i) { int R, C; stage_rc(tid * 16 + i * 8192, R, C); const int Rb = Epi::PERM ? ((R & ~31) + perm32(R & 31)) : R;
        voffA[i] = (unsigned)(R * K + C) * 2u; voffB[i] = (unsigned)(Rb * K + C) * 2u; gR[i] = R * 4; gC[i] = C * 2; }
    const size_t kstep = (size_t)(BK * 2);
    const size_t hstep = (size_t)HALF * K * 2;
    const unsigned ldsw = (unsigned)wid * 1024u;
    const int aofk0 = lds_byte(wr * 64 + fr, F8 ? fq * 16 : fq * 8), aofk1 = lds_byte(wr * 64 + fr, F8 ? fq * 16 + 8 : fq * 8 + 32);
    const int bofk0 = lds_byte(wc * 32 + fr, F8 ? fq * 16 : fq * 8), bofk1 = lds_byte(wc * 32 + fr, F8 ? fq * 16 + 8 : fq * 8 + 32);
#define PG8_SA(b, h) (((b) * 2 + (h)) * HTB)
#define PG8_SB(b, h) ((4 + (b) * 2 + (h)) * HTB)
#define PG8_STAGE(bufoff, gbase, voff) do { _Pragma("unroll") for (int _i = 0; _i < 2; ++_i) \
        __builtin_amdgcn_global_load_lds((const unsigned*)((const char*)(gbase) + (voff)[_i]), (LAS unsigned*)(lds + (bufoff) + ldsw + _i * 8192), 16, 0, 0); } while (0)
#define PG8_STAGE_A(b, h, gbase, par) do { if constexpr (GATHER) { _Pragma("unroll") for (int _i = 0; _i < 2; ++_i) { \
            const unsigned _o = (unsigned)*(const LAS int*)(lds + GTAB_OFF + (par) * 1024 + (h) * 512 + gR[_i]) * (unsigned)(K * 2) + (unsigned)gC[_i]; \
            __builtin_amdgcn_global_load_lds((const unsigned*)((const char*)(gbase) + _o), (LAS unsigned*)(lds + PG8_SA(b, h) + ldsw + _i * 8192), 16, 0, 0); } } \
        else { PG8_STAGE(PG8_SA(b, h), (gbase) + (h) * hstep, voffA); } } while (0)
#define PG8_LDA(dst, b, h) do { if constexpr (F8) { _Pragma("unroll") for (int m = 0; m < 4; ++m) dst##8[m] = __builtin_shufflevector(*(const LAS v4i32*)(lds + PG8_SA(b, h) + aofk0 + m * 2048), *(const LAS v4i32*)(lds + PG8_SA(b, h) + aofk1 + m * 2048), 0, 1, 2, 3, 4, 5, 6, 7); } \
        else { _Pragma("unroll") for (int m = 0; m < 4; ++m) _Pragma("unroll") for (int k = 0; k < 2; ++k) dst[m][k] = *(const LAS bf16x8*)(lds + PG8_SA(b, h) + (k ? aofk1 : aofk0) + m * 2048); } } while (0)
#define PG8_LDB(dst, b, h) do { if constexpr (F8) { _Pragma("unroll") for (int n = 0; n < 2; ++n) dst##8[n] = __builtin_shufflevector(*(const LAS v4i32*)(lds + PG8_SB(b, h) + bofk0 + n * 2048), *(const LAS v4i32*)(lds + PG8_SB(b, h) + bofk1 + n * 2048), 0, 1, 2, 3, 4, 5, 6, 7); } \
        else { _Pragma("unroll") for (int n = 0; n < 2; ++n) _Pragma("unroll") for (int k = 0; k < 2; ++k) dst[n][k] = *(const LAS bf16x8*)(lds + PG8_SB(b, h) + (k ? bofk1 : bofk0) + n * 2048); } } while (0)
#define PG8_MMA(ai, bj, At, Bt) do { __builtin_amdgcn_s_setprio(1); _Pragma("unroll") for (int m = 0; m < 4; ++m) _Pragma("unroll") for (int n = 0; n < 2; ++n) { \
        if constexpr (F8) { \
            asm volatile("v_mfma_scale_f32_16x16x128_f8f6f4 %0, %1, %2, %0, %3, %4 op_sel_hi:[0,0,0]" : "+v"(acc[ai][bj][m][n]) : "v"(Bt##8[n]), "v"(At##8[m]), "v"(f8sw), "v"(f8sa)); \
        } else { _Pragma("unroll") for (int k = 0; k < 2; ++k) \
            acc[ai][bj][m][n] = __builtin_amdgcn_mfma_f32_16x16x32_bf16(Bt[n][k], At[m][k], acc[ai][bj][m][n], 0, 0, 0); } } \
        __builtin_amdgcn_s_setprio(0); } while (0)
#define PG8_WAIT_V(n) asm volatile("s_waitcnt vmcnt(" #n ")" ::: "memory")
#define PG8_WAIT_L(n) asm volatile("s_waitcnt lgkmcnt(" #n ")" ::: "memory")
#define PG8_BAR __builtin_amdgcn_s_barrier()
#define PG8_SCHED __builtin_amdgcn_sched_barrier(0)
    Unit cur, nxt; int ui = 0;
    if (!S.next(0, cur)) return;
    f32x4 acc[2][2][4][2];
#pragma unroll
    for (int a = 0; a < 2; ++a)
#pragma unroll
        for (int b = 0; b < 2; ++b)
#pragma unroll
            for (int m = 0; m < 4; ++m)
#pragma unroll
                for (int n = 0; n < 2; ++n) acc[a][b][m][n] = (f32x4){0.f, 0.f, 0.f, 0.f};
    bf16x8 At[4][2], B0[2][2], B1[2][2];
    const int f8sw = 0x7b7b7b7b, f8sa = F8_ROW_SCALE * 0x01010101;
    v8i32 At8[4], B08[2], B18[2];
    const char* cA = cur.A; const char* cB = cur.B;
    if constexpr (GATHER) { S.fill(cur, lds + GTAB_OFF, wid, lane); asm volatile("s_waitcnt vmcnt(0) lgkmcnt(0)" ::: "memory"); __syncthreads(); }
    int par = 0;
    PG8_STAGE(PG8_SB(0, 0), cB, voffB); PG8_STAGE(PG8_SB(0, 1), cB + hstep, voffB); PG8_STAGE_A(0, 0, cA, par); PG8_STAGE_A(0, 1, cA, par);
    if (wr == 1) PG8_BAR;
    PG8_WAIT_V(2); PG8_BAR;
    PG8_STAGE(PG8_SB(1, 0), cB + kstep, voffB); PG8_STAGE_A(1, 0, cA + kstep, par); PG8_STAGE(PG8_SB(1, 1), cB + hstep + kstep, voffB);
    PG8_WAIT_V(6); PG8_BAR;
    int rpar = 0;
    for (;;) {
        bool has_next = false; const char* nA = cA; const char* nB = cB;
        if constexpr (Epi::RTAB) E.rowtab(cur, lds + RTAB_OFF + rpar * 1024, wid, lane);
        if constexpr (DYN) { S.prefetch(ui + 1); }
        else { has_next = S.next(ui + 1, nxt); nA = has_next ? nxt.A : cA; nB = has_next ? nxt.B : cB; }
        if constexpr (GATHER) { if (has_next) S.fill(nxt, lds + GTAB_OFF + (par ^ 1) * 1024, wid, lane); }
        const int npar = (GATHER && has_next) ? (par ^ 1) : par;
        for (int t = 0; t < nt; t += 2) {
            const bool last = (t == nt - 2);
            if constexpr (DYN) { if (last) { has_next = S.next(ui + 1, nxt); nA = has_next ? nxt.A : cA; nB = has_next ? nxt.B : cB; } }
            const char* a1 = cA + (size_t)(t + 1) * kstep;
            const char* a2 = last ? nA : cA + (size_t)(t + 2) * kstep; const char* b2 = last ? nB : cB + (size_t)(t + 2) * kstep;
            const char* a3 = a2 + kstep; const char* b3 = b2 + kstep;
            const int p2 = last ? npar : par;
            PG8_LDB(B0, 0, 0); PG8_LDB(B1, 0, 1); PG8_SCHED; PG8_LDA(At, 0, 0); PG8_STAGE_A(1, 1, a1, par);
            PG8_WAIT_V(8); PG8_WAIT_L(0); PG8_BAR; PG8_MMA(0, 0, At, B0); PG8_MMA(0, 1, At, B1); PG8_BAR; PG8_SCHED;
            PG8_LDA(At, 0, 1); PG8_STAGE(PG8_SB(0, 0), b2, voffB); PG8_STAGE(PG8_SB(0, 1), b2 + hstep, voffB); PG8_STAGE_A(0, 0, a2, p2);
            PG8_WAIT_V(8); PG8_WAIT_L(0); PG8_BAR; PG8_MMA(1, 0, At, B0); PG8_MMA(1, 1, At, B1); PG8_BAR; PG8_SCHED;
            PG8_LDB(B0, 1, 0); PG8_LDB(B1, 1, 1); PG8_SCHED; PG8_LDA(At, 1, 0); PG8_STAGE_A(0, 1, a2, p2);
            PG8_WAIT_V(8); PG8_WAIT_L(0); PG8_BAR; PG8_MMA(0, 0, At, B0); PG8_MMA(0, 1, At, B1); PG8_BAR; PG8_SCHED;
            PG8_LDA(At, 1, 1); PG8_STAGE(PG8_SB(1, 0), b3, voffB); PG8_STAGE(PG8_SB(1, 1), b3 + hstep, voffB); PG8_STAGE_A(1, 0, a3, p2);
            PG8_WAIT_V(8); PG8_WAIT_L(0); PG8_BAR; PG8_MMA(1, 0, At, B0); PG8_MMA(1, 1, At, B1); PG8_BAR; PG8_SCHED;
        }
        if constexpr (F8) asm volatile("s_nop 7\n\ts_nop 7\n\ts_nop 3" ::: "memory");
        if constexpr (ALIGN_EPI) { if (wr == 0) PG8_BAR; }
        if constexpr (Epi::RTAB) E(acc, cur, wr, wc, fr, fq, (const LAS float*)(lds + RTAB_OFF + rpar * 1024)); else E(acc, cur, wr, wc, fr, fq);
        S.done(cur);
        if (!has_next) break;
        if (!E.keep(cur)) {
#pragma unroll
            for (int a = 0; a < 2; ++a)
#pragma unroll
                for (int b = 0; b < 2; ++b)
#pragma unroll
                    for (int m = 0; m < 4; ++m)
#pragma unroll
                        for (int n = 0; n < 2; ++n) acc[a][b][m][n] = (f32x4){0.f, 0.f, 0.f, 0.f};
        }
        cur = nxt; cA = nA; cB = nB; ++ui; par = npar; rpar ^= 1;
        if constexpr (ALIGN_EPI) { if (wr == 1) PG8_BAR; }
    }
    PG8_WAIT_V(0);
    if constexpr (!ALIGN_EPI) { if (wr == 0) PG8_BAR; }
    PG8_BAR;
#undef PG8_SA
#undef PG8_SB
#undef PG8_STAGE
#undef PG8_STAGE_A
#undef PG8_LDA
#undef PG8_LDB
#undef PG8_MMA
#undef PG8_WAIT_V
#undef PG8_WAIT_L
#undef PG8_BAR
#undef PG8_SCHED
}
}

__device__ __forceinline__ void tr64_load(const float* W, int N, int k0, int n0, int lane, f32x4 (&v)[16]) {
    const int rr = lane >> 4, q = lane & 15;
#pragma unroll
    for (int i = 0; i < 16; ++i) v[i] = *(const f32x4*)(W + (size_t)(k0 + 4 * i + rr) * N + n0 + 4 * q);
}
__device__ __forceinline__ void tr64_finish(const f32x4 (&v)[16], int K, bf16* WT, int k0, int drow0, float* scr, int lane) {
    const int rr = lane >> 4, q = lane & 15;
#pragma unroll
    for (int i = 0; i < 16; ++i) { float* d = scr + (4 * i + rr) * 65 + 4 * q; d[0] = v[i].x; d[1] = v[i].y; d[2] = v[i].z; d[3] = v[i].w; }
    asm volatile("s_waitcnt lgkmcnt(0)" ::: "memory");
    const int nn = lane >> 3, c = lane & 7;
#pragma unroll
    for (int j = 0; j < 8; ++j) { const int n = nn + 8 * j; const float* s = scr + (8 * c) * 65 + n;
        u32x4 o; o.x = pk2(s[0 * 65], s[1 * 65]); o.y = pk2(s[2 * 65], s[3 * 65]); o.z = pk2(s[4 * 65], s[5 * 65]); o.w = pk2(s[6 * 65], s[7 * 65]);
        *(u32x4*)(WT + (size_t)(drow0 + n) * K + k0 + 8 * c) = o; }
    asm volatile("s_waitcnt lgkmcnt(0)" ::: "memory");
}
__device__ __forceinline__ unsigned pk4_fp8(float a, float b, float c, float d) { unsigned w = 0; w = __builtin_amdgcn_cvt_pk_fp8_f32(a, b, w, false); w = __builtin_amdgcn_cvt_pk_fp8_f32(c, d, w, true); return w; }
__device__ __forceinline__ unsigned pk4_fp8_sat(float a, float b, float c, float d) { return pk4_fp8(__builtin_amdgcn_fmed3f(a, -448.f, 448.f), __builtin_amdgcn_fmed3f(b, -448.f, 448.f), __builtin_amdgcn_fmed3f(c, -448.f, 448.f), __builtin_amdgcn_fmed3f(d, -448.f, 448.f)); }
__device__ __forceinline__ void tr_fp8_item(const float* W, int N, unsigned char* WT8, int Kb, int k0, int n0, int drow0, float* scr, int lane, float scale) {
    const int rr = lane >> 3, q = lane & 7;
    f32x4 v[16];
#pragma unroll
    for (int i = 0; i < 16; ++i) v[i] = __builtin_nontemporal_load((const f32x4*)(W + (size_t)(k0 + 8 * i + rr) * N + n0 + 4 * q));
#pragma unroll
    for (int i = 0; i < 16; ++i) { const int row = 8 * i + rr; float* d = scr + row * 33 + (i >= 8 ? 32 : 0) + 4 * q; d[0] = v[i].x * scale; d[1] = v[i].y * scale; d[2] = v[i].z * scale; d[3] = v[i].w * scale; }
    asm volatile("s_waitcnt lgkmcnt(0)" ::: "memory");
    const int n = lane >> 1, h = lane & 1;
    const float* sp = scr + (64 * h) * 33 + (h ? 32 : 0) + n;
#pragma unroll
    for (int j = 0; j < 4; ++j) { u32x4 o;
#pragma unroll
        for (int e = 0; e < 4; ++e) { const int k = 16 * j + 4 * e; o[e] = pk4_fp8_sat(sp[k * 33], sp[(k + 1) * 33], sp[(k + 2) * 33], sp[(k + 3) * 33]); }
        __builtin_nontemporal_store(o, (u32x4*)(WT8 + (size_t)(drow0 + n) * Kb + k0 + 64 * h + 16 * j)); }
    asm volatile("s_waitcnt lgkmcnt(0)" ::: "memory");
}
template <bool NT>
__device__ __forceinline__ void tr64_item(const float* W, int K, int N, bf16* WT, int k0, int n0, int drow0, float* scr, int lane) {
    const int rr = lane >> 4, q = lane & 15;
    f32x4 v[16];
#pragma unroll
    for (int i = 0; i < 16; ++i) { const f32x4* p = (const f32x4*)(W + (size_t)(k0 + 4 * i + rr) * N + n0 + 4 * q); v[i] = NT ? __builtin_nontemporal_load(p) : *p; }
#pragma unroll
    for (int i = 0; i < 16; ++i) { float* d = scr + (4 * i + rr) * 65 + 4 * q; d[0] = v[i].x; d[1] = v[i].y; d[2] = v[i].z; d[3] = v[i].w; }
    asm volatile("s_waitcnt lgkmcnt(0)" ::: "memory");
    const int nn = lane >> 3, c = lane & 7;
#pragma unroll
    for (int j = 0; j < 8; ++j) { const int n = nn + 8 * j; const float* s = scr + (8 * c) * 65 + n;
        u32x4 o; o.x = pk2(s[0 * 65], s[1 * 65]); o.y = pk2(s[2 * 65], s[3 * 65]); o.z = pk2(s[4 * 65], s[5 * 65]); o.w = pk2(s[6 * 65], s[7 * 65]);
        u32x4* dp = (u32x4*)(WT + (size_t)(drow0 + n) * K + k0 + 8 * c);
        if (NT) __builtin_nontemporal_store(o, dp); else *dp = o; }
    asm volatile("s_waitcnt lgkmcnt(0)" ::: "memory");
}
constexpr int TI_IN = (D / 64) * (PW / 64), TI_A = (AW / 64) * (D / 64), TI_OUT = (D / 64) * (D / 64), TI_G = (D / 64) * (DE / 64), TI_D = (DE / 64) * (D / 64);
constexpr int TI_E = 2 * TI_G + TI_D, TI_DENSE = TI_IN + 2 * TI_A + TI_OUT, TI_MOE = NE * TI_E;
__device__ __forceinline__ void conv_dense(Frame& F, int cw, int ncw, bool first) {
    float* scr = (float*)(F.lds + F.wave * 17024); const int lane = F.lane;
    if (first) { constexpr int nb = PW / 64, nbp = GATES_FP8 ? OFF_GA / 64 : PW / 64, TI_P0 = (D / 64) * nbp;
        if (GATES_FP8) for (int r = cw; r < (D / 128) * ((PW - OFF_GA) / 32); r += ncw)
            tr_fp8_item(F_w_in + OFF_GA, PW, (unsigned char*)(WSP(bf16, WS_WIN_T) + (size_t)OFF_GA * D), D, 128 * (r >> 7), 32 * (r & 127), 32 * (r & 127), scr, lane, 16.f);
        for (int rq = cw; rq < TI_P0; rq += 2 * ncw) { const int rq2 = rq + ncw; const bool two = rq2 < TI_P0; const int r = (rq / nbp) * nb + rq % nbp, r2 = (rq2 / nbp) * nb + rq2 % nbp;
            f32x4 va[16], vb[16];
            tr64_load(F_w_in, PW, 64 * (r / nb), 64 * (r % nb), lane, va);
            if (two) tr64_load(F_w_in, PW, 64 * (r2 / nb), 64 * (r2 % nb), lane, vb);
            tr64_finish(va, D, WSP(bf16, WS_WIN_T), 64 * (r / nb), 64 * (r % nb), scr, lane);
            if (two) tr64_finish(vb, D, WSP(bf16, WS_WIN_T), 64 * (r2 / nb), 64 * (r2 % nb), scr, lane); }
        return; }
    for (int it = cw; it < 2 * TI_A + TI_OUT; it += ncw) {
        int r = it;
        if (r < TI_A) { const int nb = D / 64; tr64_item<false>(F_w_a, AW, D, WSP(bf16, WS_WA_T), 64 * (r / nb), 64 * (r % nb), 64 * (r % nb), scr, lane); continue; } r -= TI_A;
        if (r < TI_A) { const int nb = D / 64; tr64_item<false>(F_w_b, AW, D, WSP(bf16, WS_WB_T), 64 * (r / nb), 64 * (r % nb), 64 * (r % nb), scr, lane); continue; } r -= TI_A;
        { const int nb = D / 64; tr64_item<false>(F_w_out, D, D, WSP(bf16, WS_WOUT_T), 64 * (r / nb), 64 * (r % nb), 64 * (r % nb), scr, lane); }
    }
}
__device__ __forceinline__ void conv_moe(Frame& F, int cw, int ncw) {
    float* scr = (float*)(F.lds + F.wave * 17024); const int lane = F.lane;
    for (int it = cw; it < TI_MOE; it += ncw) {
        const int e = it / TI_E; int r = it - e * TI_E;
        if (MOE_GU_FP8 && r < 2 * TI_G) { const int up = r >= TI_G; if (up) r -= TI_G; const int n0 = 32 * (r & 31), k0 = 128 * (r >> 5);
            tr_fp8_item((up ? F_w_up : F_w_gate) + (size_t)e * D * DE, DE, (unsigned char*)WSP(bf16, WS_WGU_T) + (size_t)e * 2048 * D, D, k0, n0, (n0 >> 7) * 256 + up * 128 + (n0 & 127), scr, lane, 16.f); continue; }
        if (r < 2 * TI_G) { const int up = r >= TI_G; if (up) r -= TI_G; const int nb = DE / 64, n0 = 64 * (r % nb);
            const int drow0 = (n0 >> 7) * 256 + up * 128 + (n0 & 127);
            tr64_item<true>((up ? F_w_up : F_w_gate) + (size_t)e * D * DE, D, DE, WSP(bf16, WS_WGU_T) + (size_t)e * 2048 * D, 64 * (r / nb), n0, drow0, scr, lane); continue; }
        r -= 2 * TI_G;
        if (MOE_DN_FP8) { tr_fp8_item(F_w_down + (size_t)e * DE * D, D, (unsigned char*)WSP(bf16, WS_WD_T) + (size_t)e * D * DE, DE, 128 * (r >> 6), 32 * (r & 63), 32 * (r & 63), scr, lane, 16.f); continue; }
        { const int nb = D / 64; tr64_item<true>(F_w_down + (size_t)e * DE * D, DE, D, WSP(bf16, WS_WD_T) + (size_t)e * D * DE, 64 * (r / nb), 64 * (r % nb), 64 * (r % nb), scr, lane); }
    }
}

__device__ __forceinline__ void p0_router_weights(Frame& F) {
    const int gt = F.bid * NTHR + F.tid, NT = F.G * NTHR;
    bf16* wf = WSP(bf16, WS_WRH);
    for (int i = gt; i < 4 * 8 * 4 * 2 * 64 * 8; i += NT) {
        const int j = i & 7, lane = (i >> 3) & 63, nt = (i >> 9) & 1, sst = (i >> 10) & 3, w = (i >> 12) & 7, kc = i >> 15;
        const int col = 32 * nt + (lane & 31), k = 512 * kc + 64 * w + 16 * sst + 8 * (lane >> 5) + j;
        float v = 0.f; if (col < 32) v = F_w_re[(size_t)k * 32 + col] * F_g_ffn[k]; else if (col < 36) v = F_w_rg[(size_t)k * 4 + (col - 32)] * F_g_ffn[k];
        const unsigned h = f2bf(v); const float hf = __uint_as_float(h << 16);
        const size_t base = ((((size_t)(kc * 8 + w) * 4 + sst) * 2 + nt) * 2) * 512;
        wf[base + lane * 8 + j] = (bf16)h; wf[base + 512 + lane * 8 + j] = (bf16)f2bf(v - hf); }
}
__device__ __forceinline__ void p0_weights(Frame& F) {
    const int gw = F.bid * NWAVES + F.wave, NGW = F.G * NWAVES;
    conv_dense(F, gw, NGW, true);
    if (!OVERLAP_CONV) { conv_dense(F, gw, NGW, false); conv_moe(F, gw, NGW); }
}

constexpr int CW_PANEL = 12288, CW_GQ = 14400, CW_UDONE = 14464, NPROJ_UNITS = (T / 256) * (PW / 256);
static_assert((CW_UDONE + 64) * 4 <= (int)CTL_ZERO_BYTES, "hand-off words inside the zeroed control region");
constexpr int GQ_LDS_OFF = 131072 + 4096 + 64;
__device__ __forceinline__ void p2_gating_mfma(Frame& F, const bool early);
__device__ __forceinline__ __amdgpu_buffer_rsrc_t wt_rsrc(void* p) { return __builtin_amdgcn_make_buffer_rsrc(p, 0, 0x7fffffff, 0x00020000); }
__device__ __forceinline__ void wt_store16(__amdgpu_buffer_rsrc_t r, unsigned byte_off, u32x4 v) { __builtin_amdgcn_raw_buffer_store_b128(v, r, byte_off, 0, 16); }
struct EpiProj {
    static constexpr bool PERM = true; static constexpr bool RTAB = false;
    bf16* P; float* STAT;
    __device__ __forceinline__ bool keep(const pg8::Unit&) const { return false; }
    __device__ __forceinline__ void operator()(f32x4 (&acc)[2][2][4][2], const pg8::Unit& u, int wr, int wc, int fr, int fq) const {
        const int act = (u.pn < 8) ? ((GELU_U_LATE && u.pn < 4) ? 0 : 1) : ((u.pn < 20 || RAW_GATES) ? 0 : 2);
        const bool gv = (u.pn >= 4 && u.pn < 8);
        const int row0 = u.pm * 256 + wr * 64 + fr, col0 = u.pn * 256 + wc * 32 + 8 * fq;
#pragma unroll
        for (int ai = 0; ai < 2; ++ai)
#pragma unroll
            for (int m = 0; m < 4; ++m) { bf16* rowp = P + (size_t)(row0 + ai * 128 + m * 16) * PW + col0; float ssm = 0.f, ss2 = 0.f;
#pragma unroll
                for (int bj = 0; bj < 2; ++bj) { f32x4 v0 = acc[ai][bj][m][0], v1 = acc[ai][bj][m][1];
                    if (act == 1) {
#pragma unroll
                        for (int j = 0; j < 4; ++j) { v0[j] = gelu_tanh(v0[j]); v1[j] = gelu_tanh(v1[j]); } }
                    else if (act == 2) {
#pragma unroll
                        for (int j = 0; j < 4; ++j) { v0[j] = sigmoidf_(v0[j]); v1[j] = sigmoidf_(v1[j]); } }
                    u32x4 w; w.x = pg8::cvt_pk_bf16(v0[0], v0[1]); w.y = pg8::cvt_pk_bf16(v0[2], v0[3]); w.z = pg8::cvt_pk_bf16(v1[0], v1[1]); w.w = pg8::cvt_pk_bf16(v1[2], v1[3]);
                    if (gv) {
#pragma unroll
                        for (int j = 0; j < 4; ++j) { const float a = __uint_as_float(w[j] << 16), b = __uint_as_float(w[j] & 0xffff0000u); ssm += a + b; ss2 += a * a + b * b; } }
                    if (WT_STORES || (EARLY_GATING && u.pn < 8)) asm volatile("global_store_dwordx4 %0, %1, off sc1\n\ts_nop 1" :: "v"(rowp + bj * 128), "v"(w) : "memory"); else *(u32x4*)(rowp + bj * 128) = w; }
                if (gv) {
                    float a = ssm, b = ss2; a += __shfl_xor(a, 16); b += __shfl_xor(b, 16); a += __shfl_xor(a, 32); b += __shfl_xor(b, 32);
                    if (fq == 0) { u32x2 st; st.x = __float_as_uint(a); st.y = __float_as_uint(b); float* sp = STAT + ((size_t)(row0 + ai * 128 + m * 16) * 16 + (u.pn - 4) * 4 + wc) * 2;
                        asm volatile("global_store_dwordx2 %0, %1, off sc1\n\ts_nop 1" :: "v"(sp), "v"(st) : "memory"); } }
            }
    }
};
struct SchedProj {
    pg8::TileOrder o; const char* A; const char* B;
    __device__ __forceinline__ void done(const pg8::Unit&) const {}
    __device__ __forceinline__ bool next(int i, pg8::Unit& u) const { int pm, pn; if (!o.tile(i, pm, pn)) return false; u.pm = pm; u.pn = pn; u.e = 0; u.aux = 0; u.ti = 0;
        u.A = A + (size_t)pm * 256 * D * 2; u.B = B + (size_t)pn * 256 * D * 2; return true; }
};
constexpr int CW_Q = 64;
constexpr int DQ_LDS_OFF = 131072 + 4096;
struct SchedProjDyn {
    pg8::TileOrder o; const char* A; const char* B; unsigned* q; volatile LAS int* slot; int x; unsigned* ctl; int pn_off = 0, ebytes = 2;
    __device__ __forceinline__ void done(const pg8::Unit& u) const {
        if (!EARLY_GATING) return;
        if (u.pn < 8) { asm volatile("s_waitcnt vmcnt(0)" ::: "memory"); if ((threadIdx.x & 63) == 0) __hip_atomic_fetch_add(ctl + CW_PANEL + 64 * u.pm, 1u, __ATOMIC_RELAXED, __HIP_MEMORY_SCOPE_AGENT); }
        if (threadIdx.x == 0) __hip_atomic_fetch_add(ctl + CW_UDONE, 1u, __ATOMIC_RELAXED, __HIP_MEMORY_SCOPE_AGENT); }
    __device__ __forceinline__ bool unit_of(int idx, pg8::Unit& u) const { pg8::TileOrder t = o; t.G = 8; t.c = x; int pm, pn; if (!t.tile(idx, pm, pn)) return false; u.pm = pm; u.pn = pn + pn_off; u.e = 0; u.aux = 0; u.ti = 0;
        u.A = A + (size_t)pm * 256 * D * ebytes; u.B = B + (size_t)pn * 256 * D * ebytes; return true; }
    __device__ __forceinline__ void prefetch(int i) const { if (threadIdx.x == 0) slot[i & 1] = (int)__hip_atomic_fetch_add(q, 1u, __ATOMIC_RELAXED, __HIP_MEMORY_SCOPE_AGENT); }
    __device__ __forceinline__ bool next(int i, pg8::Unit& u) const {
        if (i == 0) { prefetch(0); asm volatile("s_waitcnt vmcnt(0) lgkmcnt(0)" ::: "memory"); __syncthreads(); }
        const int idx = __builtin_amdgcn_readfirstlane(slot[i & 1]); return unit_of(idx, u); }
};
__device__ __forceinline__ void p1_proj_mfma(Frame& F) {
    EpiProj E{F_PROJ, WSP(float, WS_STAT)};
    if (OVERLAP_CONV) {
        const int NC = CONV_CUS < F.G ? CONV_CUS : F.G / 2;
        if (F.bid < NC) { if (F.wave < CONV_WAVES) conv_moe(F, F.bid * CONV_WAVES + F.wave, NC * CONV_WAVES); else conv_dense(F, F.bid * (NWAVES - CONV_WAVES) + F.wave - CONV_WAVES, NC * (NWAVES - CONV_WAVES), false); __syncthreads(); }
        SchedProjDyn S; S.o.init(T, GATES_FP8 ? OFF_GA : PW, 8, 0, P1_WGM); S.A = (const char*)F_XN; S.B = (const char*)WSP(bf16, WS_WIN_T); S.x = F.bid & 7; S.q = F_ctl + CW_Q + 64 * S.x;
        S.slot = (volatile LAS int*)((LAS unsigned char*)F.lds + DQ_LDS_OFF); S.ctl = F_ctl;
        pg8::gemm_phase<EpiProj, SchedProjDyn, false, true, true, true>((LAS unsigned char*)F.lds, D, S, E);
        if (GATES_FP8) {
            SchedProjDyn S2; S2.o.init(T, PW - OFF_GA, 8, 0, P1_WGM); S2.A = (const char*)WSP(unsigned char, WS_TMP); S2.B = (const char*)(WSP(bf16, WS_WIN_T) + (size_t)OFF_GA * D); S2.x = F.bid & 7; S2.q = F_ctl + CW_Q + 64 * S2.x + 16;
            S2.slot = S.slot; S2.ctl = F_ctl; S2.pn_off = OFF_GA / 256; S2.ebytes = 1;
            pg8::gemm_phase<EpiProj, SchedProjDyn, false, true, true, true, true, 0x7d>((LAS unsigned char*)F.lds, D / 2, S2, E); }
        if (EARLY_GATING) p2_gating_mfma(F, true);
    } else {
        SchedProj S; S.o.init(T, PW, F.G, F.bid); S.A = (const char*)F_XN; S.B = (const char*)WSP(bf16, WS_WIN_T);
        pg8::gemm_phase<EpiProj, SchedProj, false, true, true>((LAS unsigned char*)F.lds, D, S, E);
    }
}
struct EpiBranch {
    static constexpr bool PERM = true; static constexpr bool RTAB = false;
    const bf16* P; bf16* MG;
    __device__ __forceinline__ bool keep(const pg8::Unit& u) const { return u.aux == 0; }
    __device__ __forceinline__ void operator()(f32x4 (&acc)[2][2][4][2], const pg8::Unit& u, int wr, int wc, int fr, int fq) const {
        const int row0 = u.pm * 256 + wr * 64 + fr, col0 = u.pn * 256 + wc * 32 + 8 * fq;
        if (u.aux == 0) {
            u32x4 gas[3][2], gbs[3][2];
#pragma unroll
            for (int it = 0; it < 3; ++it)
#pragma unroll
                for (int bj = 0; bj < 2; ++bj) { const bf16* gp = P + (size_t)(row0 + (it >> 2) * 128 + (it & 3) * 16) * PW + col0 + bj * 128;
                    gas[it][bj] = *(const u32x4*)(gp + OFF_GA); gbs[it][bj] = *(const u32x4*)(gp + OFF_GB); }
#pragma unroll
            for (int it = 0; it < 8; ++it) { const int ai = it >> 2, m = it & 3;
                u32x4 gaw[2], gbw[2];
#pragma unroll
                for (int bj = 0; bj < 2; ++bj) { gaw[bj] = gas[it % 3][bj]; gbw[bj] = gbs[it % 3][bj]; }
                if (it + 3 < 8) {
#pragma unroll
                    for (int bj = 0; bj < 2; ++bj) { const bf16* gp = P + (size_t)(row0 + ((it + 3) >> 2) * 128 + ((it + 3) & 3) * 16) * PW + col0 + bj * 128;
                        gas[it % 3][bj] = *(const u32x4*)(gp + OFF_GA); gbs[it % 3][bj] = *(const u32x4*)(gp + OFF_GB); } }
#pragma unroll
                for (int bj = 0; bj < 2; ++bj)
#pragma unroll
                    for (int j = 0; j < 4; ++j) { const int n = j >> 1, q = (j & 1) * 2;
                        if (RAW_GATES) {
                            const float a0 = __uint_as_float(gaw[bj][j] << 16), a1 = __uint_as_float(gaw[bj][j] & 0xffff0000u);
                            const float b0 = fmaxf(__uint_as_float(gbw[bj][j] << 16), -80.f), b1 = fmaxf(__uint_as_float(gbw[bj][j] & 0xffff0000u), -80.f);
                            acc[ai][bj][m][n][q] *= (1.0f + __builtin_amdgcn_exp2f(b0 * -1.4426950408889634f)) * __builtin_amdgcn_rcpf(1.0f + __builtin_amdgcn_exp2f(a0 * -1.4426950408889634f));
                            acc[ai][bj][m][n][q + 1] *= (1.0f + __builtin_amdgcn_exp2f(b1 * -1.4426950408889634f)) * __builtin_amdgcn_rcpf(1.0f + __builtin_amdgcn_exp2f(a1 * -1.4426950408889634f));
                        } else {
                            const float gb0 = fmaxf(__uint_as_float(gbw[bj][j] << 16), 1e-30f), gb1 = fmaxf(__uint_as_float(gbw[bj][j] & 0xffff0000u), 1e-30f);
                            const float ga0 = __uint_as_float(gaw[bj][j] << 16), ga1 = __uint_as_float(gaw[bj][j] & 0xffff0000u);
                            acc[ai][bj][m][n][q] *= ga0 * __builtin_amdgcn_rcpf(gb0); acc[ai][bj][m][n][q + 1] *= ga1 * __builtin_amdgcn_rcpf(gb1); } }
            }
        } else {
            const __amdgpu_buffer_rsrc_t rM = wt_rsrc(MG);
            u32x4 gbw[2][4][2];
#pragma unroll
            for (int ai = 0; ai < 2; ++ai)
#pragma unroll
                for (int m = 0; m < 4; ++m)
#pragma unroll
                    for (int bj = 0; bj < 2; ++bj) gbw[ai][m][bj] = *(const u32x4*)(P + (size_t)(row0 + ai * 128 + m * 16) * PW + OFF_GB + col0 + bj * 128);
#pragma unroll
            for (int ai = 0; ai < 2; ++ai)
#pragma unroll
                for (int m = 0; m < 4; ++m)
#pragma unroll
                    for (int bj = 0; bj < 2; ++bj) { const unsigned r = (unsigned)(row0 + ai * 128 + m * 16);
                        float gb[8];
#pragma unroll
                        for (int j = 0; j < 4; ++j) { const float b0 = __uint_as_float(gbw[ai][m][bj][j] << 16), b1 = __uint_as_float(gbw[ai][m][bj][j] & 0xffff0000u);
                            if (RAW_GATES) { gb[2 * j] = __builtin_amdgcn_rcpf(1.0f + __builtin_amdgcn_exp2f(fmaxf(b0, -80.f) * -1.4426950408889634f)); gb[2 * j + 1] = __builtin_amdgcn_rcpf(1.0f + __builtin_amdgcn_exp2f(fmaxf(b1, -80.f) * -1.4426950408889634f)); }
                            else { gb[2 * j] = fmaxf(b0, 1e-30f); gb[2 * j + 1] = fmaxf(b1, 1e-30f); } }
                        const f32x4 v0 = acc[ai][bj][m][0], v1 = acc[ai][bj][m][1];
                        u32x4 w; w.x = pg8::cvt_pk_bf16(v0[0] * gb[0], v0[1] * gb[1]); w.y = pg8::cvt_pk_bf16(v0[2] * gb[2], v0[3] * gb[3]);
                        w.z = pg8::cvt_pk_bf16(v1[0] * gb[4], v1[1] * gb[5]); w.w = pg8::cvt_pk_bf16(v1[2] * gb[6], v1[3] * gb[7]);
                        if (WT_STORES) wt_store16(rM, (r * D + col0 + bj * 128) * 2u, w); else *(u32x4*)(MG + (size_t)r * D + col0 + bj * 128) = w; }
        }
    }
};
struct SchedBranch {
    pg8::TileOrder o; const char *YA, *YB, *WA, *WB;
    __device__ __forceinline__ void done(const pg8::Unit&) const {}
    __device__ __forceinline__ bool next(int i, pg8::Unit& u) const { int pm, pn; if (!o.tile(i >> 1, pm, pn)) return false; u.pm = pm; u.pn = pn; u.e = 0; u.aux = i & 1; u.ti = 0;
        u.A = ((i & 1) ? YB : YA) + (size_t)pm * 256 * AW * 2; u.B = ((i & 1) ? WB : WA) + (size_t)pn * 256 * AW * 2; return true; }
};
__device__ __forceinline__ void p3_branch_mfma(Frame& F) {
    SchedBranch S; S.o.init(T, D, F.G, F.bid); S.YA = (const char*)F_YA; S.YB = (const char*)F_YB; S.WA = (const char*)WSP(bf16, WS_WA_T); S.WB = (const char*)WSP(bf16, WS_WB_T);
    EpiBranch E{F_PROJ, F_MERGED};
    pg8::gemm_phase<EpiBranch, SchedBranch, false, true, true>((LAS unsigned char*)F.lds, AW, S, E);
}
struct EpiOut {
    static constexpr bool PERM = true; static constexpr bool RTAB = false;
    const float* x; const float* gf; float* X1; bf16* H2;
    __device__ __forceinline__ bool keep(const pg8::Unit&) const { return false; }
    __device__ __forceinline__ void operator()(f32x4 (&acc)[2][2][4][2], const pg8::Unit& u, int wr, int wc, int fr, int fq) const {
        const int row0 = u.pm * 256 + wr * 64 + fr, col0 = u.pn * 256 + wc * 32 + 8 * fq;
        f32x4 g[2][2];
#pragma unroll
        for (int bj = 0; bj < 2; ++bj) { g[bj][0] = *(const f32x4*)(gf + col0 + bj * 128); g[bj][1] = *(const f32x4*)(gf + col0 + bj * 128 + 4); }
        f32x4 xs[3][2][2];
#pragma unroll
        for (int it = 0; it < 3; ++it) { const size_t off = (size_t)(row0 + (it >> 2) * 128 + (it & 3) * 16) * D + col0;
#pragma unroll
            for (int bj = 0; bj < 2; ++bj) { xs[it][bj][0] = *(const f32x4*)(x + off + bj * 128); xs[it][bj][1] = *(const f32x4*)(x + off + bj * 128 + 4); } }
#pragma unroll
        for (int it = 0; it < 8; ++it) { const int ai = it >> 2, m = it & 3;
            const size_t off = (size_t)(row0 + ai * 128 + m * 16) * D + col0;
            f32x4 v[2][2];
#pragma unroll
            for (int bj = 0; bj < 2; ++bj) { v[bj][0] = xs[it % 3][bj][0] + acc[ai][bj][m][0]; v[bj][1] = xs[it % 3][bj][1] + acc[ai][bj][m][1]; }
            if (it + 3 < 8) { const size_t offn = (size_t)(row0 + ((it + 3) >> 2) * 128 + ((it + 3) & 3) * 16) * D + col0;
#pragma unroll
                for (int bj = 0; bj < 2; ++bj) { xs[it % 3][bj][0] = *(const f32x4*)(x + offn + bj * 128); xs[it % 3][bj][1] = *(const f32x4*)(x + offn + bj * 128 + 4); } }
#pragma unroll
            for (int bj = 0; bj < 2; ++bj) {
                *(f32x4*)(X1 + off + bj * 128) = v[bj][0]; *(f32x4*)(X1 + off + bj * 128 + 4) = v[bj][1];
                u32x4 w; w.x = pg8::cvt_pk_bf16(v[bj][0][0] * g[bj][0][0], v[bj][0][1] * g[bj][0][1]); w.y = pg8::cvt_pk_bf16(v[bj][0][2] * g[bj][0][2], v[bj][0][3] * g[bj][0][3]);
                w.z = pg8::cvt_pk_bf16(v[bj][1][0] * g[bj][1][0], v[bj][1][1] * g[bj][1][1]); w.w = pg8::cvt_pk_bf16(v[bj][1][2] * g[bj][1][2], v[bj][1][3] * g[bj][1][3]);
                if (MOE_GU_FP8) { u32x2 w8; w8.x = pk4_fp8_sat(v[bj][0][0] * g[bj][0][0] * 4.f, v[bj][0][1] * g[bj][0][1] * 4.f, v[bj][0][2] * g[bj][0][2] * 4.f, v[bj][0][3] * g[bj][0][3] * 4.f);
                    w8.y = pk4_fp8_sat(v[bj][1][0] * g[bj][1][0] * 4.f, v[bj][1][1] * g[bj][1][1] * 4.f, v[bj][1][2] * g[bj][1][2] * 4.f, v[bj][1][3] * g[bj][1][3] * 4.f);
                    *(u32x2*)((unsigned char*)H2 + off + bj * 128) = w8; }
                else *(u32x4*)(H2 + off + bj * 128) = w; }
            asm volatile("" ::: "memory"); }
    }
};
struct SchedOut {
    pg8::TileOrder o; const char* A; const char* B;
    __device__ __forceinline__ void done(const pg8::Unit&) const {}
    __device__ __forceinline__ bool next(int i, pg8::Unit& u) const { int pm, pn; if (!o.tile(i, pm, pn)) return false; u.pm = pm; u.pn = pn; u.e = 0; u.aux = 0; u.ti = 0;
        u.A = A + (size_t)pm * 256 * D * 2; u.B = B + (size_t)pn * 256 * D * 2; return true; }
};
__device__ __forceinline__ void p4_out_mfma(Frame& F) {
    SchedOut S; S.o.init(T, D, F.G, F.bid); S.A = (const char*)F_MERGED; S.B = (const char*)WSP(bf16, WS_WOUT_T);
    EpiOut E{F_x, F_g_ffn, F_out, F_H2};
    pg8::gemm_phase<EpiOut, SchedOut, false, true, true>((LAS unsigned char*)F.lds, D, S, E);
}
constexpr int MOE_TAB_OFF = 131072 + 2048;
__device__ __forceinline__ void moe_table(Frame& F) {
    int* tb = (int*)(F.lds + MOE_TAB_OFF);
    __syncthreads();
    if (F.tid < 64) {
        const int e = F.lane; int c = 0;
        if (e < NE) c = (int)__hip_atomic_load(F_ctl + CW_CNT + CNT_STRIDE * e, __ATOMIC_RELAXED, __HIP_MEMORY_SCOPE_AGENT);
        const int m = (c + 255) >> 8; int incl = m;
#pragma unroll
        for (int d = 1; d < 32; d <<= 1) { const int v = __shfl_up(incl, d); if (e >= d) incl += v; }
        const int excl = incl - m;
        if (e < NE) { tb[e] = excl << 8; tb[320 + e] = c; for (int j = 0; j < m; ++j) { tb[64 + 2 * (excl + j)] = e; tb[65 + 2 * (excl + j)] = j; } }
        if (e == NE - 1) { tb[NE] = incl << 8; tb[33] = incl; }
    }
    __syncthreads();
}
struct SchedMoe {
    const int* tb; int G, vcu, t_lo, t_hi, n_pub, pub_lo = 0, hole_lo = 0, hole_n = 0; unsigned* donew; const char* A; const char* B; const int* LTOK; const unsigned* cnt; int a_row_bytes; size_t b_exp_bytes, b_pn_bytes; int Kg;
    __device__ __forceinline__ bool next(int i, pg8::Unit& u) const {
        const int L = i * G + vcu; if (L >= (t_hi - t_lo) * 8) return false;
        int ti = t_lo + (L >> 3); if (ti >= hole_lo) ti += hole_n;
        u.ti = ti; u.pn = L & 7; u.e = __builtin_amdgcn_readfirstlane(tb[64 + 2 * ti]); u.pm = __builtin_amdgcn_readfirstlane(tb[65 + 2 * ti]); u.aux = __builtin_amdgcn_readfirstlane(tb[u.e]) + u.pm * 256;
        u.A = (a_row_bytes ? A + (size_t)u.aux * a_row_bytes : A); u.B = B + (size_t)u.e * b_exp_bytes + (size_t)u.pn * b_pn_bytes; return true; }
    __device__ __forceinline__ void fill(const pg8::Unit& u, LAS unsigned char* dst, int wid, int lane) const {
        if (wid < 4) __builtin_amdgcn_global_load_lds((const unsigned*)(LTOK + u.e * T + u.pm * 256 + wid * 64 + lane), (LAS unsigned*)(dst + wid * 256), 4, 0, 0); }
    __device__ __forceinline__ void done(const pg8::Unit& u) const {
        if (u.ti >= pub_lo && u.ti < pub_lo + n_pub) { asm volatile("s_waitcnt vmcnt(0)" ::: "memory");
            if ((threadIdx.x & 63) == 0) __hip_atomic_fetch_add(donew + 64 * (u.ti - pub_lo), 1u, __ATOMIC_RELAXED, __HIP_MEMORY_SCOPE_AGENT); } }
};

constexpr int CW_DONE = 8192;
static_assert((CW_DONE + 64 * 32) * 4 <= (int)CTL_ZERO_BYTES, "arrival counters inside the zeroed control region");
__device__ __forceinline__ int moe_early_tiles(int nt, int G) {
    if (!MOE_EARLY_DOWN || G != 256 || nt * 8 <= 2 * G || nt * 8 >= 3 * G) return 0;
    const int idle = 3 * G - nt * 8; int n = idle >> 3; if (n > 32) n = 32; if (n > nt) n = nt; return n;
}
__device__ __forceinline__ int moe_early_first(int nt, int G) { const int fi = nt * 8 - 2 * G; return fi > 0 ? (fi + 7) >> 3 : 0; }
struct EpiGateUp {
    static constexpr bool PERM = true; static constexpr bool RTAB = true;
    const float* LRSTD; bf16* HDN; int n_pub;
    __device__ __forceinline__ bool keep(const pg8::Unit&) const { return false; }
    __device__ __forceinline__ void rowtab(const pg8::Unit& u, LAS unsigned char* dst, int wid, int lane) const {
        if (wid < 4) __builtin_amdgcn_global_load_lds((const unsigned*)(LRSTD + u.e * T + u.pm * 256 + wid * 64 + lane), (LAS unsigned*)(dst + wid * 256), 4, 0, 0); }
    __device__ __forceinline__ void operator()(f32x4 (&acc)[2][2][4][2], const pg8::Unit& u, int wr, int wc, int fr, int fq, const LAS float* rt) const {
        const int col0 = u.pn * 128 + wc * 32 + 8 * fq;
#pragma unroll
        for (int ai = 0; ai < 2; ++ai)
#pragma unroll
            for (int m = 0; m < 4; ++m) { const int rl = ai * 128 + wr * 64 + m * 16 + fr;
                const float rs = rt[rl];
                float h[8];
#pragma unroll
                for (int n = 0; n < 2; ++n)
#pragma unroll
                    for (int j = 0; j < 4; ++j) { const float g = acc[ai][0][m][n][j] * rs, uu = acc[ai][1][m][n][j] * rs; h[n * 4 + j] = g * sigmoidf_(g) * uu; }
                if (MOE_DN_FP8) { u32x2 w8; w8.x = pk4_fp8_sat(h[0] * 8.f, h[1] * 8.f, h[2] * 8.f, h[3] * 8.f); w8.y = pk4_fp8_sat(h[4] * 8.f, h[5] * 8.f, h[6] * 8.f, h[7] * 8.f);
                    unsigned char* dp8 = (unsigned char*)HDN + (size_t)(u.aux + rl) * DE + col0;
                    asm volatile("global_store_dwordx2 %0, %1, off sc1\n\ts_nop 1" :: "v"(dp8), "v"(w8) : "memory"); continue; }
                u32x4 w; w.x = pg8::cvt_pk_bf16(h[0], h[1]); w.y = pg8::cvt_pk_bf16(h[2], h[3]); w.z = pg8::cvt_pk_bf16(h[4], h[5]); w.w = pg8::cvt_pk_bf16(h[6], h[7]);
                bf16* dp = HDN + (size_t)(u.aux + rl) * DE + col0;
                if (WT_STORES || u.ti < n_pub) asm volatile("global_store_dwordx4 %0, %1, off sc1\n\ts_nop 1" :: "v"(dp), "v"(w) : "memory"); else *(u32x4*)dp = w; }
    }
};
__device__ __forceinline__ void p7_early(Frame& F, int n_early);
__device__ __forceinline__ void p6_gateup_mfma(Frame& F) {
    moe_table(F);
    const int* tb = (const int*)(F.lds + MOE_TAB_OFF);
    SchedMoe S; S.tb = tb; S.G = F.G; S.vcu = (F.G % 8 == 0) ? (F.bid % 8) * (F.G / 8) + F.bid / 8 : F.bid;
    S.A = (const char*)F_H2; S.a_row_bytes = 0; S.B = (const char*)WSP(bf16, WS_WGU_T); S.b_exp_bytes = (size_t)2048 * D * (MOE_GU_FP8 ? 1 : 2); S.b_pn_bytes = (size_t)256 * D * (MOE_GU_FP8 ? 1 : 2); S.LTOK = F_LTOK; S.cnt = F_ctl + CW_CNT; S.Kg = D;
    const int nt = tb[33], n_early = moe_early_tiles(nt, F.G);
    S.t_lo = 0; S.t_hi = nt; S.n_pub = n_early; S.pub_lo = moe_early_first(nt, F.G); S.donew = F_ctl + CW_DONE;
    EpiGateUp E{F_LRSTD, F_HDN, n_early};
    if (MOE_GU_FP8) pg8::gemm_phase<EpiGateUp, SchedMoe, true, true, true, false, true>((LAS unsigned char*)F.lds, D / 2, S, E);
    else pg8::gemm_phase<EpiGateUp, SchedMoe, true, true, true>((LAS unsigned char*)F.lds, D, S, E);
    if (n_early > 0) p7_early(F, n_early);
}
struct EpiDown {
    static constexpr bool PERM = true; static constexpr bool RTAB = true;
    const float* LW; bf16* Y;
    __device__ __forceinline__ bool keep(const pg8::Unit&) const { return false; }
    __device__ __forceinline__ void rowtab(const pg8::Unit& u, LAS unsigned char* dst, int wid, int lane) const {
        if (wid < 4) __builtin_amdgcn_global_load_lds((const unsigned*)(LW + u.e * T + u.pm * 256 + wid * 64 + lane), (LAS unsigned*)(dst + wid * 256), 4, 0, 0); }
    __device__ __forceinline__ void operator()(f32x4 (&acc)[2][2][4][2], const pg8::Unit& u, int wr, int wc, int fr, int fq, const LAS float* rt) const {
        const int col0 = u.pn * 256 + wc * 32 + 8 * fq;
#pragma unroll
        for (int ai = 0; ai < 2; ++ai)
#pragma unroll
            for (int m = 0; m < 4; ++m) { const int rl = ai * 128 + wr * 64 + m * 16 + fr;
                const float gw = rt[rl];
#pragma unroll
                for (int bj = 0; bj < 2; ++bj) { const f32x4 v0 = acc[ai][bj][m][0] * gw, v1 = acc[ai][bj][m][1] * gw;
                    u32x4 w; w.x = pg8::cvt_pk_bf16(v0[0], v0[1]); w.y = pg8::cvt_pk_bf16(v0[2], v0[3]); w.z = pg8::cvt_pk_bf16(v1[0], v1[1]); w.w = pg8::cvt_pk_bf16(v1[2], v1[3]);
                    if (Y_FP8) { u32x2 w8; w8.x = pk4_fp8_sat(v0[0] * 16.f, v0[1] * 16.f, v0[2] * 16.f, v0[3] * 16.f); w8.y = pk4_fp8_sat(v1[0] * 16.f, v1[1] * 16.f, v1[2] * 16.f, v1[3] * 16.f);
                        unsigned char* dp8 = (unsigned char*)Y + (size_t)(u.aux + rl) * D + col0 + bj * 128;
                        *(u32x2*)dp8 = w8; continue; }
                    bf16* dp = Y + (size_t)(u.aux + rl) * D + col0 + bj * 128;
                    if (WT_STORES) asm volatile("global_store_dwordx4 %0, %1, off sc1\n\ts_nop 1" :: "v"(dp), "v"(w) : "memory"); else *(u32x4*)dp = w; } }
    }
};
struct SchedMoeOne {
    pg8::Unit u0; bool have;
    __device__ __forceinline__ bool next(int i, pg8::Unit& u) const { if (i != 0 || !have) return false; u = u0; return true; }
    __device__ __forceinline__ void fill(const pg8::Unit&, LAS unsigned char*, int, int) const {}
    __device__ __forceinline__ void done(const pg8::Unit&) const {}
};
__device__ __forceinline__ void p7_early(Frame& F, int n_early) {
    const int* tb = (const int*)(F.lds + MOE_TAB_OFF);
    const int nt = tb[33]; const int vcu = (F.bid % 8) * (F.G / 8) + F.bid / 8; const int first_idle = nt * 8 - 2 * F.G;
    const int j = vcu - first_idle;
    SchedMoeOne S; S.have = (j >= 0 && j < n_early * 8);
    if (S.have) { const int ti = moe_early_first(nt, F.G) + (j >> 3); S.u0.ti = ti; S.u0.pn = j & 7; S.u0.e = tb[64 + 2 * ti]; S.u0.pm = tb[65 + 2 * ti]; S.u0.aux = tb[S.u0.e] + S.u0.pm * 256;
        S.u0.A = (const char*)F_HDN + (size_t)S.u0.aux * DE * (MOE_DN_FP8 ? 1 : 2); S.u0.B = (const char*)WSP(bf16, WS_WD_T) + ((size_t)S.u0.e * D * DE + (size_t)S.u0.pn * 256 * DE) * (MOE_DN_FP8 ? 1 : 2);
        if (F.tid < 64) { unsigned* w = F_ctl + CW_DONE + 64 * (j >> 3); unsigned sp = 0;
            while ((unsigned)__builtin_amdgcn_readfirstlane(__hip_atomic_load(w, __ATOMIC_RELAXED, __HIP_MEMORY_SCOPE_AGENT)) < 64u) { __builtin_amdgcn_s_sleep(2); if (++sp > (1u << 22)) break; }
            __builtin_amdgcn_fence(__ATOMIC_ACQUIRE, "agent");
            asm volatile("s_waitcnt vmcnt(0)" ::: "memory"); } }
    __syncthreads();
    EpiDown E{F_LW, F_Y};
    if (MOE_DN_FP8) pg8::gemm_phase<EpiDown, SchedMoeOne, false, true, true, false, true, 0x7c>((LAS unsigned char*)F.lds, DE / 2, S, E);
    else pg8::gemm_phase<EpiDown, SchedMoeOne, false, true, true>((LAS unsigned char*)F.lds, DE, S, E);
}
__device__ __forceinline__ void p7_down_mfma(Frame& F, bool have_tab) {
    if (!have_tab) moe_table(F);
    const int* tb = (const int*)(F.lds + MOE_TAB_OFF);
    SchedMoe S; S.tb = tb; S.G = F.G; S.vcu = (F.G % 8 == 0) ? (F.bid % 8) * (F.G / 8) + F.bid / 8 : F.bid;
    S.A = (const char*)F_HDN; S.a_row_bytes = DE * (MOE_DN_FP8 ? 1 : 2); S.B = (const char*)WSP(bf16, WS_WD_T); S.b_exp_bytes = (size_t)D * DE * (MOE_DN_FP8 ? 1 : 2); S.b_pn_bytes = (size_t)256 * DE * (MOE_DN_FP8 ? 1 : 2); S.LTOK = F_LTOK; S.cnt = F_ctl + CW_CNT; S.Kg = DE;
    const int nt = tb[33]; const int n_early = moe_early_tiles(nt, F.G); S.t_lo = 0; S.t_hi = nt - n_early; S.hole_lo = moe_early_first(nt, F.G); S.hole_n = n_early; S.n_pub = 0; S.donew = F_ctl + CW_DONE;
    EpiDown E{F_LW, F_Y};
    if (MOE_DN_FP8) pg8::gemm_phase<EpiDown, SchedMoe, false, true, true, false, true, 0x7c>((LAS unsigned char*)F.lds, DE / 2, S, E);
    else pg8::gemm_phase<EpiDown, SchedMoe, false, true, true>((LAS unsigned char*)F.lds, DE, S, E);
}


typedef float f32x16 __attribute__((ext_vector_type(16)));
typedef short s16x8 __attribute__((ext_vector_type(8)));
typedef short s16x4 __attribute__((ext_vector_type(4)));
__device__ __forceinline__ s16x4 vtr16(const LAS unsigned char* p) { return __builtin_bit_cast(s16x4, __builtin_amdgcn_ds_read_tr16_b64_v4i16((LAS s16x4*)p)); }
__device__ __forceinline__ float xhalf(float v, int hi) { auto rr = __builtin_amdgcn_permlane32_swap(__float_as_uint(v), __float_as_uint(v), false, false); return __uint_as_float(hi ? rr[0] : rr[1]); }

__device__ __forceinline__ void p2_attn_mfma(Frame& F) {
    LAS unsigned char* L = (LAS unsigned char*)F.lds;
    constexpr int LK = 0, LV = 32768, LFL = 65536;
    const int tid = F.tid, lane = F.lane, wid = F.wave, r32 = lane & 31, hi = lane >> 5;
    const bf16* P = F_PROJ; bf16* YB = F_YB;
    const float c2 = 0.08838834764831845f * 1.4426950408889634f;
    int srow[2], sch[2], kdst[2], vdst[2];
#pragma unroll
    for (int i = 0; i < 2; ++i) { const int c = tid + 512 * i; srow[i] = c >> 4; sch[i] = c & 15; const int row = srow[i], ch = sch[i];
        kdst[i] = row * 256 + ((ch ^ (row & 15)) << 4); vdst[i] = row * 256 + ((ch ^ (((row & 3) << 2) | ((row >> 2) & 3))) << 4); }
    int vaddr[4][2];
    { const int i = lane & 15, g16b = (lane >> 4) & 1, qrow = i >> 2, p = i & 3;
#pragma unroll
      for (int db = 0; db < 4; ++db)
#pragma unroll
        for (int h8 = 0; h8 < 2; ++h8) { const int mlo = (2 * h8 + hi) & 3, chlo = (2 * g16b + (p >> 1)) ^ mlo, chhi = db ^ qrow;
            vaddr[db][h8] = 256 * (4 * hi + qrow + 8 * h8) + 16 * ((chhi << 2) | chlo) + 8 * (p & 1); } }
    for (int unit = F.bid; unit < NH * (T / 256); unit += F.G) {
        const int h = unit & 7, qb = unit >> 3, q0 = qb * 256, qw0 = q0 + 32 * wid, qg = qw0 + r32;
        s16x8 qf[8];
        { const bf16* qrow = P + (size_t)qg * PW + OFF_Q + h * HD + hi * 8;
#pragma unroll
          for (int s = 0; s < 8; ++s) qf[s] = *(const s16x8*)(qrow + 16 * s); }
        f32x16 o[4];
#pragma unroll
        for (int db = 0; db < 4; ++db)
#pragma unroll
            for (int r = 0; r < 16; ++r) o[db][r] = 0.f;
        float R = 1.f;
        int jt = (q0 >> 6) + 3;
        u32x4 kreg[2], vreg[2];
        const bf16* kbase = P + OFF_K + h * HD; const bf16* vbase = P + OFF_V + h * HD;
#define ATT_LOAD(j) do { _Pragma("unroll") for (int i = 0; i < 2; ++i) { const size_t ro = (size_t)((j) * 64 + srow[i]) * PW + sch[i] * 8; \
            kreg[i] = *(const u32x4*)(kbase + ro); vreg[i] = *(const u32x4*)(vbase + ro); } } while (0)
#define ATT_WRITE(b) do { _Pragma("unroll") for (int i = 0; i < 2; ++i) { *(LAS u32x4*)(L + LK + (b) * 16384 + kdst[i]) = kreg[i]; *(LAS u32x4*)(L + LV + (b) * 16384 + vdst[i]) = vreg[i]; } } while (0)
        __syncthreads();
        ATT_LOAD(jt); ATT_WRITE(0);
        __syncthreads();
        int buf = 0; bool wdone = false;
        for (;;) {
            const int k0 = jt * 64; const bool more = jt > 0;
            if (more) ATT_LOAD(jt - 1);
            if (!wdone && k0 < qw0 + 31) {
                const LAS unsigned char* Kb = L + LK + buf * 16384; const LAS unsigned char* Vb = L + LV + buf * 16384;
                f32x16 p0, p1;
#pragma unroll
                for (int r = 0; r < 16; ++r) { p0[r] = 0.f; p1[r] = 0.f; }
#pragma unroll
                for (int s = 0; s < 8; ++s) { const int sw = ((2 * s + hi) ^ (r32 & 15)) << 4;
                    const s16x8 a0 = *(const LAS s16x8*)(Kb + r32 * 256 + sw), a1 = *(const LAS s16x8*)(Kb + (32 + r32) * 256 + sw);
                    p0 = __builtin_amdgcn_mfma_f32_32x32x16_bf16(a0, qf[s], p0, 0, 0, 0); p1 = __builtin_amdgcn_mfma_f32_32x32x16_bf16(a1, qf[s], p1, 0, 0, 0); }
                const bool diag = (k0 + 63 >= qw0);
#pragma unroll
                for (int r = 0; r < 16; ++r) { const int kk = k0 + (r & 3) + 8 * (r >> 2) + 4 * hi;
                    float e0 = __builtin_amdgcn_exp2f(fminf(p0[r] * c2, 100.f)), e1 = __builtin_amdgcn_exp2f(fminf(p1[r] * c2, 100.f));
                    if (diag) { if (kk >= qg) e0 = 0.f; if (kk + 32 >= qg) e1 = 0.f; }
                    p0[r] = __builtin_amdgcn_rcpf(1.0f + e0); p1[r] = __builtin_amdgcn_rcpf(1.0f + e1); }
                float Gp[8], Pn[8], Sx[8];
#pragma unroll
                for (int i = 0; i < 4; ++i) { Gp[i] = (p0[4 * i] * p0[4 * i + 1]) * (p0[4 * i + 2] * p0[4 * i + 3]); Gp[4 + i] = (p1[4 * i] * p1[4 * i + 1]) * (p1[4 * i + 2] * p1[4 * i + 3]); }
#pragma unroll
                for (int g = 0; g < 8; ++g) Pn[g] = xhalf(Gp[g], hi);
                Sx[7] = R;
#pragma unroll
                for (int g = 6; g >= 0; --g) Sx[g] = Sx[g + 1] * (Gp[g + 1] * Pn[g + 1]);
                R = Sx[0] * (Gp[0] * Pn[0]);
#pragma unroll
                for (int g = 0; g < 8; ++g) { float s = hi ? Sx[g] : Sx[g] * Pn[g];
#pragma unroll
                    for (int e = 3; e >= 0; --e) { const int r = 4 * (g & 3) + e; const float rv = (g < 4) ? p0[r] : p1[r]; const float t = s * rv; if (g < 4) p0[r] = s - t; else p1[r] = s - t; s = t; } }
                s16x8 pa[4];
#pragma unroll
                for (int ks = 0; ks < 4; ++ks) { u32x4 w;
#pragma unroll
                    for (int j = 0; j < 4; ++j) { const int r = 8 * (ks & 1) + 2 * j; w[j] = (ks < 2) ? pg8::cvt_pk_bf16(p0[r], p0[r + 1]) : pg8::cvt_pk_bf16(p1[r], p1[r + 1]); }
                    pa[ks] = __builtin_bit_cast(s16x8, w); }
#pragma unroll
                for (int db = 0; db < 4; ++db)
#pragma unroll
                    for (int ks = 0; ks < 4; ++ks) { const int rb = 256 * (16 * ks);
                        const s16x4 lo = vtr16(Vb + vaddr[db][0] + rb), hi4 = vtr16(Vb + vaddr[db][1] + rb);
                        const s16x8 vf = (s16x8){lo[0], lo[1], lo[2], lo[3], hi4[0], hi4[1], hi4[2], hi4[3]};
                        o[db] = __builtin_amdgcn_mfma_f32_32x32x16_bf16(pa[ks], vf, o[db], 0, 0, 0); }
            }
            if (ATTN_EARLY_EXIT) wdone = wdone || __all(R < 1e-30f);
            if (lane == 0) *(LAS unsigned*)(L + LFL + buf * 32 + wid * 4) = wdone ? 1u : 0u;
            if (more) ATT_WRITE(buf ^ 1);
            __syncthreads();
            const u32x4 f0 = *(const LAS u32x4*)(L + LFL + buf * 32), f1 = *(const LAS u32x4*)(L + LFL + buf * 32 + 16);
            const bool alldone = (f0.x & f0.y & f0.z & f0.w & f1.x & f1.y & f1.z & f1.w) != 0u;
            if (!more || alldone) break;
            buf ^= 1; --jt;
        }
#undef ATT_LOAD
#undef ATT_WRITE
        bf16* yb = YB + (size_t)qw0 * AW + h * HD + r32;
#pragma unroll
        for (int db = 0; db < 4; ++db)
#pragma unroll
            for (int r = 0; r < 16; ++r) { const int q = (r & 3) + 8 * (r >> 2) + 4 * hi; yb[(size_t)q * AW + 32 * db] = (bf16)f2bf(o[db][r]); }
    }
    __syncthreads();
}


__device__ __forceinline__ void p2_gating_mfma(Frame& F, const bool early) {
    LAS unsigned char* L = (LAS unsigned char*)F.lds;
    constexpr int LA = 0, LB = 32768, LO = 0;
    const int tid = F.tid, lane = F.lane, wid = F.wave, r32 = lane & 31, hi = lane >> 5, wr = wid >> 1, wc = wid & 1;
    const bf16* P = F_PROJ;
    int vaddr[2][2];
    { const int i = lane & 15, g16b = (lane >> 4) & 1, qrow = i >> 2, p = i & 3;
#pragma unroll
      for (int nb = 0; nb < 2; ++nb)
#pragma unroll
        for (int q4 = 0; q4 < 2; ++q4) { const int db = 2 * wc + nb, mlo = (2 * hi + q4) & 3, chlo = (2 * g16b + (p >> 1)) ^ mlo, chhi = db ^ qrow;
            vaddr[nb][q4] = 256 * (8 * hi + 4 * q4 + qrow) + 16 * ((chhi << 2) | chlo) + 8 * (p & 1); } }
    volatile LAS int* gslot = (volatile LAS int*)((LAS unsigned char*)F.lds + GQ_LDS_OFF); int stat_next = -1;
    for (;;) {
        __syncthreads();
        if (tid == 0) { int it = -1;
            if (early) { if ((int)__hip_atomic_load(F_ctl + CW_UDONE, __ATOMIC_RELAXED, __HIP_MEMORY_SCOPE_AGENT) < NPROJ_UNITS) it = (int)__hip_atomic_fetch_add(F_ctl + CW_GQ, 1u, __ATOMIC_RELAXED, __HIP_MEMORY_SCOPE_AGENT); }
            else {
                if (stat_next < 0) { int base = (int)__hip_atomic_load(F_ctl + CW_GQ, __ATOMIC_RELAXED, __HIP_MEMORY_SCOPE_AGENT); if (base > (T / CHK) * 8) base = (T / CHK) * 8; stat_next = base + F.bid; }
                it = stat_next; stat_next += F.G; }
            gslot[0] = it; }
        __syncthreads();
        const int item = gslot[0];
        if (item < 0 || item >= (T / CHK) * 8) break;
        const int c = item >> 3, g = item & 7, t0 = c * CHK;
        if (early) {
            if (tid < 64) { unsigned* w = F_ctl + CW_PANEL + 64 * (c >> 1); unsigned sp = 0;
                while ((unsigned)__builtin_amdgcn_readfirstlane(__hip_atomic_load(w, __ATOMIC_RELAXED, __HIP_MEMORY_SCOPE_AGENT)) < 64u) { __builtin_amdgcn_s_sleep(2); if (++sp > (1u << 22)) break; }
                __builtin_amdgcn_fence(__ATOMIC_ACQUIRE, "agent");
                asm volatile("s_waitcnt vmcnt(0)" ::: "memory"); } }
        __syncthreads();
        f32x4 wa[4], wb[4];
#pragma unroll
        for (int i = 0; i < 4; ++i) { const int cid = tid + 512 * i, t = cid >> 4, ch = cid & 15; const float* wp = F_w_sp + (size_t)g * 16384 + t * 128 + ch * 8; wa[i] = *(const f32x4*)wp; wb[i] = *(const f32x4*)(wp + 4); }
        { const int rr = lane >> 4, q = lane & 15; const int col = g * 128 + q * 8;
          const f32x4 g0 = *(const f32x4*)(F_ln_g + col), g1 = *(const f32x4*)(F_ln_g + col + 4), b0 = *(const f32x4*)(F_ln_b + col), b1 = *(const f32x4*)(F_ln_b + col + 4);
          u32x4 vv[4]; f32x2 st[4];
#pragma unroll
          for (int pass = 0; pass < 4; ++pass) { const int row = t0 + 16 * wid + 4 * pass + rr;
            vv[pass] = *((const u32x4*)(P + (size_t)row * PW + OFF_GV) + 16 * g + q); st[pass] = *((const f32x2*)WSP(float, WS_STAT) + (size_t)row * 16 + q); }
#pragma unroll
          for (int pass = 0; pass < 4; ++pass) { const int s = 16 * wid + 4 * pass + rr;
            float sm = st[pass].x, s2 = st[pass].y; const u32x4 v = vv[pass];
#pragma unroll
            for (int o = 1; o < 16; o <<= 1) { sm += __shfl_xor(sm, o); s2 += __shfl_xor(s2, o); }
            const float mu = sm * (1.f / AW), rs = rsqrtf(fmaxf(s2 * (1.f / AW) - mu * mu, 0.f) + EPS);
            u32x4 o4; o4.x = pk2((__uint_as_float(v.x << 16) - mu) * rs * g0.x + b0.x, (__uint_as_float(v.x & 0xffff0000u) - mu) * rs * g0.y + b0.y);
            o4.y = pk2((__uint_as_float(v.y << 16) - mu) * rs * g0.z + b0.z, (__uint_as_float(v.y & 0xffff0000u) - mu) * rs * g0.w + b0.w);
            o4.z = pk2((__uint_as_float(v.z << 16) - mu) * rs * g1.x + b1.x, (__uint_as_float(v.z & 0xffff0000u) - mu) * rs * g1.y + b1.y);
            o4.w = pk2((__uint_as_float(v.w << 16) - mu) * rs * g1.z + b1.z, (__uint_as_float(v.w & 0xffff0000u) - mu) * rs * g1.w + b1.w);
            *(LAS u32x4*)(L + LB + s * 256 + ((q ^ (((s & 3) << 2) | ((s >> 2) & 3))) << 4)) = o4; } }
#pragma unroll
        for (int i = 0; i < 4; ++i) { const int cid = tid + 512 * i, t = cid >> 4, ch = cid & 15; const f32x4 a = wa[i], b = wb[i]; const int s0 = ch * 8;
            u32x4 w; w.x = pk2(s0 + 0 <= t ? a.x : 0.f, s0 + 1 <= t ? a.y : 0.f); w.y = pk2(s0 + 2 <= t ? a.z : 0.f, s0 + 3 <= t ? a.w : 0.f);
            w.z = pk2(s0 + 4 <= t ? b.x : 0.f, s0 + 5 <= t ? b.y : 0.f); w.w = pk2(s0 + 6 <= t ? b.z : 0.f, s0 + 7 <= t ? b.w : 0.f);
            *(LAS u32x4*)(L + LA + t * 256 + ((ch ^ (t & 15)) << 4)) = w; }
        __syncthreads();
        f32x16 acc[2];
#pragma unroll
        for (int nb = 0; nb < 2; ++nb)
#pragma unroll
            for (int r = 0; r < 16; ++r) acc[nb][r] = 0.f;
        const int trow = 32 * wr + r32;
        for (int ks = 0; ks < 2 * (wr + 1); ++ks) {
            const s16x8 a = *(const LAS s16x8*)(L + LA + trow * 256 + (((2 * ks + hi) ^ (trow & 15)) << 4));
#pragma unroll
            for (int nb = 0; nb < 2; ++nb) { const s16x4 lo = vtr16(L + LB + vaddr[nb][0] + 4096 * ks), h4 = vtr16(L + LB + vaddr[nb][1] + 4096 * ks);
                const s16x8 b = (s16x8){lo[0], lo[1], lo[2], lo[3], h4[0], h4[1], h4[2], h4[3]};
                acc[nb] = __builtin_amdgcn_mfma_f32_32x32x16_bf16(a, b, acc[nb], 0, 0, 0); }
        }
        __syncthreads();
        { float* ot = (float*)(F.lds + LO);
#pragma unroll
          for (int nb = 0; nb < 2; ++nb)
#pragma unroll
            for (int r = 0; r < 16; ++r) { const int t = 32 * wr + (r & 3) + 8 * (r >> 2) + 4 * hi; ot[t * 132 + 64 * wc + 32 * nb + r32] = acc[nb][r]; }
          __syncthreads();
#pragma unroll
          for (int i = 0; i < 4; ++i) { const int cid = tid + 512 * i, t = cid >> 4, ch = cid & 15; const int col = g * 128 + ch * 8;
            const f32x4 m0 = *(const f32x4*)(ot + t * 132 + ch * 8), m1 = *(const f32x4*)(ot + t * 132 + ch * 8 + 4);
            const u32x4 u = *(const u32x4*)(P + (size_t)(t0 + t) * PW + OFF_U + col); const float bb = F_b_sp[g * 128 + t];
            float uf[8];
#pragma unroll
            for (int e = 0; e < 4; ++e) { uf[2 * e] = __uint_as_float(u[e] << 16); uf[2 * e + 1] = __uint_as_float(u[e] & 0xffff0000u); }
            if (GELU_U_LATE) {
#pragma unroll
                for (int e = 0; e < 8; ++e) uf[e] = gelu_tanh(uf[e]); }
            u32x4 y; y.x = pk2(uf[0] * (m0.x + bb), uf[1] * (m0.y + bb)); y.y = pk2(uf[2] * (m0.z + bb), uf[3] * (m0.w + bb));
            y.z = pk2(uf[4] * (m1.x + bb), uf[5] * (m1.y + bb)); y.w = pk2(uf[6] * (m1.z + bb), uf[7] * (m1.w + bb));
            *(u32x4*)(F_YA + (size_t)(t0 + t) * AW + col) = y; } }
    }
    __syncthreads();
}
__device__ __forceinline__ void route_thread(Frame& F, int t, const float* lg36, float rstd) {
    float lg[4];
#pragma unroll
    for (int i = 0; i < 4; ++i) lg[i] = lg36[32 + i] * rstd + F_b_rg[i];
    int grp = 0; float m = lg[0];
#pragma unroll
    for (int i = 1; i < 4; ++i) if (lg[i] > m) { m = lg[i]; grp = i; }
    float ssum = 0.f;
#pragma unroll
    for (int i = 0; i < 4; ++i) ssum += __expf(lg[i] - m);
    const float pg = 1.0f / ssum;
    float le[8];
#pragma unroll
    for (int i = 0; i < 8; ++i) le[i] = lg36[grp * 8 + i] * rstd + F_b_re[grp * 8 + i];
    int i1 = 0; float v1 = le[0];
#pragma unroll
    for (int i = 1; i < 8; ++i) if (le[i] > v1) { v1 = le[i]; i1 = i; }
    int i2 = -1; float v2 = -3.0e38f;
#pragma unroll
    for (int i = 0; i < 8; ++i) if (i != i1 && le[i] > v2) { v2 = le[i]; i2 = i; }
    const float ed = __expf(v2 - v1), pe1 = 1.0f / (1.0f + ed), pe2 = ed * pe1;
    const int e0 = grp * 8 + i1, e1 = grp * 8 + i2;
    const int p0 = (int)atomicAdd(F_ctl + CW_CNT + CNT_STRIDE * e0, 1u), p1 = (int)atomicAdd(F_ctl + CW_CNT + CNT_STRIDE * e1, 1u);
    F_LTOK[e0 * T + p0] = t; F_LW[e0 * T + p0] = pg * pe1; F_LRSTD[e0 * T + p0] = rstd;
    F_LTOK[e1 * T + p1] = t; F_LW[e1 * T + p1] = pg * pe2; F_LRSTD[e1 * T + p1] = rstd;
    F_TINFO[t * 4 + 0] = e0; F_TINFO[t * 4 + 1] = e1; F_TINFO[t * 4 + 2] = p0; F_TINFO[t * 4 + 3] = p1;
}
__device__ __forceinline__ void p5_router_mfma(Frame& F) {
    float* xs = (float*)F.lds;
    float* part = xs + 32 * 513;
    float* ssq = part + 8 * 32 * 36;
    float* lgt = ssq + 256;
    const int tid = F.tid, lane = F.lane, wid = F.wave, r32 = lane & 31, hi = lane >> 5;
    const float *X1 = F_out, *gf = F_g_ffn, *Wre = F_w_re, *Wrg = F_w_rg;
    for (int tb = F.bid; tb < T / 32; tb += F.G) {
        const int t0 = tb * 32;
        f32x16 acc, accg;
#pragma unroll
        for (int r = 0; r < 16; ++r) { acc[r] = 0.f; accg[r] = 0.f; }
        f32x4 xv[8];
#pragma unroll
        for (int i = 0; i < 8; ++i) { const int idx = tid + 512 * i, row = idx >> 7, c4 = idx & 127; xv[i] = *(const f32x4*)(X1 + (size_t)(t0 + row) * D + c4 * 4); }
        for (int kc = 0; kc < 4; ++kc) {
            __syncthreads();
#pragma unroll
            for (int i = 0; i < 8; ++i) { const int idx = tid + 512 * i, row = idx >> 7, c4 = idx & 127;
                const f32x4 v = xv[i], g = *(const f32x4*)(gf + kc * 512 + c4 * 4);
                const float ss = wave_sum((v.x * v.x + v.y * v.y) + (v.z * v.z + v.w * v.w));
                if (lane == 0) ssq[row * 8 + kc * 2 + (wid & 1)] = ss;
                float* d = xs + row * 513 + c4 * 4; d[0] = v.x * g.x; d[1] = v.y * g.y; d[2] = v.z * g.z; d[3] = v.w * g.w; }
            const int kw0 = wid * 64; float wb[32], wg[32];
#pragma unroll
            for (int s = 0; s < 32; ++s) { const int kg = kc * 512 + kw0 + 2 * s + hi; wb[s] = Wre[(size_t)kg * 32 + r32]; wg[s] = (r32 < 4) ? Wrg[(size_t)kg * 4 + r32] : 0.f; }
            if (kc < 3) {
#pragma unroll
                for (int i = 0; i < 8; ++i) { const int idx = tid + 512 * i, row = idx >> 7, c4 = idx & 127; xv[i] = *(const f32x4*)(X1 + (size_t)(t0 + row) * D + (kc + 1) * 512 + c4 * 4); } }
            __syncthreads();
#pragma unroll
            for (int s = 0; s < 32; ++s) { const float a = xs[r32 * 513 + kw0 + 2 * s + hi];
                acc = __builtin_amdgcn_mfma_f32_32x32x2f32(a, wb[s], acc, 0, 0, 0); accg = __builtin_amdgcn_mfma_f32_32x32x2f32(a, wg[s], accg, 0, 0, 0); }
        }
#pragma unroll
        for (int r = 0; r < 16; ++r) { const int i = (r & 3) + 8 * (r >> 2) + 4 * hi; part[(wid * 32 + i) * 36 + r32] = acc[r]; if (r32 < 4) part[(wid * 32 + i) * 36 + 32 + r32] = accg[r]; }
        __syncthreads();
        for (int o = tid; o < 32 * 36; o += NTHR) { float s = 0.f;
#pragma unroll
            for (int w = 0; w < 8; ++w) s += part[w * 1152 + o];
            lgt[o] = s; }
        __syncthreads();
        if (tid < 32) { float s = 0.f;
#pragma unroll
            for (int q = 0; q < 8; ++q) s += ssq[tid * 8 + q];
            route_thread(F, t0 + tid, lgt + tid * 36, rsqrtf(s * (1.f / D) + EPS)); }
    }
    __syncthreads();
}


__device__ __forceinline__ void route_decide(Frame& F, const float* lg36, float rstd, int& e0, int& e1, float& w0, float& w1) {
    float lg[4];
#pragma unroll
    for (int i = 0; i < 4; ++i) lg[i] = lg36[32 + i] * rstd + F_b_rg[i];
    int grp = 0; float m = lg[0];
#pragma unroll
    for (int i = 1; i < 4; ++i) if (lg[i] > m) { m = lg[i]; grp = i; }
    float ssum = 0.f;
#pragma unroll
    for (int i = 0; i < 4; ++i) ssum += __expf(lg[i] - m);
    const float pg = 1.0f / ssum;
    float le[8];
#pragma unroll
    for (int i = 0; i < 8; ++i) le[i] = lg36[grp * 8 + i] * rstd + F_b_re[grp * 8 + i];
    int i1 = 0; float v1 = le[0];
#pragma unroll
    for (int i = 1; i < 8; ++i) if (le[i] > v1) { v1 = le[i]; i1 = i; }
    int i2 = -1; float v2 = -3.0e38f;
#pragma unroll
    for (int i = 0; i < 8; ++i) if (i != i1 && le[i] > v2) { v2 = le[i]; i2 = i; }
    const float ed = __expf(v2 - v1), pe1 = 1.0f / (1.0f + ed), pe2 = ed * pe1;
    e0 = grp * 8 + i1; e1 = grp * 8 + i2; w0 = pg * pe1; w1 = pg * pe2;
}
__device__ __forceinline__ void p5_router_split(Frame& F) {
    unsigned char* ahL = F.lds; unsigned char* alL = F.lds + 32 * 1040;
    float* part = (float*)F.lds;
    float* ssq = (float*)(F.lds + 66560);
    float* lgt = ssq + 256;
    int* lcnt = (int*)(lgt + 32 * 36); int* lbase = lcnt + 32;
    const int tid = F.tid, lane = F.lane, wid = F.wave, r32 = lane & 31, hi = lane >> 5;
    const float* X1 = F_out; const bf16* WF = WSP(bf16, WS_WRH);
    for (int tb = F.bid; tb < T / 32; tb += F.G) {
        const int t0 = tb * 32;
        f32x16 acc0, acc1;
#pragma unroll
        for (int r = 0; r < 16; ++r) { acc0[r] = 0.f; acc1[r] = 0.f; }
        f32x4 xv[8];
#pragma unroll
        for (int i = 0; i < 8; ++i) { const int idx = tid + 512 * i, row = idx >> 7, c4 = idx & 127; xv[i] = *(const f32x4*)(X1 + (size_t)(t0 + row) * D + c4 * 4); }
        for (int kc = 0; kc < 4; ++kc) {
            __syncthreads();
#pragma unroll
            for (int i = 0; i < 8; ++i) { const int idx = tid + 512 * i, row = idx >> 7, c4 = idx & 127; const f32x4 v = xv[i];
                const float ss = wave_sum((v.x * v.x + v.y * v.y) + (v.z * v.z + v.w * v.w));
                if (lane == 0) ssq[row * 8 + kc * 2 + (wid & 1)] = ss;
                u32x2 ph, pl; ph.x = pg8::cvt_pk_bf16(v.x, v.y); ph.y = pg8::cvt_pk_bf16(v.z, v.w);
                pl.x = pg8::cvt_pk_bf16(v.x - __uint_as_float(ph.x << 16), v.y - __uint_as_float(ph.x & 0xffff0000u)); pl.y = pg8::cvt_pk_bf16(v.z - __uint_as_float(ph.y << 16), v.w - __uint_as_float(ph.y & 0xffff0000u));
                *(u32x2*)(ahL + row * 1040 + c4 * 8) = ph; *(u32x2*)(alL + row * 1040 + c4 * 8) = pl; }
            s16x8 bfr[4][4];
            { const bf16* wp = WF + ((size_t)(kc * 8 + wid) * 4) * 2048 + lane * 8;
#pragma unroll
              for (int s4 = 0; s4 < 4; ++s4)
#pragma unroll
                for (int q = 0; q < 4; ++q) bfr[s4][q] = *(const s16x8*)(wp + (size_t)s4 * 2048 + q * 512); }
            if (kc < 3) {
#pragma unroll
                for (int i = 0; i < 8; ++i) { const int idx = tid + 512 * i, row = idx >> 7, c4 = idx & 127; xv[i] = *(const f32x4*)(X1 + (size_t)(t0 + row) * D + (kc + 1) * 512 + c4 * 4); } }
            __syncthreads();
#pragma unroll
            for (int s4 = 0; s4 < 4; ++s4) { const int ko = (64 * wid + 16 * s4 + 8 * hi) * 2;
                const s16x8 ah = *(const s16x8*)(ahL + r32 * 1040 + ko), al = *(const s16x8*)(alL + r32 * 1040 + ko);
                acc0 = __builtin_amdgcn_mfma_f32_32x32x16_bf16(ah, bfr[s4][0], acc0, 0, 0, 0); acc0 = __builtin_amdgcn_mfma_f32_32x32x16_bf16(ah, bfr[s4][1], acc0, 0, 0, 0); acc0 = __builtin_amdgcn_mfma_f32_32x32x16_bf16(al, bfr[s4][0], acc0, 0, 0, 0);
                acc1 = __builtin_amdgcn_mfma_f32_32x32x16_bf16(ah, bfr[s4][2], acc1, 0, 0, 0); acc1 = __builtin_amdgcn_mfma_f32_32x32x16_bf16(ah, bfr[s4][3], acc1, 0, 0, 0); acc1 = __builtin_amdgcn_mfma_f32_32x32x16_bf16(al, bfr[s4][2], acc1, 0, 0, 0); }
        }
        __syncthreads();
#pragma unroll
        for (int r = 0; r < 16; ++r) { const int i = (r & 3) + 8 * (r >> 2) + 4 * hi; part[(wid * 32 + i) * 64 + r32] = acc0[r]; if (r32 < 4) part[(wid * 32 + i) * 64 + 32 + r32] = acc1[r]; }
        if (tid < 32) lcnt[tid] = 0;
        __syncthreads();
        for (int o = tid; o < 32 * 36; o += NTHR) { const int i = o / 36, j = o - i * 36; float s = 0.f;
#pragma unroll
            for (int w = 0; w < 8; ++w) s += part[(w * 32 + i) * 64 + j];
            lgt[o] = s; }
        __syncthreads();
        int e0 = 0, e1 = 0, q0 = 0, q1 = 0; float w0 = 0.f, w1 = 0.f, rstd = 0.f;
        if (tid < 32) { float s = 0.f;
#pragma unroll
            for (int q = 0; q < 8; ++q) s += ssq[tid * 8 + q];
            rstd = rsqrtf(s * (1.f / D) + EPS);
            route_decide(F, lgt + tid * 36, rstd, e0, e1, w0, w1);
            q0 = atomicAdd(&lcnt[e0], 1); q1 = atomicAdd(&lcnt[e1], 1); }
        __syncthreads();
        if (tid < 32) { const int n = lcnt[tid]; lbase[tid] = n ? (int)atomicAdd(F_ctl + CW_CNT + CNT_STRIDE * tid, (unsigned)n) : 0; }
        __syncthreads();
        if (tid < 32) { const int t = t0 + tid, p0 = lbase[e0] + q0, p1 = lbase[e1] + q1;
            F_LTOK[e0 * T + p0] = t; F_LW[e0 * T + p0] = w0; F_LRSTD[e0 * T + p0] = rstd;
            F_LTOK[e1 * T + p1] = t; F_LW[e1 * T + p1] = w1; F_LRSTD[e1 * T + p1] = rstd;
            F_TINFO[t * 4 + 0] = e0; F_TINFO[t * 4 + 1] = e1; F_TINFO[t * 4 + 2] = p0; F_TINFO[t * 4 + 3] = p1; }
    }
    __syncthreads();
}
__device__ __forceinline__ void p5_router_wave(Frame& F) {
    unsigned char* ahL = F.lds + F.wave * 9216; unsigned char* alL = ahL + 4608;
    float* part = (float*)F.lds;
    float* ssq = (float*)(F.lds + 73728);
    float* lgt = ssq + 256;
    int* lcnt = (int*)(lgt + 32 * 36); int* lbase = lcnt + 32;
    const int tid = F.tid, lane = F.lane, wid = F.wave, r32 = lane & 31, hi = lane >> 5;
    const float* X1 = F_out; const bf16* WF = WSP(bf16, WS_WRH);
    for (int tb = F.bid; tb < T / 32; tb += F.G) {
        const int t0 = tb * 32;
        f32x16 acc0, acc1;
#pragma unroll
        for (int r = 0; r < 16; ++r) { acc0[r] = 0.f; acc1[r] = 0.f; }
        const int rr = lane >> 4, q16 = lane & 15;
        const float* xb = X1 + (size_t)(t0 + rr) * D + 64 * wid + 4 * q16;
        f32x4 xv[8]; float ssr[8];
#pragma unroll
        for (int i = 0; i < 8; ++i) { xv[i] = *(const f32x4*)(xb + (size_t)(4 * i) * D); ssr[i] = 0.f; }
#pragma unroll 1
        for (int kc = 0; kc < 4; ++kc) {
            s16x8 bfr[4][4];
            { const bf16* wp = WF + ((size_t)(kc * 8 + wid) * 4) * 2048 + lane * 8;
#pragma unroll
              for (int s4 = 0; s4 < 4; ++s4)
#pragma unroll
                for (int q = 0; q < 4; ++q) bfr[s4][q] = *(const s16x8*)(wp + (size_t)s4 * 2048 + q * 512); }
#pragma unroll
            for (int i = 0; i < 8; ++i) { const f32x4 v = xv[i]; const int row = 4 * i + rr;
                ssr[i] += (v.x * v.x + v.y * v.y) + (v.z * v.z + v.w * v.w);
                u32x2 ph, pl; ph.x = pg8::cvt_pk_bf16(v.x, v.y); ph.y = pg8::cvt_pk_bf16(v.z, v.w);
                pl.x = pg8::cvt_pk_bf16(v.x - __uint_as_float(ph.x << 16), v.y - __uint_as_float(ph.x & 0xffff0000u)); pl.y = pg8::cvt_pk_bf16(v.z - __uint_as_float(ph.y << 16), v.w - __uint_as_float(ph.y & 0xffff0000u));
                *(u32x2*)(ahL + row * 144 + q16 * 8) = ph; *(u32x2*)(alL + row * 144 + q16 * 8) = pl; }
            if (kc < 3) {
#pragma unroll
                for (int i = 0; i < 8; ++i) xv[i] = *(const f32x4*)(xb + (size_t)(4 * i) * D + (kc + 1) * 512); }
#pragma unroll
            for (int s4 = 0; s4 < 4; ++s4) { const int ko = (16 * s4 + 8 * hi) * 2;
                const s16x8 ah = *(const s16x8*)(ahL + r32 * 144 + ko), al = *(const s16x8*)(alL + r32 * 144 + ko);
                acc0 = __builtin_amdgcn_mfma_f32_32x32x16_bf16(ah, bfr[s4][0], acc0, 0, 0, 0); acc0 = __builtin_amdgcn_mfma_f32_32x32x16_bf16(ah, bfr[s4][1], acc0, 0, 0, 0); acc0 = __builtin_amdgcn_mfma_f32_32x32x16_bf16(al, bfr[s4][0], acc0, 0, 0, 0);
                acc1 = __builtin_amdgcn_mfma_f32_32x32x16_bf16(ah, bfr[s4][2], acc1, 0, 0, 0); acc1 = __builtin_amdgcn_mfma_f32_32x32x16_bf16(ah, bfr[s4][3], acc1, 0, 0, 0); acc1 = __builtin_amdgcn_mfma_f32_32x32x16_bf16(al, bfr[s4][2], acc1, 0, 0, 0); }
        }
#pragma unroll
        for (int i = 0; i < 8; ++i) { float ss = ssr[i];
#pragma unroll
            for (int o = 1; o < 16; o <<= 1) ss += __shfl_xor(ss, o);
            if (q16 == 0) ssq[(4 * i + rr) * 8 + wid] = ss; }
        __syncthreads();
#pragma unroll
        for (int r = 0; r < 16; ++r) { const int i = (r & 3) + 8 * (r >> 2) + 4 * hi; part[(wid * 32 + i) * 64 + r32] = acc0[r]; if (r32 < 4) part[(wid * 32 + i) * 64 + 32 + r32] = acc1[r]; }
        if (tid < 32) lcnt[tid] = 0;
        __syncthreads();
        for (int o = tid; o < 32 * 36; o += NTHR) { const int i = o / 36, j = o - i * 36; float s = 0.f;
#pragma unroll
            for (int w = 0; w < 8; ++w) s += part[(w * 32 + i) * 64 + j];
            lgt[o] = s; }
        __syncthreads();
        int e0 = 0, e1 = 0, q0 = 0, q1 = 0; float w0 = 0.f, w1 = 0.f, rstd = 0.f;
        if (tid < 32) { float s = 0.f;
#pragma unroll
            for (int q = 0; q < 8; ++q) s += ssq[tid * 8 + q];
            rstd = rsqrtf(s * (1.f / D) + EPS);
            route_decide(F, lgt + tid * 36, rstd, e0, e1, w0, w1);
            q0 = atomicAdd(&lcnt[e0], 1); q1 = atomicAdd(&lcnt[e1], 1); }
        __syncthreads();
        if (tid < 32) { const int n = lcnt[tid]; lbase[tid] = n ? (int)atomicAdd(F_ctl + CW_CNT + CNT_STRIDE * tid, (unsigned)n) : 0; }
        __syncthreads();
        if (tid < 32) { const int t = t0 + tid, p0 = lbase[e0] + q0, p1 = lbase[e1] + q1;
            F_LTOK[e0 * T + p0] = t; F_LW[e0 * T + p0] = w0; F_LRSTD[e0 * T + p0] = rstd;
            F_LTOK[e1 * T + p1] = t; F_LW[e1 * T + p1] = w1; F_LRSTD[e1 * T + p1] = rstd;
            F_TINFO[t * 4 + 0] = e0; F_TINFO[t * 4 + 1] = e1; F_TINFO[t * 4 + 2] = p0; F_TINFO[t * 4 + 3] = p1; }
    }
    __syncthreads();
}
#define XB_TMO      128
#define XB_XCNT(j)  (256  + 64 * (j))
#define XB_XSUB(j)  (1280 + 64 * (j))
#define XB_XGEN(j)  (2304 + 64 * (j))
#define XB_TOP      3328
#define XB_TOPGEN   3392
#define XCD_BAR_WORDS 3456
#define XB_SPIN_CAP (1u << 18)
__device__ __forceinline__ unsigned xb_ld(unsigned* p)              { return __hip_atomic_load(p, __ATOMIC_RELAXED, __HIP_MEMORY_SCOPE_AGENT); }
__device__ __forceinline__ unsigned xb_add(unsigned* p, unsigned v) { return __hip_atomic_fetch_add(p, v, __ATOMIC_RELAXED, __HIP_MEMORY_SCOPE_AGENT); }
__device__ __forceinline__ unsigned xb_xcc_id() { return (unsigned)__builtin_amdgcn_s_getreg((3 << 11) | 20) & 0xFu; }
#define XB_SPIN(cond, bar) do { unsigned _sp = 0; while (cond) { __builtin_amdgcn_s_sleep(1); \
    if ((++_sp & 255u) == 0u) { if (xb_ld(&(bar)[XB_TMO])) break; if (_sp > XB_SPIN_CAP) { atomicAdd(&(bar)[XB_TMO], 1u); break; } } } } while (0)
struct XcdBarrier { unsigned* bar; unsigned x; volatile LAS unsigned* st; };
__device__ __forceinline__ XcdBarrier xcd_barrier_post(unsigned* bar, volatile LAS unsigned* st) {
    XcdBarrier b; b.bar = bar; b.x = xb_xcc_id(); b.st = st;
    if (threadIdx.x == 0) (void)xb_add(&bar[XB_XCNT(b.x)], 1u);
    return b;
}
__device__ __forceinline__ void xcd_barrier_complete(unsigned* bar, unsigned x, unsigned& nloc, unsigned& nx) {
    const unsigned G = gridDim.x * gridDim.y * gridDim.z;
    unsigned sum, cnt, mine, sp = 0u;
    for (;;) {
        sum = 0u; cnt = 0u; mine = 0u;
#pragma unroll
        for (unsigned j = 0; j < 16; ++j) { const unsigned c = xb_ld(&bar[XB_XCNT(j)]); sum += c; cnt += (c > 0u) ? 1u : 0u; mine = (j == x) ? c : mine; }
        if (sum == G) break;
        __builtin_amdgcn_s_sleep(1);
        if ((++sp & 255u) == 0u) { if (xb_ld(&bar[XB_TMO])) break; if (sp > XB_SPIN_CAP) { atomicAdd(&bar[XB_TMO], 1u); break; } }
    }
    nloc = mine > 0u ? mine : 1u; nx = cnt > 0u ? cnt : 1u;
}
__device__ __forceinline__ void xcd_barrier(const XcdBarrier& b) {
    asm volatile("s_waitcnt vmcnt(0)" ::: "memory");
    __syncthreads();
    if (threadIdx.x == 0) {
        unsigned* bar = b.bar;
        __builtin_amdgcn_s_waitcnt(0);
        unsigned nloc = b.st[0], nx = b.st[1];
        if (nloc == 0u) { xcd_barrier_complete(bar, b.x, nloc, nx); b.st[0] = nloc; b.st[1] = nx; }
        const unsigned old = xb_add(&bar[XB_XSUB(b.x)], 1u);
        const unsigned gen = old / nloc;
        if (old + 1u == (gen + 1u) * nloc) {
            __builtin_amdgcn_fence(__ATOMIC_RELEASE, "agent");
            asm volatile("s_waitcnt vmcnt(0)" ::: "memory");
            const unsigned og = xb_add(&bar[XB_TOP], 1u);
            const unsigned tg = og / nx;
            if (og + 1u == (tg + 1u) * nx) xb_add(&bar[XB_TOPGEN], 1u);
            else XB_SPIN(xb_ld(&bar[XB_TOPGEN]) == tg, bar);
            __builtin_amdgcn_fence(__ATOMIC_ACQUIRE, "agent");
            xb_add(&bar[XB_XGEN(b.x)], 1u);
            asm volatile("s_waitcnt vmcnt(0)" ::: "memory");
        } else if (EARLY_ACQUIRE) {
            __builtin_amdgcn_fence(__ATOMIC_ACQUIRE, "agent");
            XB_SPIN(xb_ld(&bar[XB_XGEN(b.x)]) == gen, bar);
            asm volatile("s_waitcnt vmcnt(0)" ::: "memory");
        } else {
            XB_SPIN(xb_ld(&bar[XB_XGEN(b.x)]) == gen, bar);
            __builtin_amdgcn_fence(__ATOMIC_ACQUIRE, "agent");
            asm volatile("s_waitcnt vmcnt(0)" ::: "memory");
        }
    }
    __syncthreads();
}
constexpr int CW_BAR = 4096; static_assert((CW_BAR + XCD_BAR_WORDS) * 4 <= (int)CTL_ZERO_BYTES, "barrier words inside the zeroed control region");
constexpr int XB_LDS_OFF = LDS_BYTES - 16;
__global__ void __launch_bounds__(NTHR, 2) fwd_kernel(Args args) {
    extern __shared__ __attribute__((aligned(16))) unsigned char lds[];
    cg::grid_group grid = cg::this_grid();
    Frame F;
    F.lds = lds; F.tid = threadIdx.x; F.lane = F.tid & 63; F.wave = __builtin_amdgcn_readfirstlane(F.tid >> 6); F.G = gridDim.x; F.bid = blockIdx.x; F.A = &args;
    const int lo = args.ph_lo, hi = args.ph_hi;
#define IN(k) (lo <= (k) && (k) < hi)
    volatile LAS unsigned* xbst = (volatile LAS unsigned*)((LAS unsigned char*)lds + XB_LDS_OFF);
    if (F.tid < 4) xbst[F.tid] = 0u;
    __syncthreads();
    XcdBarrier xbar = xcd_barrier_post(F_ctl + CW_BAR, xbst);
#define SEAM(k) do { if (IN(k) && IN((k) + 1)) { if (!XCD_BARRIER || args.use_cg) grid.sync(); else xcd_barrier(xbar); } } while (0)
    if (IN(0)) { if (MFMA_MASK) p0_weights(F); if (ROUTER_MFMA >= 2) p0_router_weights(F); p0_prologue(F); if (PROBE_REPEAT & (1 << 0)) { grid.sync(); if (MFMA_MASK) p0_weights(F); p0_prologue(F); } } SEAM(0);
    if (IN(1)) { if (MFMA_MASK & 1) p1_proj_mfma(F); else p1_proj(F); if (PROBE_REPEAT & (1 << 1)) { grid.sync(); if (MFMA_MASK & 1) p1_proj_mfma(F); else p1_proj(F); } } SEAM(1);
    if (IN(2)) { p2_gating_mfma(F, false); if (ATTN_MFMA) p2_attn_mfma(F); else p2_attn(F); if (PROBE_REPEAT & 4) { grid.sync(); if (ATTN_MFMA) p2_attn_mfma(F); else p2_attn(F); } } SEAM(2);
    if (IN(3)) { if (MFMA_MASK & 2) p3_branch_mfma(F); else p3_branch(F); if (PROBE_REPEAT & (1 << 3)) { grid.sync(); if (MFMA_MASK & 2) p3_branch_mfma(F); else p3_branch(F); } } SEAM(3);
    if (IN(4)) { if (MFMA_MASK & 4) p4_out_mfma(F); else p4_out(F); } SEAM(4);
    if (IN(5)) { if (ROUTER_MFMA == 3) p5_router_wave(F); else if (ROUTER_MFMA == 2) p5_router_split(F); else if (ROUTER_MFMA) p5_router_mfma(F); else p5_router(F); } SEAM(5);
    if (IN(6)) { if (MFMA_MASK & 8) p6_gateup_mfma(F); else p6_gateup(F); if (PROBE_REPEAT & (1 << 6)) { grid.sync(); if (MFMA_MASK & 8) p6_gateup_mfma(F); else p6_gateup(F); } } SEAM(6);
    if (IN(7)) { if (MFMA_MASK & 16) p7_down_mfma(F, IN(6) && (MFMA_MASK & 8) && !(PROBE_REPEAT & (1 << 6))); else p7_down(F); if (PROBE_REPEAT & (1 << 7)) { grid.sync(); if (MFMA_MASK & 16) p7_down_mfma(F, IN(6) && (MFMA_MASK & 8) && !(PROBE_REPEAT & (1 << 6))); else p7_down(F); } } SEAM(7);
    if (IN(8)) { p8_final(F, IN(6) && (MFMA_MASK & 8)); }
#undef IN
#undef SEAM
}

extern "C" void kernel_launch(void* const* d_in, const int* in_sizes, int n_in, void* d_out, int out_size, void* d_ws, size_t ws_size, hipStream_t stream) {
    static int grid = 0;
    if (grid == 0) {
        if (n_in != 19 || out_size != T * D || ws_size < WS_END) { fprintf(stderr, "kernel_launch: unexpected problem (n_in %d out %d ws %zu)\n", n_in, out_size, ws_size); grid = -1; return; }
        int dev = 0, cus = 0, per_cu = 0;
        hipGetDevice(&dev); hipDeviceGetAttribute(&cus, hipDeviceAttributeMultiprocessorCount, dev);
        if (hipFuncSetAttribute((const void*)fwd_kernel, hipFuncAttributeMaxDynamicSharedMemorySize, LDS_BYTES) != hipSuccess) { fprintf(stderr, "kernel_launch: hipFuncSetAttribute failed\n"); grid = -1; return; }
        if (hipOccupancyMaxActiveBlocksPerMultiprocessor(&per_cu, (const void*)fwd_kernel, NTHR, LDS_BYTES) != hipSuccess || per_cu < 1) { fprintf(stderr, "kernel_launch: occupancy query says %d\n", per_cu); per_cu = 1; }
        (void)hipGetLastError();
        grid = cus;
    }
    if (grid < 0) return;
    hipMemsetAsync((char*)d_ws + WS_CTL, 0, CTL_ZERO_BYTES, stream);
    Args a{};
    for (int i = 0; i < 19; ++i) a.in[i] = (const float*)d_in[i];
    a.out = (float*)d_out; a.ws = (unsigned char*)d_ws; a.use_cg = USE_CG_SEAMS; a.pad = 0;
    if (N_LAUNCH_MODE == 1) {
        a.ph_lo = 0; a.ph_hi = N_PHASES; void* kargs[] = {&a};
        hipError_t e = hipLaunchCooperativeKernel((const void*)fwd_kernel, dim3(grid), dim3(NTHR), kargs, LDS_BYTES, stream);
        if (e != hipSuccess) fprintf(stderr, "cooperative launch failed: %s\n", hipGetErrorString(e));
    } else {
        for (int p = 0; p < N_PHASES; ++p) {
            a.ph_lo = p; a.ph_hi = p + 1; void* kargs[] = {&a};
            hipError_t e = hipLaunchCooperativeKernel((const void*)fwd_kernel, dim3(grid), dim3(NTHR), kargs, LDS_BYTES, stream);
            if (e != hipSuccess) { fprintf(stderr, "cooperative launch %d failed: %s\n", p, hipGetErrorString(e)); break; }
        }
    }
}
```
